# Optimizing an MI355X kernel written in HIP

```python
import jax, jax.numpy as jnp
from jax import lax
import numpy as np

D_MODEL = 1024
BATCH = 8
SEQ = 2048
DEPTH = 4
DEC_BATCH = 128
DEC_SEQ = 8
PAST_LEN = 16384
PAGE_SIZE = 128

N_MIXERS = 3
N_A = (DEPTH + 2) // 3
N_B = (DEPTH + 1) // 3
N_C = DEPTH // 3
CONV_W = 3
CHUNK = 128
B_HEADS = 4
B_HEAD_DIM = D_MODEL // B_HEADS
POOL_WINDOWS = (2, 4, 8, 16)
POOL_GROUPS = len(POOL_WINDOWS)
POOL_GROUP_DIM = D_MODEL // POOL_GROUPS
POOL_STATE = max(POOL_WINDOWS) - 1
D_FF = 2816
EPS = 1e-6

kernel_name = "hybrid_shortconv_chunkmlp_pool_convffn_step"


def rmsnorm(x, g):
    xf = x.astype(jnp.float32)
    y = xf * lax.rsqrt(jnp.mean(xf * xf, axis=-1, keepdims=True) + EPS)
    return (y * g.astype(jnp.float32)).astype(x.dtype)


def causal_dwconv3(x, prev, w):
    L = x.shape[1]
    xp = jnp.concatenate([prev, x], axis=1)
    y = w[0] * xp[:, 0:L]
    for k in range(1, CONV_W):
        y = y + w[k] * xp[:, k:k + L]
    return y, xp[:, -(CONV_W - 1):]


def short_conv_mixer(h, prev, w_in, w_conv, w_out):
    bg, cg, v = jnp.split(h @ w_in, 3, axis=-1)
    y, new_prev = causal_dwconv3(cg * v, prev, w_conv)
    return (bg * y) @ w_out, new_prev


def chunk_mlp_mixer(h, w_in, g_v, w_s, bias, w_out):
    Bn, L, _ = h.shape
    u, v = jnp.split(h @ w_in, 2, axis=-1)
    v = rmsnorm(v, g_v)
    n_chunks = -(-L // CHUNK)
    pad = n_chunks * CHUNK - L
    vp = jnp.pad(v, ((0, 0), (0, pad), (0, 0))).reshape(Bn, n_chunks, CHUNK, B_HEADS, B_HEAD_DIM)
    mask = jnp.tril(jnp.ones((CHUNK, CHUNK), dtype=bool))
    w_m = jnp.where(mask[None], w_s, 0)
    s = jnp.einsum('hts,bnshd->bnthd', w_m, vp) + bias.T[:, :, None]
    s = s.reshape(Bn, n_chunks * CHUNK, D_MODEL)[:, :L]
    return (u * s) @ w_out, v


def pool_mixer(h, prev, start_pos, w_group, scale):
    Bn, L, D = h.shape
    xp = jnp.concatenate([prev, h], axis=1)
    csum = jnp.cumsum(xp.astype(jnp.float32), axis=1)
    csum = jnp.pad(csum, ((0, 0), (1, 0), (0, 0)))
    pos = start_pos + jnp.arange(L)
    means = []
    for gi, w in enumerate(POOL_WINDOWS):
        sl = slice(gi * POOL_GROUP_DIM, (gi + 1) * POOL_GROUP_DIM)
        hi = csum[:, POOL_STATE + 1:POOL_STATE + 1 + L, sl]
        lo = csum[:, POOL_STATE + 1 - w:POOL_STATE + 1 - w + L, sl]
        cnt = jnp.minimum(pos + 1, w).astype(jnp.float32)[None, :, None]
        means.append((hi - lo) / cnt)
    pooled = jnp.concatenate(means, axis=-1).astype(h.dtype)
    d = (pooled - h).reshape(Bn, L, POOL_GROUPS, POOL_GROUP_DIM)
    y = jnp.einsum('blgc,gce->blge', d, w_group).reshape(Bn, L, D)
    return y * scale, xp[:, -POOL_STATE:]


def conv_ffn(h, prev, w_up, w_conv, b_conv, w_down):
    g, a = jnp.split(h @ w_up, 2, axis=-1)
    gc, new_prev = causal_dwconv3(g, prev, w_conv)
    return (jax.nn.silu(gc + b_conv) * a) @ w_down, new_prev


def trunk(x, conv_prev, pool_prev, ffn_prev, start_pos,
          g_mix, g_ffn, g_final,
          a_w_in, a_conv, a_w_out,
          b_w_in, b_g_v, b_w_s, b_bias, b_w_out,
          c_w_group, c_scale,
          f_w_up, f_conv, f_conv_b, f_w_down):
    new_conv, new_pool, new_ffn, new_v = [], [], [], []
    for i in range(DEPTH):
        kind, j = i % N_MIXERS, i // N_MIXERS
        h = rmsnorm(x, g_mix[i])
        if kind == 0:
            y, st = short_conv_mixer(h, conv_prev[j], a_w_in[j], a_conv[j], a_w_out[j])
            new_conv.append(st)
        elif kind == 1:
            y, v = chunk_mlp_mixer(h, b_w_in[j], b_g_v[j], b_w_s[j], b_bias[j], b_w_out[j])
            new_v.append(v)
        else:
            y, st = pool_mixer(h, pool_prev[j], start_pos, c_w_group[j], c_scale[j])
            new_pool.append(st)
        x = x + y
        h = rmsnorm(x, g_ffn[i])
        y, st = conv_ffn(h, ffn_prev[i], f_w_up[i], f_conv[i], f_conv_b[i], f_w_down[i])
        new_ffn.append(st)
        x = x + y
    return (rmsnorm(x, g_final), jnp.stack(new_conv), jnp.stack(new_pool),
            jnp.stack(new_ffn), jnp.stack(new_v))


def setup_inputs(seed: int = 0) -> dict:
    key = jax.random.key(seed)
    ks = jax.random.split(key, 24)
    nrm = lambda k, shape, s: jax.random.normal(k, shape, jnp.float32) * s
    D = D_MODEL
    return {
        "x_prompt": nrm(ks[0], (BATCH, SEQ, D), 1.0),
        "x_sample": nrm(ks[1], (DEC_BATCH, DEC_SEQ, D), 1.0),
        "state_shortconv": nrm(ks[2], (N_A, DEC_BATCH, CONV_W - 1, D), 1.0),
        "state_pool": nrm(ks[3], (N_C, DEC_BATCH, POOL_STATE, D), 1.0),
        "state_ffnconv": nrm(ks[4], (DEPTH, DEC_BATCH, CONV_W - 1, D_FF), 1.0),
        "g_mix": 1.0 + nrm(ks[5], (DEPTH, D), 0.05),
        "g_ffn": 1.0 + nrm(ks[6], (DEPTH, D), 0.05),
        "g_final": 1.0 + nrm(ks[7], (D,), 0.05),
        "a_w_in": nrm(ks[8], (N_A, D, 3 * D), D ** -0.5),
        "a_conv": nrm(ks[9], (N_A, CONV_W, D), CONV_W ** -0.5),
        "a_w_out": nrm(ks[10], (N_A, D, D), D ** -0.5),
        "b_w_in": nrm(ks[11], (N_B, D, 2 * D), D ** -0.5),
        "b_g_v": 1.0 + nrm(ks[12], (N_B, D), 0.05),
        "b_w_s": nrm(ks[13], (N_B, B_HEADS, CHUNK, CHUNK), CHUNK ** -0.5),
        "b_bias": 1.0 + nrm(ks[14], (N_B, B_HEADS, CHUNK), 0.1),
        "b_w_out": nrm(ks[15], (N_B, D, D), D ** -0.5),
        "c_w_group": nrm(ks[16], (N_C, POOL_GROUPS, POOL_GROUP_DIM, POOL_GROUP_DIM), POOL_GROUP_DIM ** -0.5),
        "c_scale": 1.0 + nrm(ks[17], (N_C, D), 0.1),
        "f_w_up": nrm(ks[18], (DEPTH, D, 2 * D_FF), D ** -0.5),
        "f_conv": nrm(ks[19], (DEPTH, CONV_W, D_FF), CONV_W ** -0.5),
        "f_conv_b": nrm(ks[20], (DEPTH, D_FF), 0.02),
        "f_w_down": nrm(ks[21], (DEPTH, D_FF, D), D_FF ** -0.5),
    }


def reference(x_prompt, x_sample, state_shortconv, state_pool, state_ffnconv,
              g_mix, g_ffn, g_final,
              a_w_in, a_conv, a_w_out,
              b_w_in, b_g_v, b_w_s, b_bias, b_w_out,
              c_w_group, c_scale,
              f_w_up, f_conv, f_conv_b, f_w_down):
    params = (g_mix, g_ffn, g_final, a_w_in, a_conv, a_w_out,
              b_w_in, b_g_v, b_w_s, b_bias, b_w_out, c_w_group, c_scale,
              f_w_up, f_conv, f_conv_b, f_w_down)
    dt = x_prompt.dtype
    conv0 = jnp.zeros((N_A, BATCH, CONV_W - 1, D_MODEL), dt)
    pool0 = jnp.zeros((N_C, BATCH, POOL_STATE, D_MODEL), dt)
    ffn0 = jnp.zeros((DEPTH, BATCH, CONV_W - 1, D_FF), dt)
    y_prompt, conv_p, pool_p, ffn_p, _ = trunk(x_prompt, conv0, pool0, ffn0, 0, *params)
    y_sample, conv_s, pool_s, ffn_s, chunkv_s = trunk(
        x_sample, state_shortconv, state_pool, state_ffnconv, PAST_LEN, *params)
    return (y_prompt, y_sample, conv_p, conv_s, pool_p, pool_s, ffn_p, ffn_s, chunkv_s)
```

```cpp
#include <hip/hip_runtime.h>
#include <hip/hip_cooperative_groups.h>
#include <cstdio>
#include <cstdint>
namespace cg = cooperative_groups;

#define LAS __attribute__((address_space(3)))
typedef unsigned short bf16_t;
typedef short bf16x8 __attribute__((ext_vector_type(8)));
typedef float f32x4 __attribute__((ext_vector_type(4)));
typedef float f32x2 __attribute__((ext_vector_type(2)));
typedef unsigned u32x4 __attribute__((ext_vector_type(4)));
typedef unsigned u32x2 __attribute__((ext_vector_type(2)));

constexpr int D = 1024, SEQ = 2048, MP = 16384, MS = 1024, M = MP + MS, DFF = 2816, NBATCH = 8, DECB = 128, DECS = 8;
constexpr float EPS = 1e-6f;
constexpr int NWAVES = 8, NTHREADS = 512;

constexpr size_t MiB = 1u << 20;
constexpr size_t WS_SS = 0;
constexpr size_t WS_VSS = WS_SS + (size_t)9 * M * 4;
constexpr size_t WS_W = 1 * MiB;
constexpr size_t SZ_AIN = (size_t)3072 * 1024 * 2, SZ_SQ = (size_t)1024 * 1024 * 2, SZ_BIN = (size_t)2048 * 1024 * 2, SZ_CG = (size_t)4 * 256 * 256 * 2;
constexpr size_t SZ_UP = (size_t)5632 * 1024 * 2, SZ_DN = (size_t)1024 * 2816 * 2;
constexpr size_t WS_AIN = WS_W, WS_AOUT = WS_AIN + 2 * SZ_AIN, WS_BIN = WS_AOUT + 2 * SZ_SQ, WS_BOUT = WS_BIN + SZ_BIN, WS_CG = WS_BOUT + SZ_SQ;
constexpr size_t WS_UP = WS_CG + SZ_CG, WS_DN = WS_UP + 4 * SZ_UP, WS_WEND = WS_DN + 4 * SZ_DN;
constexpr size_t WS_X = 90 * MiB;
constexpr size_t WS_XB = WS_X + (size_t)M * D * 4;
constexpr size_t WS_T1 = WS_XB + (size_t)M * D * 2;
constexpr size_t WS_T2 = WS_T1 + (size_t)M * D * 2, WS_T3 = WS_T2 + (size_t)M * D * 2;
constexpr size_t WS_MB = WS_T1;
constexpr size_t WS_VS = WS_T3 + (size_t)M * D * 2;
constexpr size_t WS_FXP = WS_VS + (size_t)MS * D * 4;
constexpr size_t SZ_FX = (size_t)256 * 2 * DFF * 4;
constexpr size_t WS_FXA = WS_FXP + SZ_FX, WS_GL = WS_FXA + SZ_FX, WS_END = WS_GL + SZ_FX;
static_assert(WS_WEND <= WS_X, "weights fit");
static_assert(WS_T1 + (size_t)M * DFF * 2 <= WS_VS, "MB overlays T1..T3");

constexpr size_t O_YP = 0, O_YS = O_YP + (size_t)MP * D, O_SCP = O_YS + (size_t)MS * D, O_SCS = O_SCP + 2 * 8 * 2 * 1024, O_PP = O_SCS + 2 * 128 * 2 * 1024;
constexpr size_t O_PS = O_PP + 8 * 15 * 1024, O_FP = O_PS + 128 * 15 * 1024, O_FS = O_FP + 4 * 8 * 2 * DFF, O_CV = O_FS + 4 * 128 * 2 * DFF, O_END = O_CV + 128 * 8 * 1024;

__device__ __forceinline__ unsigned cvt_pk_bf16(float lo, float hi) { unsigned r; asm volatile("v_cvt_pk_bf16_f32 %0, %1, %2" : "=v"(r) : "v"(lo), "v"(hi)); return r; }
__device__ __forceinline__ float bf_lo(unsigned w) { return __uint_as_float(w << 16); }
__device__ __forceinline__ float bf_hi(unsigned w) { return __uint_as_float(w & 0xffff0000u); }
__device__ __forceinline__ float rstd_of(float ss) { return rsqrtf(ss * (1.0f / 1024.0f) + EPS); }
__device__ __forceinline__ float silu_f(float x) { return x * __builtin_amdgcn_rcpf(1.0f + __builtin_amdgcn_exp2f(-1.4426950408889634f * x)); }
__device__ __forceinline__ void atomic_addf(float* p, float v) { (void)__hip_atomic_fetch_add(p, v, __ATOMIC_RELAXED, __HIP_MEMORY_SCOPE_AGENT); }
__device__ __forceinline__ float wave_sum(float v) {
#pragma unroll
    for (int o = 1; o < 64; o <<= 1) v += __shfl_xor(v, o);
    return v;
}

namespace pg8 {
constexpr int BM = 256, BK = 64, HALF = 128, HTB = HALF * BK * 2, STAGE_BYTES = 8 * HTB, NXCD = 8, WGM = 8;
__host__ __device__ __forceinline__ int lds_byte(int r, int c) { const int st = (r >> 4) * 2 + (c >> 5), rr = r & 15, cc = c & 31, ob = rr * 64 + cc * 2; return st * 1024 + (ob ^ (((ob >> 9) & 1) << 5)); }
__host__ __device__ __forceinline__ void stage_rc(int b, int& R, int& C) { const int st = b / 1024, sb = b % 1024, swz = sb ^ (((sb >> 9) & 1) << 5); R = (st >> 1) * 16 + swz / 64; C = (st & 1) * 32 + (swz % 64) / 2; }
__host__ __device__ __forceinline__ int perm32(int rho) { const int n = rho >> 4, i = rho & 15; return 8 * (i >> 2) + 4 * n + (i & 3); }

struct Unit { int pm, pn; };
struct Gemm { const bf16_t* A; const bf16_t* Bt; int lda, ldb, K, nM, nN, a_pn_off; };

struct StaticOrder {
    int nM, nN, nwg, G, c;
    __device__ void init(int nM_, int nN_, int G_, int c_) { nM = nM_; nN = nN_; nwg = nM * nN; G = G_; c = c_; }
    __device__ bool next(int i, Unit& u) const {
        const long L = (long)i * G + c; if (L >= nwg) return false;
        int wgid = (int)L; { const int q = nwg / NXCD, r = nwg % NXCD, xcd = wgid % NXCD, off = wgid / NXCD; wgid = (xcd < r ? xcd * (q + 1) : r * (q + 1) + (xcd - r) * q) + off; }
        const int nig = WGM * nN, gid = wgid / nig, fm = gid * WGM, gsz = (nM - fm) < WGM ? (nM - fm) : WGM;
        u.pm = fm + ((wgid % nig) % gsz); u.pn = (wgid % nig) / gsz; return true;
    }
};

template <class Epi>
__device__ __forceinline__ void gemm_phase(LAS unsigned char* lds, const Gemm g, const StaticOrder& S, const Epi& E) {
    int tid = threadIdx.x; asm volatile("" : "+v"(tid)); const int wid = __builtin_amdgcn_readfirstlane(tid >> 6), lane = tid & 63, wr = wid >> 2, wc = wid & 3, fr = lane & 15, fq = lane >> 4;
    const int K = g.K, nt = K / BK;
    unsigned voffA[2], voffB[2];
#pragma unroll
    for (int i = 0; i < 2; ++i) { int R, C; stage_rc(tid * 16 + i * 8192, R, C); const int Rb = (R & ~31) + perm32(R & 31);
        voffA[i] = (unsigned)(R * g.lda + C) * 2u; voffB[i] = (unsigned)(Rb * g.ldb + C) * 2u; }
    const unsigned kstep = (unsigned)(BK * 2);
    const unsigned hstepA = (unsigned)HALF * g.lda * 2, hstepB = (unsigned)HALF * g.ldb * 2;
    const unsigned tstepA = 2 * hstepA, tstepB = 2 * hstepB;
    const unsigned ldsw = (unsigned)wid * 1024u;
    const int aoff = lds_byte(wr * 64 + fr, fq * 8), boff = lds_byte(wc * 32 + fr, fq * 8);
#define PG8_SA(b, h) (((b) * 2 + (h)) * HTB)
#define PG8_SB(b, h) ((4 + (b) * 2 + (h)) * HTB)
#define PG8_STAGE(bufoff, gbase, voff) do { _Pragma("unroll") for (int _i = 0; _i < 2; ++_i) \
        __builtin_amdgcn_global_load_lds((const unsigned*)((const char*)(gbase) + (voff)[_i]), (LAS unsigned*)(lds + (bufoff) + ldsw + _i * 8192), 16, 0, 0); } while (0)
#define PG8_LDA(dst, b, h) do { _Pragma("unroll") for (int m = 0; m < 4; ++m) _Pragma("unroll") for (int k = 0; k < 2; ++k) dst[m][k] = *(const LAS bf16x8*)(lds + PG8_SA(b, h) + aoff + m * 2048 + k * 1024); } while (0)
#define PG8_LDB(dst, b, h) do { _Pragma("unroll") for (int n = 0; n < 2; ++n) _Pragma("unroll") for (int k = 0; k < 2; ++k) dst[n][k] = *(const LAS bf16x8*)(lds + PG8_SB(b, h) + boff + n * 2048 + k * 1024); } while (0)
#define PG8_MMA(ai, bj, At, Bt) do { __builtin_amdgcn_s_setprio(1); _Pragma("unroll") for (int m = 0; m < 4; ++m) _Pragma("unroll") for (int n = 0; n < 2; ++n) _Pragma("unroll") for (int k = 0; k < 2; ++k) \
        acc[ai][bj][m][n] = __builtin_amdgcn_mfma_f32_16x16x32_bf16(Bt[n][k], At[m][k], acc[ai][bj][m][n], 0, 0, 0); __builtin_amdgcn_s_setprio(0); } while (0)
#define PG8_WAIT_V(n) asm volatile("s_waitcnt vmcnt(" #n ")" ::: "memory")
#define PG8_WAIT_L(n) asm volatile("s_waitcnt lgkmcnt(" #n ")" ::: "memory")
#define PG8_BAR __builtin_amdgcn_s_barrier()
#define PG8_SCHED __builtin_amdgcn_sched_barrier(0)
    Unit cur, nxt; int ui = 0;
    if (!S.next(0, cur)) return;
    f32x4 acc[2][2][4][2];
#pragma unroll
    for (int a = 0; a < 2; ++a)
#pragma unroll
        for (int b = 0; b < 2; ++b)
#pragma unroll
            for (int m = 0; m < 4; ++m)
#pragma unroll
                for (int n = 0; n < 2; ++n) acc[a][b][m][n] = (f32x4){0.f, 0.f, 0.f, 0.f};
    bf16x8 At[4][2], B0[2][2], B1[2][2];
    const char* cA = (const char*)g.A + (size_t)cur.pm * tstepA + (size_t)cur.pn * g.a_pn_off * 2; const char* cB = (const char*)g.Bt + (size_t)cur.pn * tstepB;
    PG8_STAGE(PG8_SB(0, 0), cB, voffB); PG8_STAGE(PG8_SB(0, 1), cB + hstepB, voffB); PG8_STAGE(PG8_SA(0, 0), cA, voffA); PG8_STAGE(PG8_SA(0, 1), cA + hstepA, voffA);
    if (wr == 1) PG8_BAR;
    PG8_WAIT_V(2); PG8_BAR;
    PG8_STAGE(PG8_SB(1, 0), cB + kstep, voffB); PG8_STAGE(PG8_SA(1, 0), cA + kstep, voffA); PG8_STAGE(PG8_SB(1, 1), cB + hstepB + kstep, voffB);
    PG8_WAIT_V(6); PG8_BAR;
    for (;;) {
        const bool has_next = S.next(ui + 1, nxt);
        const char* nA = has_next ? (const char*)g.A + (size_t)nxt.pm * tstepA + (size_t)nxt.pn * g.a_pn_off * 2 : cA; const char* nB = has_next ? (const char*)g.Bt + (size_t)nxt.pn * tstepB : cB;
        for (int t = 0; t < nt; t += 2) {
            const bool last = (t == nt - 2);
            const char* a1 = cA + (unsigned)(t + 1) * kstep;
            const char* a2 = last ? nA : cA + (unsigned)(t + 2) * kstep; const char* b2 = last ? nB : cB + (unsigned)(t + 2) * kstep;
            const char* a3 = a2 + kstep; const char* b3 = b2 + kstep;
            PG8_LDB(B0, 0, 0); PG8_LDB(B1, 0, 1); PG8_SCHED; PG8_LDA(At, 0, 0); PG8_STAGE(PG8_SA(1, 1), a1 + hstepA, voffA);
            PG8_WAIT_V(8); PG8_WAIT_L(0); PG8_BAR; PG8_MMA(0, 0, At, B0); PG8_MMA(0, 1, At, B1); PG8_BAR; PG8_SCHED;
            PG8_LDA(At, 0, 1); PG8_STAGE(PG8_SB(0, 0), b2, voffB); PG8_STAGE(PG8_SB(0, 1), b2 + hstepB, voffB); PG8_STAGE(PG8_SA(0, 0), a2, voffA);
            PG8_WAIT_V(8); PG8_WAIT_L(0); PG8_BAR; PG8_MMA(1, 0, At, B0); PG8_MMA(1, 1, At, B1); PG8_BAR; PG8_SCHED;
            PG8_LDB(B0, 1, 0); PG8_LDB(B1, 1, 1); PG8_SCHED; PG8_LDA(At, 1, 0); PG8_STAGE(PG8_SA(0, 1), a2 + hstepA, voffA);
            PG8_WAIT_V(8); PG8_WAIT_L(0); PG8_BAR; PG8_MMA(0, 0, At, B0); PG8_MMA(0, 1, At, B1); PG8_BAR; PG8_SCHED;
            PG8_LDA(At, 1, 1); PG8_STAGE(PG8_SB(1, 0), b3, voffB); PG8_STAGE(PG8_SB(1, 1), b3 + hstepB, voffB); PG8_STAGE(PG8_SA(1, 0), a3, voffA);
            PG8_WAIT_V(8); PG8_WAIT_L(0); PG8_BAR; PG8_MMA(1, 0, At, B0); PG8_MMA(1, 1, At, B1); PG8_BAR; PG8_SCHED;
        }
        if (wr == 0) PG8_BAR;
        E(acc, cur, wr, wc, fr, fq);
        if (!has_next) break;
#pragma unroll
        for (int a = 0; a < 2; ++a)
#pragma unroll
            for (int b = 0; b < 2; ++b)
#pragma unroll
                for (int m = 0; m < 4; ++m)
#pragma unroll
                    for (int n = 0; n < 2; ++n) acc[a][b][m][n] = (f32x4){0.f, 0.f, 0.f, 0.f};
        cur = nxt; cA = nA; cB = nB; ++ui;
        if (wr == 1) PG8_BAR;
    }
    PG8_WAIT_V(0);
    PG8_BAR;
#undef PG8_SA
#undef PG8_SB
#undef PG8_STAGE
#undef PG8_LDA
#undef PG8_LDB
#undef PG8_MMA
#undef PG8_WAIT_V
#undef PG8_WAIT_L
#undef PG8_BAR
#undef PG8_SCHED
}
}

typedef f32x4 AccT[2][2][4][2];
__device__ __forceinline__ void store_bf16x8(bf16_t* p, f32x4 v0, f32x4 v1) {
    u32x4 w; w.x = cvt_pk_bf16(v0[0], v0[1]); w.y = cvt_pk_bf16(v0[2], v0[3]); w.z = cvt_pk_bf16(v1[0], v1[1]); w.w = cvt_pk_bf16(v1[2], v1[3]); *(u32x4*)p = w;
}

struct EpiRes {
    const float* xin_p; const float* xin_s; float* xout; bf16_t* xb; float* ssn; const float* cs;
    __device__ __forceinline__ void operator()(const AccT& acc, const pg8::Unit& u, int wr, int wc, int fr, int fq) const {
        const int colb = u.pn * 256 + wc * 32 + 8 * fq;
        f32x4 c[2][2];
#pragma unroll
        for (int bj = 0; bj < 2; ++bj)
#pragma unroll
            for (int n = 0; n < 2; ++n) c[bj][n] = cs ? *(const f32x4*)(cs + colb + 128 * bj + 4 * n) : (f32x4){1.f, 1.f, 1.f, 1.f};
#pragma unroll
        for (int ai = 0; ai < 2; ++ai)
#pragma unroll
            for (int m = 0; m < 4; ++m) {
                const int row = u.pm * 256 + ai * 128 + wr * 64 + m * 16 + fr;
                const float* xi = (u.pm < 64) ? xin_p + (size_t)row * D : xin_s + (size_t)(row - MP) * D;
                float* xo = xout + (size_t)row * D; bf16_t* xbo = xb + (size_t)row * D;
                float s = 0.f;
#pragma unroll
                for (int bj = 0; bj < 2; ++bj) {
                    const int col = colb + 128 * bj;
                    const f32x4 o0 = *(const f32x4*)(xi + col) + acc[ai][bj][m][0] * c[bj][0], o1 = *(const f32x4*)(xi + col + 4) + acc[ai][bj][m][1] * c[bj][1];
                    *(f32x4*)(xo + col) = o0; *(f32x4*)(xo + col + 4) = o1; store_bf16x8(xbo + col, o0, o1);
                    s += (o0[0] * o0[0] + o0[1] * o0[1]) + (o0[2] * o0[2] + o0[3] * o0[3]) + (o1[0] * o1[0] + o1[1] * o1[1]) + (o1[2] * o1[2] + o1[3] * o1[3]);
                }
                s += __shfl_xor(s, 16); s += __shfl_xor(s, 32);
                if (fq == 0) atomic_addf(ssn + row, s);
            }
    }
};
struct EpiAin {
    const float* ss; bf16_t* BG; bf16_t* CV; float* st_p; float* st_s;
    __device__ __forceinline__ void operator()(const AccT& acc, const pg8::Unit& u, int wr, int wc, int fr, int fq) const {
#pragma unroll
        for (int ai = 0; ai < 2; ++ai)
#pragma unroll
            for (int m = 0; m < 4; ++m) {
                const int row = u.pm * 256 + ai * 128 + wr * 64 + m * 16 + fr;
                const float r = rstd_of(ss[row]);
                if (u.pn < 4) {
#pragma unroll
                    for (int bj = 0; bj < 2; ++bj) store_bf16x8(BG + (size_t)row * D + u.pn * 256 + 128 * bj + wc * 32 + 8 * fq, acc[ai][bj][m][0] * r, acc[ai][bj][m][1] * r);
                } else {
                    const int ch = (u.pn - 4) * 128 + wc * 32 + 8 * fq; const float r2 = r * r;
                    const f32x4 c0 = acc[ai][0][m][0] * acc[ai][1][m][0] * r2, c1 = acc[ai][0][m][1] * acc[ai][1][m][1] * r2;
                    store_bf16x8(CV + (size_t)row * D + ch, c0, c1);
                    if (u.pm < 64) { const int t = row & (SEQ - 1); if (t >= SEQ - 2) { float* o = st_p + ((size_t)(row >> 11) * 2 + (t - (SEQ - 2))) * D + ch; *(f32x4*)o = c0; *(f32x4*)(o + 4) = c1; } }
                    else { const int rr = row - MP, t = rr & 7; if (t >= 6) { float* o = st_s + ((size_t)(rr >> 3) * 2 + (t - 6)) * D + ch; *(f32x4*)o = c0; *(f32x4*)(o + 4) = c1; } }
                }
            }
    }
};
struct EpiBin {
    const float* ss; bf16_t* U; bf16_t* VT; float* VS; float* vss;
    __device__ __forceinline__ void operator()(const AccT& acc, const pg8::Unit& u, int wr, int wc, int fr, int fq) const {
#pragma unroll
        for (int ai = 0; ai < 2; ++ai)
#pragma unroll
            for (int m = 0; m < 4; ++m) {
                const int row = u.pm * 256 + ai * 128 + wr * 64 + m * 16 + fr;
                const float r = rstd_of(ss[row]);
                if (u.pn < 4) {
#pragma unroll
                    for (int bj = 0; bj < 2; ++bj) store_bf16x8(U + (size_t)row * D + u.pn * 256 + 128 * bj + wc * 32 + 8 * fq, acc[ai][bj][m][0] * r, acc[ai][bj][m][1] * r);
                } else {
                    float s = 0.f;
#pragma unroll
                    for (int bj = 0; bj < 2; ++bj) {
                        const int ch = (u.pn - 4) * 256 + 128 * bj + wc * 32 + 8 * fq;
                        const f32x4 v0 = acc[ai][bj][m][0] * r, v1 = acc[ai][bj][m][1] * r;
                        s += (v0[0] * v0[0] + v0[1] * v0[1]) + (v0[2] * v0[2] + v0[3] * v0[3]) + (v1[0] * v1[0] + v1[1] * v1[1]) + (v1[2] * v1[2] + v1[3] * v1[3]);
                        if (u.pm < 64) {
                            const unsigned w0 = cvt_pk_bf16(v0[0], v0[1]), w1 = cvt_pk_bf16(v0[2], v0[3]), w2 = cvt_pk_bf16(v1[0], v1[1]), w3 = cvt_pk_bf16(v1[2], v1[3]);
                            bf16_t* o = VT + (size_t)ch * MP + row;
                            o[0] = (bf16_t)w0; o[(size_t)MP] = (bf16_t)(w0 >> 16); o[(size_t)2 * MP] = (bf16_t)w1; o[(size_t)3 * MP] = (bf16_t)(w1 >> 16);
                            o[(size_t)4 * MP] = (bf16_t)w2; o[(size_t)5 * MP] = (bf16_t)(w2 >> 16); o[(size_t)6 * MP] = (bf16_t)w3; o[(size_t)7 * MP] = (bf16_t)(w3 >> 16);
                        } else { float* o = VS + (size_t)(row - MP) * D + ch; *(f32x4*)o = v0; *(f32x4*)(o + 4) = v1; }
                    }
                    s += __shfl_xor(s, 16); s += __shfl_xor(s, 32);
                    if (fq == 0) atomic_addf(vss + row, s);
                }
            }
    }
};
struct EpiUp {
    const float* ss; bf16_t* MB; const float* cw; const float* cb; const float* st_in; float* fxp; float* fxa; float* gl; float* st_p; float* st_s;
    __device__ __forceinline__ void operator()(const AccT& acc, const pg8::Unit& u, int wr, int wc, int fr, int fq) const {
        const int lane = threadIdx.x & 63;
        const int src1 = (lane & 48) | ((fr - 1) & 15), src2 = (lane & 48) | ((fr - 2) & 15);
        const bool prompt = u.pm < 64;
#pragma unroll
        for (int n = 0; n < 2; ++n) {
            const int ch = u.pn * 128 + wc * 32 + 8 * fq + 4 * n;
            const f32x4 w0 = *(const f32x4*)(cw + ch), w1 = *(const f32x4*)(cw + DFF + ch), w2 = *(const f32x4*)(cw + 2 * DFF + ch), bb = *(const f32x4*)(cb + ch);
#pragma unroll
            for (int ai = 0; ai < 2; ++ai) {
                const int G = u.pm * 4 + ai * 2 + wr;
                f32x4 p1 = (f32x4){0.f, 0.f, 0.f, 0.f}, p2 = p1;
#pragma unroll
                for (int m = 0; m < 4; ++m) {
                    const int row = u.pm * 256 + ai * 128 + wr * 64 + m * 16 + fr;
                    const float r = rstd_of(ss[row]);
                    const f32x4 gg = acc[ai][0][m][n] * r, aa = acc[ai][1][m][n] * r;
                    f32x4 q1, q2, pv1, pv2;
#pragma unroll
                    for (int j = 0; j < 4; ++j) { q1[j] = __shfl(gg[j], src1); q2[j] = __shfl(gg[j], src2); }
                    if (prompt) { pv1 = (fr >= 1) ? q1 : p1; pv2 = (fr >= 2) ? q2 : p2; }
                    else {
                        const int rr = row - MP, t = rr & 7; const float* sp = st_in + (size_t)(rr >> 3) * 2 * DFF + ch;
                        pv1 = q1; pv2 = q2;
                        if (t == 0) { pv1 = *(const f32x4*)(sp + DFF); pv2 = *(const f32x4*)(sp); }
                        if (t == 1) { pv2 = *(const f32x4*)(sp + DFF); }
                    }
                    const f32x4 pre = w2 * gg + w1 * pv1 + w0 * pv2 + bb;
                    u32x2 o; o.x = cvt_pk_bf16(silu_f(pre[0]) * aa[0], silu_f(pre[1]) * aa[1]); o.y = cvt_pk_bf16(silu_f(pre[2]) * aa[2], silu_f(pre[3]) * aa[3]);
                    *(u32x2*)(MB + (size_t)row * DFF + ch) = o;
                    if (prompt) {
                        if (m == 0 && fr < 2 && (G & 31) != 0) { *(f32x4*)(fxp + ((size_t)G * 2 + fr) * DFF + ch) = pre; *(f32x4*)(fxa + ((size_t)G * 2 + fr) * DFF + ch) = aa; }
                        if (m == 3 && fr >= 14) {
                            *(f32x4*)(gl + ((size_t)G * 2 + (fr - 14)) * DFF + ch) = gg;
                            if ((G & 31) == 31) *(f32x4*)(st_p + ((size_t)(G >> 5) * 2 + (fr - 14)) * DFF + ch) = gg;
                        }
                    } else {
                        const int rr = row - MP, t = rr & 7;
                        if (t >= 6) *(f32x4*)(st_s + ((size_t)(rr >> 3) * 2 + (t - 6)) * DFF + ch) = gg;
                    }
                    p1 = q1; p2 = q2;
                }
            }
        }
    }
};

struct Args { const float* in[22]; float* out; unsigned char* ws; int ph_lo, ph_hi; };
__device__ __forceinline__ const float* ldp(const Args& a, int i) { asm volatile("" : "+s"(i)); return a.in[i]; }
__device__ __forceinline__ unsigned char* ws_of(const Args& a) { unsigned char* p = a.ws; asm volatile("" : "+s"(p)); return p; }
__device__ __forceinline__ float* out_of(const Args& a) { float* p = a.out; asm volatile("" : "+s"(p)); return p; }
__device__ __forceinline__ int tid_l() { int t = threadIdx.x; asm volatile("" : "+v"(t)); return t; }
enum { I_XP = 0, I_XS, I_SSC, I_SPOOL, I_SFFN, I_GMIX, I_GFFN, I_GFIN, I_AWIN, I_ACONV, I_AWOUT, I_BWIN, I_BGV, I_BWS, I_BBIAS, I_BWOUT, I_CWG, I_CSCALE, I_FWUP, I_FCONV, I_FCONVB, I_FWDN };

template <int MAP> __device__ __forceinline__ int colmap(int n0) {
    if (MAP == 1) { if (n0 < 1024) return n0; const int q = n0 - 1024, p = q >> 8, jj = q & 255; return jj < 128 ? 1024 + 128 * p + jj : 2048 + 128 * p + (jj - 128); }
    if (MAP == 2) { const int p = n0 >> 8, jj = n0 & 255; return jj < 128 ? 128 * p + jj : DFF + 128 * p + (jj - 128); }
    return n0;
}
template <int MAP>
__device__ __forceinline__ void prep_matrix(const float* W, int K, int N, bf16_t* WT, const float* gs, LAS float* scr, int lane, int gw, int NGW, int& base) {
    const int nblk = N / 32, nitems = (K / 64) * nblk;
    int first = gw - (base % NGW); if (first < 0) first += NGW;
    for (int item = first; item < nitems; item += NGW) {
        const int kb = item / nblk, nb = item % nblk, k0 = 64 * kb, n0 = 32 * nb, sc = colmap<MAP>(n0);
#pragma unroll 8
        for (int i = 0; i < 32; ++i) { const int kk = 2 * i + (lane >> 5); float v = W[(size_t)(k0 + kk) * N + sc + (lane & 31)]; if (gs) v *= gs[k0 + kk]; scr[kk * 33 + (lane & 31)] = v; }
        asm volatile("s_waitcnt lgkmcnt(0)" ::: "memory");
        const int c = lane & 7;
#pragma unroll
        for (int j = 0; j < 4; ++j) { const int n = (lane >> 3) + 8 * j; const LAS float* s = scr + (8 * c) * 33 + n;
            u32x4 o; o.x = cvt_pk_bf16(s[0 * 33], s[1 * 33]); o.y = cvt_pk_bf16(s[2 * 33], s[3 * 33]); o.z = cvt_pk_bf16(s[4 * 33], s[5 * 33]); o.w = cvt_pk_bf16(s[6 * 33], s[7 * 33]);
            *(u32x4*)(WT + (size_t)(n0 + n) * K + k0 + 8 * c) = o; }
        asm volatile("s_waitcnt lgkmcnt(0)" ::: "memory");
    }
    base += nitems;
}

__device__ __forceinline__ void prep_phase(const Args& a, LAS unsigned char* lds) {
    unsigned char* const wsl = ws_of(a); float* const outl = out_of(a); const int tidl = tid_l();
    const int tid = tidl, lane = tid & 63, wave = tid >> 6;
    const int gw = blockIdx.x * NWAVES + wave, NGW = gridDim.x * NWAVES;
    LAS float* scr = (LAS float*)(lds + wave * 16384);
    unsigned char* ws = wsl;
    { float* z = (float*)(ws + WS_SS) + M; const int nz = 9 * M; for (int i = blockIdx.x * NTHREADS + tid; i < nz; i += gridDim.x * NTHREADS) z[i] = 0.f; }
    { float* ss0 = (float*)(ws + WS_SS); bf16_t* xb = (bf16_t*)(ws + WS_XB);
      for (int row = gw; row < M; row += NGW) {
          const float* xr = row < MP ? ldp(a, I_XP) + (size_t)row * D : ldp(a, I_XS) + (size_t)(row - MP) * D;
          float s = 0.f;
#pragma unroll
          for (int j = 0; j < 2; ++j) { const f32x4 v0 = *(const f32x4*)(xr + j * 512 + lane * 8), v1 = *(const f32x4*)(xr + j * 512 + lane * 8 + 4);
              s += (v0[0] * v0[0] + v0[1] * v0[1]) + (v0[2] * v0[2] + v0[3] * v0[3]) + (v1[0] * v1[0] + v1[1] * v1[1]) + (v1[2] * v1[2] + v1[3] * v1[3]);
              store_bf16x8(xb + (size_t)row * D + j * 512 + lane * 8, v0, v1); }
          s = wave_sum(s); if (lane == 0) ss0[row] = s; } }
    int base = 0;
    for (int j = 0; j < 2; ++j) {
        prep_matrix<1>(ldp(a, I_AWIN) + (size_t)j * 1024 * 3072, 1024, 3072, (bf16_t*)(ws + WS_AIN + j * SZ_AIN), ldp(a, I_GMIX) + (size_t)(3 * j) * D, scr, lane, gw, NGW, base);
        prep_matrix<0>(ldp(a, I_AWOUT) + (size_t)j * 1024 * 1024, 1024, 1024, (bf16_t*)(ws + WS_AOUT + j * SZ_SQ), nullptr, scr, lane, gw, NGW, base);
    }
    prep_matrix<0>(ldp(a, I_BWIN), 1024, 2048, (bf16_t*)(ws + WS_BIN), ldp(a, I_GMIX) + (size_t)1 * D, scr, lane, gw, NGW, base);
    prep_matrix<0>(ldp(a, I_BWOUT), 1024, 1024, (bf16_t*)(ws + WS_BOUT), nullptr, scr, lane, gw, NGW, base);
    for (int g = 0; g < 4; ++g) prep_matrix<0>(ldp(a, I_CWG) + (size_t)g * 65536, 256, 256, (bf16_t*)(ws + WS_CG) + (size_t)g * 65536, nullptr, scr, lane, gw, NGW, base);
    for (int i = 0; i < 4; ++i) {
        prep_matrix<2>(ldp(a, I_FWUP) + (size_t)i * 1024 * 5632, 1024, 5632, (bf16_t*)(ws + WS_UP + i * SZ_UP), ldp(a, I_GFFN) + (size_t)i * D, scr, lane, gw, NGW, base);
        prep_matrix<0>(ldp(a, I_FWDN) + (size_t)i * 2816 * 1024, 2816, 1024, (bf16_t*)(ws + WS_DN + i * SZ_DN), nullptr, scr, lane, gw, NGW, base);
    }
}

__device__ __forceinline__ void aconv_phase(const Args& a, int j) {
    unsigned char* const wsl = ws_of(a); float* const outl = out_of(a); const int tidl = tid_l();
    const bf16_t* BG = (const bf16_t*)(wsl + WS_T1); const bf16_t* CV = (const bf16_t*)(wsl + WS_T2); bf16_t* ZB = (bf16_t*)(wsl + WS_T3);
    const float* cw = ldp(a, I_ACONV) + (size_t)j * 3 * D; const float* st = ldp(a, I_SSC) + (size_t)j * DECB * 2 * D;
    const int tid = tidl, c8 = (tid & 127) * 8, rsub = tid >> 7;
    f32x4 w[3][2];
#pragma unroll
    for (int k = 0; k < 3; ++k) { w[k][0] = *(const f32x4*)(cw + k * D + c8); w[k][1] = *(const f32x4*)(cw + k * D + c8 + 4); }
    for (int r4 = blockIdx.x; r4 < M / 4; r4 += gridDim.x) {
        const int row = r4 * 4 + rsub;
        int t; const float* sp = nullptr;
        if (row < MP) t = row & (SEQ - 1); else { const int rr = row - MP; t = rr & 7; sp = st + (size_t)(rr >> 3) * 2 * D + c8; }
        f32x4 x[3][2];
#pragma unroll
        for (int k = 0; k < 3; ++k) {
            const int tt = t - 2 + k;
            if (tt >= 0) { const u32x4 v = *(const u32x4*)(CV + (size_t)(row - 2 + k) * D + c8);
                x[k][0] = (f32x4){bf_lo(v.x), bf_hi(v.x), bf_lo(v.y), bf_hi(v.y)}; x[k][1] = (f32x4){bf_lo(v.z), bf_hi(v.z), bf_lo(v.w), bf_hi(v.w)}; }
            else if (sp) { x[k][0] = *(const f32x4*)(sp + (size_t)(2 + tt) * D); x[k][1] = *(const f32x4*)(sp + (size_t)(2 + tt) * D + 4); }
            else { x[k][0] = (f32x4){0.f, 0.f, 0.f, 0.f}; x[k][1] = x[k][0]; }
        }
        const u32x4 b = *(const u32x4*)(BG + (size_t)row * D + c8);
        const f32x4 b0 = (f32x4){bf_lo(b.x), bf_hi(b.x), bf_lo(b.y), bf_hi(b.y)}, b1 = (f32x4){bf_lo(b.z), bf_hi(b.z), bf_lo(b.w), bf_hi(b.w)};
        const f32x4 y0 = w[0][0] * x[0][0] + w[1][0] * x[1][0] + w[2][0] * x[2][0], y1 = w[0][1] * x[0][1] + w[1][1] * x[1][1] + w[2][1] * x[2][1];
        store_bf16x8(ZB + (size_t)row * D + c8, b0 * y0, b1 * y1);
    }
}

__device__ __forceinline__ void spatial_phase(const Args& a) {
    unsigned char* const wsl = ws_of(a); float* const outl = out_of(a); const int tidl = tid_l();
    const bf16_t* U = (const bf16_t*)(wsl + WS_T1); const bf16_t* VT = (const bf16_t*)(wsl + WS_T2); bf16_t* ZB = (bf16_t*)(wsl + WS_T3);
    const float* VS = (const float*)(wsl + WS_VS); const float* vss = (const float*)(wsl + WS_VSS);
    const float* Ws = ldp(a, I_BWS); const float* bias = ldp(a, I_BBIAS); const float* gv = ldp(a, I_BGV);
    const int tid = tidl, lane = tid & 63, w = tid >> 6, fr = lane & 15, fq = lane >> 4;
    for (int unit = blockIdx.x; unit < 512 + DECB; unit += gridDim.x) {
        if (unit < 512) {
            const int c = unit >> 2, h = unit & 3, rb = c * 128, t = 16 * w + fr;
            f32x4 acc[16];
#pragma unroll
            for (int i = 0; i < 16; ++i) acc[i] = (f32x4){0.f, 0.f, 0.f, 0.f};
            const int nks = (w >> 1) + 1;
            for (int ks = 0; ks < nks; ++ks) {
                const int s0 = ks * 32 + 8 * fq;
                const float* wp = Ws + ((size_t)(h * 128 + t) * 128 + s0);
                const f32x4 wa = *(const f32x4*)wp, wb = *(const f32x4*)(wp + 4);
                const f32x4 va = *(const f32x4*)(vss + rb + s0), vb = *(const f32x4*)(vss + rb + s0 + 4);
                float wv[8];
#pragma unroll
                for (int i = 0; i < 4; ++i) { wv[i] = (s0 + i <= t) ? wa[i] * rstd_of(va[i]) : 0.f; wv[4 + i] = (s0 + 4 + i <= t) ? wb[i] * rstd_of(vb[i]) : 0.f; }
                u32x4 wpk; wpk.x = cvt_pk_bf16(wv[0], wv[1]); wpk.y = cvt_pk_bf16(wv[2], wv[3]); wpk.z = cvt_pk_bf16(wv[4], wv[5]); wpk.w = cvt_pk_bf16(wv[6], wv[7]);
                const bf16x8 Wf = __builtin_bit_cast(bf16x8, wpk);
#pragma unroll
                for (int dt = 0; dt < 16; ++dt) {
                    const bf16x8 vf = *(const bf16x8*)(VT + (size_t)(h * 256 + dt * 16 + fr) * MP + rb + s0);
                    acc[dt] = __builtin_amdgcn_mfma_f32_16x16x32_bf16(vf, Wf, acc[dt], 0, 0, 0);
                }
            }
            const int row = rb + t; const float bs = bias[h * 128 + t];
#pragma unroll
            for (int dt = 0; dt < 16; ++dt) {
                const int ch = h * 256 + dt * 16 + 4 * fq;
                const f32x4 g4 = *(const f32x4*)(gv + ch);
                const u32x2 uu = *(const u32x2*)(U + (size_t)row * D + ch);
                const f32x4 u4 = (f32x4){bf_lo(uu.x), bf_hi(uu.x), bf_lo(uu.y), bf_hi(uu.y)};
                const f32x4 z = u4 * (acc[dt] * g4 + bs);
                u32x2 o; o.x = cvt_pk_bf16(z[0], z[1]); o.y = cvt_pk_bf16(z[2], z[3]);
                *(u32x2*)(ZB + (size_t)row * D + ch) = o;
            }
        } else {
            const int b = unit - 512, r0 = MP + 8 * b, ch = 2 * tid, h = ch >> 8;
            float v0[8], v1[8], rv[8];
#pragma unroll
            for (int s = 0; s < 8; ++s) { rv[s] = rstd_of(vss[r0 + s]); const f32x2 vv = *(const f32x2*)(VS + (size_t)(8 * b + s) * D + ch); v0[s] = vv.x * rv[s]; v1[s] = vv.y * rv[s]; }
            const f32x2 g2 = *(const f32x2*)(gv + ch);
            float* cvo = outl + O_CV + (size_t)(8 * b) * D + ch;
#pragma unroll
            for (int t = 0; t < 8; ++t) {
                float s0 = 0.f, s1 = 0.f;
#pragma unroll
                for (int s = 0; s <= t; ++s) { const float ww = Ws[(size_t)(h * 128 + t) * 128 + s]; s0 += ww * v0[s]; s1 += ww * v1[s]; }
                const float bs = bias[h * 128 + t];
                const unsigned uu = *(const unsigned*)(U + (size_t)(r0 + t) * D + ch);
                const float z0 = bf_lo(uu) * (s0 * g2.x + bs), z1 = bf_hi(uu) * (s1 * g2.y + bs);
                *(unsigned*)(ZB + (size_t)(r0 + t) * D + ch) = cvt_pk_bf16(z0, z1);
                *(f32x2*)(cvo + (size_t)t * D) = (f32x2){v0[t] * g2.x, v1[t] * g2.y};
            }
        }
    }
}

__device__ __forceinline__ void pool_phase(const Args& a, const float* ssk, const float* gm) {
    unsigned char* const wsl = ws_of(a); float* const outl = out_of(a); const int tidl = tid_l();
    const float* X = (const float*)(wsl + WS_X); bf16_t* DB = (bf16_t*)(wsl + WS_T1);
    const float* st = ldp(a, I_SPOOL);
    const int tid = tidl, c4 = (tid & 255) * 4, rsub = tid >> 8, win = 2 << (c4 >> 8);
    const f32x4 g4 = *(const f32x4*)(gm + c4);
    for (int r2 = blockIdx.x; r2 < M / 2; r2 += gridDim.x) {
        const int row = r2 * 2 + rsub;
        f32x4 sum = (f32x4){0.f, 0.f, 0.f, 0.f}, hcur = sum; float cnt;
        if (row < MP) {
            const int t = row & (SEQ - 1); const int n = (t + 1 < win) ? t + 1 : win; cnt = (float)n;
            for (int k = 0; k < n; ++k) { const int rr = row - k; const f32x4 hv = *(const f32x4*)(X + (size_t)rr * D + c4) * (g4 * rstd_of(ssk[rr])); if (k == 0) hcur = hv; sum += hv; }
            if (t >= SEQ - 15) *(f32x4*)(outl + O_PP + ((size_t)(row >> 11) * 15 + (t - (SEQ - 15))) * D + c4) = hcur;
        } else {
            const int rr0 = row - MP, b = rr0 >> 3, t = rr0 & 7; cnt = (float)win;
            for (int k = 0; k < win; ++k) { const int tt = t - k; f32x4 hv;
                if (tt >= 0) hv = *(const f32x4*)(X + (size_t)(row - k) * D + c4) * (g4 * rstd_of(ssk[row - k]));
                else hv = *(const f32x4*)(st + ((size_t)b * 15 + (15 + tt)) * D + c4);
                if (k == 0) hcur = hv; sum += hv; }
            float* po = outl + O_PS + (size_t)b * 15 * D + c4;
            *(f32x4*)(po + (size_t)(t + 7) * D) = hcur;
            if (t < 7) *(f32x4*)(po + (size_t)t * D) = *(const f32x4*)(st + ((size_t)b * 15 + 8 + t) * D + c4);
        }
        const f32x4 d = sum * (1.0f / cnt) - hcur;
        u32x2 o; o.x = cvt_pk_bf16(d[0], d[1]); o.y = cvt_pk_bf16(d[2], d[3]);
        *(u32x2*)(DB + (size_t)row * D + c4) = o;
    }
}

__device__ __forceinline__ void ffn_fix_phase(const Args& a, int layer) {
    unsigned char* const wsl = ws_of(a); float* const outl = out_of(a); const int tidl = tid_l();
    const float* fxp = (const float*)(wsl + WS_FXP); const float* fxa = (const float*)(wsl + WS_FXA); const float* gl = (const float*)(wsl + WS_GL);
    bf16_t* MB = (bf16_t*)(wsl + WS_MB); const float* cw = ldp(a, I_FCONV) + (size_t)layer * 3 * DFF;
    const int total = 256 * 2 * (DFF / 4);
    for (int i = blockIdx.x * NTHREADS + tidl; i < total; i += gridDim.x * NTHREADS) {
        const int c4 = (i % (DFF / 4)) * 4, gr = i / (DFF / 4), G = gr >> 1, r = gr & 1;
        if ((G & 31) == 0) continue;
        const f32x4 w0 = *(const f32x4*)(cw + c4), w1 = *(const f32x4*)(cw + DFF + c4);
        f32x4 pre = *(const f32x4*)(fxp + ((size_t)G * 2 + r) * DFF + c4);
        const f32x4 gm1 = *(const f32x4*)(gl + ((size_t)(G - 1) * 2 + 1) * DFF + c4);
        if (r == 0) { const f32x4 gm2 = *(const f32x4*)(gl + ((size_t)(G - 1) * 2 + 0) * DFF + c4); pre += w1 * gm1 + w0 * gm2; }
        else pre += w0 * gm1;
        const f32x4 av = *(const f32x4*)(fxa + ((size_t)G * 2 + r) * DFF + c4);
        u32x2 o; o.x = cvt_pk_bf16(silu_f(pre[0]) * av[0], silu_f(pre[1]) * av[1]); o.y = cvt_pk_bf16(silu_f(pre[2]) * av[2], silu_f(pre[3]) * av[3]);
        *(u32x2*)(MB + (size_t)(G * 64 + r) * DFF + c4) = o;
    }
}

__device__ __forceinline__ void final_phase(const Args& a) {
    unsigned char* const wsl = ws_of(a); float* const outl = out_of(a); const int tidl = tid_l();
    const float* X = (const float*)(wsl + WS_X); const float* ss8 = (const float*)(wsl + WS_SS) + (size_t)8 * M; const float* gf = ldp(a, I_GFIN);
    const int lane = tidl & 63, gw = blockIdx.x * NWAVES + (tidl >> 6), NGW = gridDim.x * NWAVES;
    f32x4 g[4];
#pragma unroll
    for (int j = 0; j < 4; ++j) g[j] = *(const f32x4*)(gf + j * 256 + lane * 4);
    for (int row = gw; row < M; row += NGW) {
        const float r = rstd_of(ss8[row]);
#pragma unroll
        for (int j = 0; j < 4; ++j) *(f32x4*)(outl + (size_t)row * D + j * 256 + lane * 4) = *(const f32x4*)(X + (size_t)row * D + j * 256 + lane * 4) * (g[j] * r);
    }
}

constexpr int LDS_BYTES = 147456;
constexpr int N_PHASES = 25;

__global__ void __launch_bounds__(NTHREADS, 2) trunk_fwd(Args a) {
    extern __shared__ __attribute__((aligned(16))) unsigned char lds_raw[];
    LAS unsigned char* lds = (LAS unsigned char*)lds_raw;
    cg::grid_group grid = cg::this_grid();
    int ph = 0;
#define PHASE_BEGIN if (ph >= a.ph_lo && ph < a.ph_hi) { unsigned char* const ws = ws_of(a); const int G = gridDim.x, bx = blockIdx.x; (void)ws; (void)G; (void)bx;
#define PHASE_END   if (ph + 1 < a.ph_hi) grid.sync(); } ++ph;
#define SSP(k) ((float*)(ws + WS_SS) + (size_t)(k) * M)
#define XP ((float*)(ws + WS_X))
#define XBP ((bf16_t*)(ws + WS_XB))
#define T1P ((bf16_t*)(ws + WS_T1))
#define T2P ((bf16_t*)(ws + WS_T2))
#define T3P ((bf16_t*)(ws + WS_T3))

    PHASE_BEGIN prep_phase(a, lds); PHASE_END

    for (int layer = 0; layer < 4; ++layer) {
        const int kind = layer % 3, j = layer / 3;
        if (kind == 0) {
            PHASE_BEGIN
                pg8::Gemm g{XBP, (const bf16_t*)(ws + WS_AIN + j * SZ_AIN), D, D, D, 68, 12, 0}; pg8::StaticOrder S; S.init(68, 12, G, bx);
                EpiAin E{SSP(2 * layer), T1P, T2P, out_of(a) + O_SCP + (size_t)j * 8 * 2 * D, out_of(a) + O_SCS + (size_t)j * DECB * 2 * D};
                pg8::gemm_phase(lds, g, S, E);
            PHASE_END
            PHASE_BEGIN aconv_phase(a, j); PHASE_END
            PHASE_BEGIN
                pg8::Gemm g{T3P, (const bf16_t*)(ws + WS_AOUT + j * SZ_SQ), D, D, D, 68, 4, 0}; pg8::StaticOrder S; S.init(68, 4, G, bx);
                EpiRes E{layer == 0 ? ldp(a, I_XP) : XP, layer == 0 ? ldp(a, I_XS) : XP + (size_t)MP * D, XP, XBP, SSP(2 * layer + 1), nullptr};
                pg8::gemm_phase(lds, g, S, E);
            PHASE_END
        } else if (kind == 1) {
            PHASE_BEGIN
                pg8::Gemm g{XBP, (const bf16_t*)(ws + WS_BIN), D, D, D, 68, 8, 0}; pg8::StaticOrder S; S.init(68, 8, G, bx);
                EpiBin E{SSP(2 * layer), T1P, T2P, (float*)(ws + WS_VS), (float*)(ws + WS_VSS)};
                pg8::gemm_phase(lds, g, S, E);
            PHASE_END
            PHASE_BEGIN spatial_phase(a); PHASE_END
            PHASE_BEGIN
                pg8::Gemm g{T3P, (const bf16_t*)(ws + WS_BOUT), D, D, D, 68, 4, 0}; pg8::StaticOrder S; S.init(68, 4, G, bx);
                EpiRes E{XP, XP + (size_t)MP * D, XP, XBP, SSP(2 * layer + 1), nullptr};
                pg8::gemm_phase(lds, g, S, E);
            PHASE_END
        } else {
            PHASE_BEGIN pool_phase(a, SSP(2 * layer), ldp(a, I_GMIX) + (size_t)layer * D); PHASE_END
            PHASE_BEGIN
                pg8::Gemm g{T1P, (const bf16_t*)(ws + WS_CG), D, 256, 256, 68, 4, 256}; pg8::StaticOrder S; S.init(68, 4, G, bx);
                EpiRes E{XP, XP + (size_t)MP * D, XP, XBP, SSP(2 * layer + 1), ldp(a, I_CSCALE)};
                pg8::gemm_phase(lds, g, S, E);
            PHASE_END
        }
        PHASE_BEGIN
            pg8::Gemm g{XBP, (const bf16_t*)(ws + WS_UP + layer * SZ_UP), D, D, D, 68, 22, 0}; pg8::StaticOrder S; S.init(68, 22, G, bx);
            EpiUp E{SSP(2 * layer + 1), (bf16_t*)(ws + WS_MB), ldp(a, I_FCONV) + (size_t)layer * 3 * DFF, ldp(a, I_FCONVB) + (size_t)layer * DFF, ldp(a, I_SFFN) + (size_t)layer * DECB * 2 * DFF,
                    (float*)(ws + WS_FXP), (float*)(ws + WS_FXA), (float*)(ws + WS_GL), out_of(a) + O_FP + (size_t)layer * 8 * 2 * DFF, out_of(a) + O_FS + (size_t)layer * DECB * 2 * DFF};
            pg8::gemm_phase(lds, g, S, E);
        PHASE_END
        PHASE_BEGIN ffn_fix_phase(a, layer); PHASE_END
        PHASE_BEGIN
            pg8::Gemm g{(const bf16_t*)(ws + WS_MB), (const bf16_t*)(ws + WS_DN + layer * SZ_DN), DFF, DFF, DFF, 68, 4, 0}; pg8::StaticOrder S; S.init(68, 4, G, bx);
            EpiRes E{XP, XP + (size_t)MP * D, XP, XBP, SSP(2 * layer + 2), nullptr};
            pg8::gemm_phase(lds, g, S, E);
        PHASE_END
    }
    PHASE_BEGIN final_phase(a); PHASE_END
#undef PHASE_BEGIN
#undef PHASE_END
}

extern "C" void kernel_launch(void* const* d_in, const int* in_sizes, int n_in, void* d_out, int out_size, void* d_ws, size_t ws_size, hipStream_t stream) {
    static int grid = 0;
    if (grid == 0) {
        if (n_in != 22 || (size_t)out_size != O_END || ws_size < WS_END) { fprintf(stderr, "kernel_launch: unexpected shapes (n_in %d, out %d, ws %zu; need out %zu ws %zu)\n", n_in, out_size, ws_size, (size_t)O_END, (size_t)WS_END); grid = -1; return; }
        int dev = 0, cus = 0, per_cu = 0;
        (void)hipGetDevice(&dev); (void)hipDeviceGetAttribute(&cus, hipDeviceAttributeMultiprocessorCount, dev);
        if (hipFuncSetAttribute((const void*)trunk_fwd, hipFuncAttributeMaxDynamicSharedMemorySize, LDS_BYTES) != hipSuccess) { fprintf(stderr, "kernel_launch: hipFuncSetAttribute failed\n"); grid = -1; return; }
        if (hipOccupancyMaxActiveBlocksPerMultiprocessor(&per_cu, (const void*)trunk_fwd, NTHREADS, LDS_BYTES) != hipSuccess || per_cu < 1) { fprintf(stderr, "kernel_launch: occupancy query says %d\n", per_cu); per_cu = 1; }
        (void)hipGetLastError();
        grid = cus * 1;
        if (grid <= 0) grid = 256;
    }
    if (grid < 0) return;
    Args a{};
    for (int i = 0; i < 22; ++i) a.in[i] = (const float*)d_in[i];
    a.out = (float*)d_out; a.ws = (unsigned char*)d_ws; a.ph_lo = 0; a.ph_hi = N_PHASES;
    void* args[] = {&a};
    hipError_t e = hipLaunchCooperativeKernel((const void*)trunk_fwd, dim3(grid), dim3(NTHREADS), args, LDS_BYTES, stream);
    if (e != hipSuccess) fprintf(stderr, "kernel_launch: cooperative launch failed: %s (grid %d)\n", hipGetErrorString(e), grid);
}
```

```cpp
#include <hip/hip_runtime.h>
#include <hip/hip_cooperative_groups.h>
#include <cstdio>
#include <cstdint>
namespace cg = cooperative_groups;

#define LAS __attribute__((address_space(3)))
typedef unsigned short bf16_t;
typedef short bf16x8 __attribute__((ext_vector_type(8)));
typedef float f32x4 __attribute__((ext_vector_type(4)));
typedef float f32x2 __attribute__((ext_vector_type(2)));
typedef unsigned u32x4 __attribute__((ext_vector_type(4)));
typedef unsigned u32x2 __attribute__((ext_vector_type(2)));

constexpr int D = 1024, SEQ = 2048, MP = 16384, MS = 1024, M = MP + MS, DFF = 2816, NBATCH = 8, DECB = 128, DECS = 8;
constexpr float EPS = 1e-6f;
constexpr int NWAVES = 8, NTHREADS = 512;

constexpr size_t MiB = 1u << 20;
constexpr size_t WS_SS = 0;
constexpr size_t WS_VSS = WS_SS + (size_t)9 * M * 4;
constexpr size_t WS_BAR = 768 * 1024, BAR_BYTES = 16384;
constexpr size_t WS_W = 1 * MiB;
static_assert(WS_VSS + (size_t)M * 4 <= WS_BAR, "SS below the barrier words");
constexpr size_t SZ_AIN = (size_t)3072 * 1024 * 2, SZ_SQ = (size_t)1024 * 1024 * 2, SZ_BIN = (size_t)2048 * 1024 * 2, SZ_CG = (size_t)4 * 256 * 256 * 2;
constexpr size_t SZ_UP = (size_t)5632 * 1024 * 2, SZ_DN = (size_t)1024 * 2816 * 2;
constexpr size_t WS_AIN = WS_W, WS_AOUT = WS_AIN + 2 * SZ_AIN, WS_BIN = WS_AOUT + 2 * SZ_SQ, WS_BOUT = WS_BIN + SZ_BIN, WS_CG = WS_BOUT + SZ_SQ;
constexpr size_t WS_UP = WS_CG + SZ_CG, WS_DN = WS_UP + 4 * SZ_UP, WS_WEND = WS_DN + 4 * SZ_DN;
constexpr size_t WS_X = 90 * MiB;
constexpr size_t WS_XB = WS_X + (size_t)M * D * 4;
constexpr size_t WS_T1 = WS_XB + (size_t)M * D * 2;
constexpr size_t WS_T2 = WS_T1 + (size_t)M * D * 2, WS_T3 = WS_T2 + (size_t)M * D * 2;
constexpr size_t WS_MB = WS_T1;
constexpr size_t WS_VS = WS_T3 + (size_t)M * D * 2;
constexpr size_t WS_FXP = WS_VS + (size_t)MS * D * 4;
constexpr size_t SZ_FX = (size_t)256 * 2 * DFF * 4;
constexpr size_t WS_FXA = WS_FXP + SZ_FX, WS_GL = WS_FXA + SZ_FX, WS_END = WS_GL + SZ_FX;
static_assert(WS_WEND <= WS_X, "weights fit");
static_assert(WS_T1 + (size_t)M * DFF * 2 <= WS_VS, "MB overlays T1..T3");

constexpr size_t O_YP = 0, O_YS = O_YP + (size_t)MP * D, O_SCP = O_YS + (size_t)MS * D, O_SCS = O_SCP + 2 * 8 * 2 * 1024, O_PP = O_SCS + 2 * 128 * 2 * 1024;
constexpr size_t O_PS = O_PP + 8 * 15 * 1024, O_FP = O_PS + 128 * 15 * 1024, O_FS = O_FP + 4 * 8 * 2 * DFF, O_CV = O_FS + 4 * 128 * 2 * DFF, O_END = O_CV + 128 * 8 * 1024;

__device__ __forceinline__ unsigned cvt_pk_bf16(float lo, float hi) { unsigned r; asm volatile("v_cvt_pk_bf16_f32 %0, %1, %2" : "=v"(r) : "v"(lo), "v"(hi)); return r; }
__device__ __forceinline__ float bf_lo(unsigned w) { return __uint_as_float(w << 16); }
__device__ __forceinline__ float bf_hi(unsigned w) { return __uint_as_float(w & 0xffff0000u); }
__device__ __forceinline__ float rstd_of(float ss) { return rsqrtf(ss * (1.0f / 1024.0f) + EPS); }
__device__ __forceinline__ float silu_f(float x) { return x * __builtin_amdgcn_rcpf(1.0f + __builtin_amdgcn_exp2f(-1.4426950408889634f * x)); }
__device__ __forceinline__ void atomic_addf(float* p, float v) { (void)__hip_atomic_fetch_add(p, v, __ATOMIC_RELAXED, __HIP_MEMORY_SCOPE_AGENT); }
__device__ __forceinline__ float wave_sum(float v) {
#pragma unroll
    for (int o = 1; o < 64; o <<= 1) v += __shfl_xor(v, o);
    return v;
}

namespace pg8 {
constexpr int BM = 256, BK = 64, HALF = 128, HTB = HALF * BK * 2, STAGE_BYTES = 8 * HTB, NXCD = 8, WGM = 8;
__host__ __device__ __forceinline__ int lds_byte(int r, int c) { const int st = (r >> 4) * 2 + (c >> 5), rr = r & 15, cc = c & 31, ob = rr * 64 + cc * 2; return st * 1024 + (ob ^ (((ob >> 9) & 1) << 5)); }
__host__ __device__ __forceinline__ void stage_rc(int b, int& R, int& C) { const int st = b / 1024, sb = b % 1024, swz = sb ^ (((sb >> 9) & 1) << 5); R = (st >> 1) * 16 + swz / 64; C = (st & 1) * 32 + (swz % 64) / 2; }
__host__ __device__ __forceinline__ int perm32(int rho) { const int n = rho >> 4, i = rho & 15; return 8 * (i >> 2) + 4 * n + (i & 3); }

struct Unit { int pm, pn; };
struct Gemm { const bf16_t* A; const bf16_t* Bt; int lda, ldb, K, nM, nN, a_pn_off; };

struct StaticOrder {
    int nM, nN, nwg, G, c;
    __device__ void init(int nM_, int nN_, int G_, int c_) { nM = nM_; nN = nN_; nwg = nM * nN; G = G_; c = c_; }
    __device__ bool next(int i, Unit& u) const {
        const long L = (long)i * G + c; if (L >= nwg) return false;
        int wgid = (int)L; { const int q = nwg / NXCD, r = nwg % NXCD, xcd = wgid % NXCD, off = wgid / NXCD; wgid = (xcd < r ? xcd * (q + 1) : r * (q + 1) + (xcd - r) * q) + off; }
        const int nig = WGM * nN, gid = wgid / nig, fm = gid * WGM, gsz = (nM - fm) < WGM ? (nM - fm) : WGM;
        u.pm = fm + ((wgid % nig) % gsz); u.pn = (wgid % nig) / gsz; return true;
    }
};

template <class Epi>
__device__ __forceinline__ void gemm_phase(LAS unsigned char* lds, const Gemm g, const StaticOrder& S, const Epi& E) {
    int tid = threadIdx.x; asm volatile("" : "+v"(tid)); const int wid = __builtin_amdgcn_readfirstlane(tid >> 6), lane = tid & 63, wr = wid >> 2, wc = wid & 3, fr = lane & 15, fq = lane >> 4;
    const int K = g.K, nt = K / BK;
    unsigned voffA[2], voffB[2];
#pragma unroll
    for (int i = 0; i < 2; ++i) { int R, C; stage_rc(tid * 16 + i * 8192, R, C); const int Rb = (R & ~31) + perm32(R & 31);
        voffA[i] = (unsigned)(R * g.lda + C) * 2u; voffB[i] = (unsigned)(Rb * g.ldb + C) * 2u; }
    const unsigned kstep = (unsigned)(BK * 2);
    const unsigned hstepA = (unsigned)HALF * g.lda * 2, hstepB = (unsigned)HALF * g.ldb * 2;
    const unsigned tstepA = 2 * hstepA, tstepB = 2 * hstepB;
    const unsigned ldsw = (unsigned)wid * 1024u;
    const int aoff = lds_byte(wr * 64 + fr, fq * 8), boff = lds_byte(wc * 32 + fr, fq * 8);
#define PG8_SA(b, h) (((b) * 2 + (h)) * HTB)
#define PG8_SB(b, h) ((4 + (b) * 2 + (h)) * HTB)
#define PG8_STAGE(bufoff, gbase, voff) do { _Pragma("unroll") for (int _i = 0; _i < 2; ++_i) \
        __builtin_amdgcn_global_load_lds((const unsigned*)((const char*)(gbase) + (voff)[_i]), (LAS unsigned*)(lds + (bufoff) + ldsw + _i * 8192), 16, 0, 0); } while (0)
#define PG8_LDA(dst, b, h) do { _Pragma("unroll") for (int m = 0; m < 4; ++m) _Pragma("unroll") for (int k = 0; k < 2; ++k) dst[m][k] = *(const LAS bf16x8*)(lds + PG8_SA(b, h) + aoff + m * 2048 + k * 1024); } while (0)
#define PG8_LDB(dst, b, h) do { _Pragma("unroll") for (int n = 0; n < 2; ++n) _Pragma("unroll") for (int k = 0; k < 2; ++k) dst[n][k] = *(const LAS bf16x8*)(lds + PG8_SB(b, h) + boff + n * 2048 + k * 1024); } while (0)
#define PG8_MMA(ai, bj, At, Bt) do { __builtin_amdgcn_s_setprio(1); _Pragma("unroll") for (int m = 0; m < 4; ++m) _Pragma("unroll") for (int n = 0; n < 2; ++n) _Pragma("unroll") for (int k = 0; k < 2; ++k) \
        acc[ai][bj][m][n] = __builtin_amdgcn_mfma_f32_16x16x32_bf16(Bt[n][k], At[m][k], acc[ai][bj][m][n], 0, 0, 0); __builtin_amdgcn_s_setprio(0); } while (0)
#define PG8_WAIT_V(n) asm volatile("s_waitcnt vmcnt(" #n ")" ::: "memory")
#define PG8_WAIT_L(n) asm volatile("s_waitcnt lgkmcnt(" #n ")" ::: "memory")
#define PG8_BAR __builtin_amdgcn_s_barrier()
#define PG8_SCHED __builtin_amdgcn_sched_barrier(0)
    Unit cur, nxt; int ui = 0;
    if (!S.next(0, cur)) return;
    f32x4 acc[2][2][4][2];
#pragma unroll
    for (int a = 0; a < 2; ++a)
#pragma unroll
        for (int b = 0; b < 2; ++b)
#pragma unroll
            for (int m = 0; m < 4; ++m)
#pragma unroll
                for (int n = 0; n < 2; ++n) acc[a][b][m][n] = (f32x4){0.f, 0.f, 0.f, 0.f};
    bf16x8 At[4][2], B0[2][2], B1[2][2];
    const char* cA = (const char*)g.A + (size_t)cur.pm * tstepA + (size_t)cur.pn * g.a_pn_off * 2; const char* cB = (const char*)g.Bt + (size_t)cur.pn * tstepB;
    PG8_STAGE(PG8_SB(0, 0), cB, voffB); PG8_STAGE(PG8_SB(0, 1), cB + hstepB, voffB); PG8_STAGE(PG8_SA(0, 0), cA, voffA); PG8_STAGE(PG8_SA(0, 1), cA + hstepA, voffA);
    if (wr == 1) PG8_BAR;
    PG8_WAIT_V(2); PG8_BAR;
    PG8_STAGE(PG8_SB(1, 0), cB + kstep, voffB); PG8_STAGE(PG8_SA(1, 0), cA + kstep, voffA); PG8_STAGE(PG8_SB(1, 1), cB + hstepB + kstep, voffB);
    PG8_WAIT_V(6); PG8_BAR;
    for (;;) {
        const bool has_next = S.next(ui + 1, nxt);
        const char* nA = has_next ? (const char*)g.A + (size_t)nxt.pm * tstepA + (size_t)nxt.pn * g.a_pn_off * 2 : cA; const char* nB = has_next ? (const char*)g.Bt + (size_t)nxt.pn * tstepB : cB;
        for (int t = 0; t < nt; t += 2) {
            const bool last = (t == nt - 2);
            const char* a1 = cA + (unsigned)(t + 1) * kstep;
            const char* a2 = last ? nA : cA + (unsigned)(t + 2) * kstep; const char* b2 = last ? nB : cB + (unsigned)(t + 2) * kstep;
            const char* a3 = a2 + kstep; const char* b3 = b2 + kstep;
            PG8_LDB(B0, 0, 0); PG8_LDB(B1, 0, 1); PG8_SCHED; PG8_LDA(At, 0, 0); PG8_STAGE(PG8_SA(1, 1), a1 + hstepA, voffA);
            PG8_WAIT_V(8); PG8_WAIT_L(0); PG8_BAR; PG8_MMA(0, 0, At, B0); PG8_MMA(0, 1, At, B1); PG8_BAR; PG8_SCHED;
            PG8_LDA(At, 0, 1); PG8_STAGE(PG8_SB(0, 0), b2, voffB); PG8_STAGE(PG8_SB(0, 1), b2 + hstepB, voffB); PG8_STAGE(PG8_SA(0, 0), a2, voffA);
            PG8_WAIT_V(8); PG8_WAIT_L(0); PG8_BAR; PG8_MMA(1, 0, At, B0); PG8_MMA(1, 1, At, B1); PG8_BAR; PG8_SCHED;
            PG8_LDB(B0, 1, 0); PG8_LDB(B1, 1, 1); PG8_SCHED; PG8_LDA(At, 1, 0); PG8_STAGE(PG8_SA(0, 1), a2 + hstepA, voffA);
            PG8_WAIT_V(8); PG8_WAIT_L(0); PG8_BAR; PG8_MMA(0, 0, At, B0); PG8_MMA(0, 1, At, B1); PG8_BAR; PG8_SCHED;
            PG8_LDA(At, 1, 1); PG8_STAGE(PG8_SB(1, 0), b3, voffB); PG8_STAGE(PG8_SB(1, 1), b3 + hstepB, voffB); PG8_STAGE(PG8_SA(1, 0), a3, voffA);
            PG8_WAIT_V(8); PG8_WAIT_L(0); PG8_BAR; PG8_MMA(1, 0, At, B0); PG8_MMA(1, 1, At, B1); PG8_BAR; PG8_SCHED;
        }
        if (wr == 0) PG8_BAR;
        E(acc, cur, wr, wc, fr, fq);
        if (!has_next) break;
#pragma unroll
        for (int a = 0; a < 2; ++a)
#pragma unroll
            for (int b = 0; b < 2; ++b)
#pragma unroll
                for (int m = 0; m < 4; ++m)
#pragma unroll
                    for (int n = 0; n < 2; ++n) acc[a][b][m][n] = (f32x4){0.f, 0.f, 0.f, 0.f};
        cur = nxt; cA = nA; cB = nB; ++ui;
        if (wr == 1) PG8_BAR;
    }
    PG8_WAIT_V(0);
    PG8_BAR;
#undef PG8_SA
#undef PG8_SB
#undef PG8_STAGE
#undef PG8_LDA
#undef PG8_LDB
#undef PG8_MMA
#undef PG8_WAIT_V
#undef PG8_WAIT_L
#undef PG8_BAR
#undef PG8_SCHED
}
}

typedef f32x4 AccT[2][2][4][2];
__device__ __forceinline__ void store_bf16x8(bf16_t* p, f32x4 v0, f32x4 v1) {
    u32x4 w; w.x = cvt_pk_bf16(v0[0], v0[1]); w.y = cvt_pk_bf16(v0[2], v0[3]); w.z = cvt_pk_bf16(v1[0], v1[1]); w.w = cvt_pk_bf16(v1[2], v1[3]); *(u32x4*)p = w;
}

struct EpiRes {
    const float* xin_p; const float* xin_s; float* xout; bf16_t* xb; float* ssn; const float* cs;
    __device__ __forceinline__ void operator()(const AccT& acc, const pg8::Unit& u, int wr, int wc, int fr, int fq) const {
        const int colb = u.pn * 256 + wc * 32 + 8 * fq;
        f32x4 c[2][2];
#pragma unroll
        for (int bj = 0; bj < 2; ++bj)
#pragma unroll
            for (int n = 0; n < 2; ++n) c[bj][n] = cs ? *(const f32x4*)(cs + colb + 128 * bj + 4 * n) : (f32x4){1.f, 1.f, 1.f, 1.f};
#pragma unroll
        for (int ai = 0; ai < 2; ++ai)
#pragma unroll
            for (int m = 0; m < 4; ++m) {
                const int row = u.pm * 256 + ai * 128 + wr * 64 + m * 16 + fr;
                const float* xi = (u.pm < 64) ? xin_p + (size_t)row * D : xin_s + (size_t)(row - MP) * D;
                float* xo = xout + (size_t)row * D; bf16_t* xbo = xb + (size_t)row * D;
                float s = 0.f;
#pragma unroll
                for (int bj = 0; bj < 2; ++bj) {
                    const int col = colb + 128 * bj;
                    const f32x4 o0 = *(const f32x4*)(xi + col) + acc[ai][bj][m][0] * c[bj][0], o1 = *(const f32x4*)(xi + col + 4) + acc[ai][bj][m][1] * c[bj][1];
                    *(f32x4*)(xo + col) = o0; *(f32x4*)(xo + col + 4) = o1; store_bf16x8(xbo + col, o0, o1);
                    s += (o0[0] * o0[0] + o0[1] * o0[1]) + (o0[2] * o0[2] + o0[3] * o0[3]) + (o1[0] * o1[0] + o1[1] * o1[1]) + (o1[2] * o1[2] + o1[3] * o1[3]);
                }
                s += __shfl_xor(s, 16); s += __shfl_xor(s, 32);
                if (fq == 0) atomic_addf(ssn + row, s);
            }
    }
};
struct EpiAin {
    const float* ss; bf16_t* BG; bf16_t* CV; float* st_p; float* st_s;
    __device__ __forceinline__ void operator()(const AccT& acc, const pg8::Unit& u, int wr, int wc, int fr, int fq) const {
#pragma unroll
        for (int ai = 0; ai < 2; ++ai)
#pragma unroll
            for (int m = 0; m < 4; ++m) {
                const int row = u.pm * 256 + ai * 128 + wr * 64 + m * 16 + fr;
                const float r = rstd_of(ss[row]);
                if (u.pn < 4) {
#pragma unroll
                    for (int bj = 0; bj < 2; ++bj) store_bf16x8(BG + (size_t)row * D + u.pn * 256 + 128 * bj + wc * 32 + 8 * fq, acc[ai][bj][m][0] * r, acc[ai][bj][m][1] * r);
                } else {
                    const int ch = (u.pn - 4) * 128 + wc * 32 + 8 * fq; const float r2 = r * r;
                    const f32x4 c0 = acc[ai][0][m][0] * acc[ai][1][m][0] * r2, c1 = acc[ai][0][m][1] * acc[ai][1][m][1] * r2;
                    store_bf16x8(CV + (size_t)row * D + ch, c0, c1);
                    if (u.pm < 64) { const int t = row & (SEQ - 1); if (t >= SEQ - 2) { float* o = st_p + ((size_t)(row >> 11) * 2 + (t - (SEQ - 2))) * D + ch; *(f32x4*)o = c0; *(f32x4*)(o + 4) = c1; } }
                    else { const int rr = row - MP, t = rr & 7; if (t >= 6) { float* o = st_s + ((size_t)(rr >> 3) * 2 + (t - 6)) * D + ch; *(f32x4*)o = c0; *(f32x4*)(o + 4) = c1; } }
                }
            }
    }
};
struct EpiBin {
    const float* ss; bf16_t* U; bf16_t* VT; float* VS; float* vss;
    __device__ __forceinline__ void operator()(const AccT& acc, const pg8::Unit& u, int wr, int wc, int fr, int fq) const {
#pragma unroll
        for (int ai = 0; ai < 2; ++ai)
#pragma unroll
            for (int m = 0; m < 4; ++m) {
                const int row = u.pm * 256 + ai * 128 + wr * 64 + m * 16 + fr;
                const float r = rstd_of(ss[row]);
                if (u.pn < 4) {
#pragma unroll
                    for (int bj = 0; bj < 2; ++bj) store_bf16x8(U + (size_t)row * D + u.pn * 256 + 128 * bj + wc * 32 + 8 * fq, acc[ai][bj][m][0] * r, acc[ai][bj][m][1] * r);
                } else {
                    float s = 0.f;
#pragma unroll
                    for (int bj = 0; bj < 2; ++bj) {
                        const int ch = (u.pn - 4) * 256 + 128 * bj + wc * 32 + 8 * fq;
                        const f32x4 v0 = acc[ai][bj][m][0] * r, v1 = acc[ai][bj][m][1] * r;
                        s += (v0[0] * v0[0] + v0[1] * v0[1]) + (v0[2] * v0[2] + v0[3] * v0[3]) + (v1[0] * v1[0] + v1[1] * v1[1]) + (v1[2] * v1[2] + v1[3] * v1[3]);
                        if (u.pm < 64) {
                            const unsigned w0 = cvt_pk_bf16(v0[0], v0[1]), w1 = cvt_pk_bf16(v0[2], v0[3]), w2 = cvt_pk_bf16(v1[0], v1[1]), w3 = cvt_pk_bf16(v1[2], v1[3]);
                            bf16_t* o = VT + (size_t)ch * MP + row;
                            o[0] = (bf16_t)w0; o[(size_t)MP] = (bf16_t)(w0 >> 16); o[(size_t)2 * MP] = (bf16_t)w1; o[(size_t)3 * MP] = (bf16_t)(w1 >> 16);
                            o[(size_t)4 * MP] = (bf16_t)w2; o[(size_t)5 * MP] = (bf16_t)(w2 >> 16); o[(size_t)6 * MP] = (bf16_t)w3; o[(size_t)7 * MP] = (bf16_t)(w3 >> 16);
                        } else { float* o = VS + (size_t)(row - MP) * D + ch; *(f32x4*)o = v0; *(f32x4*)(o + 4) = v1; }
                    }
                    s += __shfl_xor(s, 16); s += __shfl_xor(s, 32);
                    if (fq == 0) atomic_addf(vss + row, s);
                }
            }
    }
};
struct EpiUp {
    const float* ss; bf16_t* MB; const float* cw; const float* cb; const float* st_in; float* fxp; float* fxa; float* gl; float* st_p; float* st_s;
    __device__ __forceinline__ void operator()(const AccT& acc, const pg8::Unit& u, int wr, int wc, int fr, int fq) const {
        const int lane = threadIdx.x & 63;
        const int src1 = (lane & 48) | ((fr - 1) & 15), src2 = (lane & 48) | ((fr - 2) & 15);
        const bool prompt = u.pm < 64;
#pragma unroll
        for (int n = 0; n < 2; ++n) {
            const int ch = u.pn * 128 + wc * 32 + 8 * fq + 4 * n;
            const f32x4 w0 = *(const f32x4*)(cw + ch), w1 = *(const f32x4*)(cw + DFF + ch), w2 = *(const f32x4*)(cw + 2 * DFF + ch), bb = *(const f32x4*)(cb + ch);
#pragma unroll
            for (int ai = 0; ai < 2; ++ai) {
                const int G = u.pm * 4 + ai * 2 + wr;
                f32x4 p1 = (f32x4){0.f, 0.f, 0.f, 0.f}, p2 = p1;
#pragma unroll
                for (int m = 0; m < 4; ++m) {
                    const int row = u.pm * 256 + ai * 128 + wr * 64 + m * 16 + fr;
                    const float r = rstd_of(ss[row]);
                    const f32x4 gg = acc[ai][0][m][n] * r, aa = acc[ai][1][m][n] * r;
                    f32x4 q1, q2, pv1, pv2;
#pragma unroll
                    for (int j = 0; j < 4; ++j) { q1[j] = __shfl(gg[j], src1); q2[j] = __shfl(gg[j], src2); }
                    if (prompt) { pv1 = (fr >= 1) ? q1 : p1; pv2 = (fr >= 2) ? q2 : p2; }
                    else {
                        const int rr = row - MP, t = rr & 7; const float* sp = st_in + (size_t)(rr >> 3) * 2 * DFF + ch;
                        pv1 = q1; pv2 = q2;
                        if (t == 0) { pv1 = *(const f32x4*)(sp + DFF); pv2 = *(const f32x4*)(sp); }
                        if (t == 1) { pv2 = *(const f32x4*)(sp + DFF); }
                    }
                    const f32x4 pre = w2 * gg + w1 * pv1 + w0 * pv2 + bb;
                    u32x2 o; o.x = cvt_pk_bf16(silu_f(pre[0]) * aa[0], silu_f(pre[1]) * aa[1]); o.y = cvt_pk_bf16(silu_f(pre[2]) * aa[2], silu_f(pre[3]) * aa[3]);
                    *(u32x2*)(MB + (size_t)row * DFF + ch) = o;
                    if (prompt) {
                        if (m == 0 && fr < 2 && (G & 31) != 0) { *(f32x4*)(fxp + ((size_t)G * 2 + fr) * DFF + ch) = pre; *(f32x4*)(fxa + ((size_t)G * 2 + fr) * DFF + ch) = aa; }
                        if (m == 3 && fr >= 14) {
                            *(f32x4*)(gl + ((size_t)G * 2 + (fr - 14)) * DFF + ch) = gg;
                            if ((G & 31) == 31) *(f32x4*)(st_p + ((size_t)(G >> 5) * 2 + (fr - 14)) * DFF + ch) = gg;
                        }
                    } else {
                        const int rr = row - MP, t = rr & 7;
                        if (t >= 6) *(f32x4*)(st_s + ((size_t)(rr >> 3) * 2 + (t - 6)) * DFF + ch) = gg;
                    }
                    p1 = q1; p2 = q2;
                }
            }
        }
    }
};

struct Args { const float* in[22]; float* out; unsigned char* ws; int ph_lo, ph_hi; };
__device__ __forceinline__ const float* ldp(const Args& a, int i) { asm volatile("" : "+s"(i)); return a.in[i]; }
__device__ __forceinline__ unsigned char* ws_of(const Args& a) { unsigned char* p = a.ws; asm volatile("" : "+s"(p)); return p; }
__device__ __forceinline__ float* out_of(const Args& a) { float* p = a.out; asm volatile("" : "+s"(p)); return p; }
__device__ __forceinline__ int tid_l() { int t = threadIdx.x; asm volatile("" : "+v"(t)); return t; }
enum { I_XP = 0, I_XS, I_SSC, I_SPOOL, I_SFFN, I_GMIX, I_GFFN, I_GFIN, I_AWIN, I_ACONV, I_AWOUT, I_BWIN, I_BGV, I_BWS, I_BBIAS, I_BWOUT, I_CWG, I_CSCALE, I_FWUP, I_FCONV, I_FCONVB, I_FWDN };

template <int MAP> __device__ __forceinline__ int colmap(int n0) {
    if (MAP == 1) { if (n0 < 1024) return n0; const int q = n0 - 1024, p = q >> 8, jj = q & 255; return jj < 128 ? 1024 + 128 * p + jj : 2048 + 128 * p + (jj - 128); }
    if (MAP == 2) { const int p = n0 >> 8, jj = n0 & 255; return jj < 128 ? 128 * p + jj : DFF + 128 * p + (jj - 128); }
    return n0;
}
template <int MAP>
__device__ __forceinline__ void prep_matrix(const float* W, int K, int N, bf16_t* WT, const float* gs, LAS float* scr, int lane, int gw, int NGW, int& base) {
    const int nblk = N / 32, nitems = (K / 64) * nblk;
    int first = gw - (base % NGW); if (first < 0) first += NGW;
    for (int item = first; item < nitems; item += NGW) {
        const int kb = item / nblk, nb = item % nblk, k0 = 64 * kb, n0 = 32 * nb, sc = colmap<MAP>(n0);
#pragma unroll 8
        for (int i = 0; i < 32; ++i) { const int kk = 2 * i + (lane >> 5); float v = W[(size_t)(k0 + kk) * N + sc + (lane & 31)]; if (gs) v *= gs[k0 + kk]; scr[kk * 33 + (lane & 31)] = v; }
        asm volatile("s_waitcnt lgkmcnt(0)" ::: "memory");
        const int c = lane & 7;
#pragma unroll
        for (int j = 0; j < 4; ++j) { const int n = (lane >> 3) + 8 * j; const LAS float* s = scr + (8 * c) * 33 + n;
            u32x4 o; o.x = cvt_pk_bf16(s[0 * 33], s[1 * 33]); o.y = cvt_pk_bf16(s[2 * 33], s[3 * 33]); o.z = cvt_pk_bf16(s[4 * 33], s[5 * 33]); o.w = cvt_pk_bf16(s[6 * 33], s[7 * 33]);
            *(u32x4*)(WT + (size_t)(n0 + n) * K + k0 + 8 * c) = o; }
        asm volatile("s_waitcnt lgkmcnt(0)" ::: "memory");
    }
    base += nitems;
}

__device__ __forceinline__ void prep_phase(const Args& a, LAS unsigned char* lds) {
    unsigned char* const wsl = ws_of(a); float* const outl = out_of(a); const int tidl = tid_l();
    const int tid = tidl, lane = tid & 63, wave = tid >> 6;
    const int gw = blockIdx.x * NWAVES + wave, NGW = gridDim.x * NWAVES;
    LAS float* scr = (LAS float*)(lds + wave * 16384);
    unsigned char* ws = wsl;
    { float* z = (float*)(ws + WS_SS) + M; const int nz = 9 * M; for (int i = blockIdx.x * NTHREADS + tid; i < nz; i += gridDim.x * NTHREADS) z[i] = 0.f; }
    { float* ss0 = (float*)(ws + WS_SS); bf16_t* xb = (bf16_t*)(ws + WS_XB);
      for (int row = gw; row < M; row += NGW) {
          const float* xr = row < MP ? ldp(a, I_XP) + (size_t)row * D : ldp(a, I_XS) + (size_t)(row - MP) * D;
          float s = 0.f;
#pragma unroll
          for (int j = 0; j < 2; ++j) { const f32x4 v0 = *(const f32x4*)(xr + j * 512 + lane * 8), v1 = *(const f32x4*)(xr + j * 512 + lane * 8 + 4);
              s += (v0[0] * v0[0] + v0[1] * v0[1]) + (v0[2] * v0[2] + v0[3] * v0[3]) + (v1[0] * v1[0] + v1[1] * v1[1]) + (v1[2] * v1[2] + v1[3] * v1[3]);
              store_bf16x8(xb + (size_t)row * D + j * 512 + lane * 8, v0, v1); }
          s = wave_sum(s); if (lane == 0) ss0[row] = s; } }
    int base = 0;
    for (int j = 0; j < 2; ++j) {
        prep_matrix<1>(ldp(a, I_AWIN) + (size_t)j * 1024 * 3072, 1024, 3072, (bf16_t*)(ws + WS_AIN + j * SZ_AIN), ldp(a, I_GMIX) + (size_t)(3 * j) * D, scr, lane, gw, NGW, base);
        prep_matrix<0>(ldp(a, I_AWOUT) + (size_t)j * 1024 * 1024, 1024, 1024, (bf16_t*)(ws + WS_AOUT + j * SZ_SQ), nullptr, scr, lane, gw, NGW, base);
    }
    prep_matrix<0>(ldp(a, I_BWIN), 1024, 2048, (bf16_t*)(ws + WS_BIN), ldp(a, I_GMIX) + (size_t)1 * D, scr, lane, gw, NGW, base);
    prep_matrix<0>(ldp(a, I_BWOUT), 1024, 1024, (bf16_t*)(ws + WS_BOUT), nullptr, scr, lane, gw, NGW, base);
    for (int g = 0; g < 4; ++g) prep_matrix<0>(ldp(a, I_CWG) + (size_t)g * 65536, 256, 256, (bf16_t*)(ws + WS_CG) + (size_t)g * 65536, nullptr, scr, lane, gw, NGW, base);
    for (int i = 0; i < 4; ++i) {
        prep_matrix<2>(ldp(a, I_FWUP) + (size_t)i * 1024 * 5632, 1024, 5632, (bf16_t*)(ws + WS_UP + i * SZ_UP), ldp(a, I_GFFN) + (size_t)i * D, scr, lane, gw, NGW, base);
        prep_matrix<0>(ldp(a, I_FWDN) + (size_t)i * 2816 * 1024, 2816, 1024, (bf16_t*)(ws + WS_DN + i * SZ_DN), nullptr, scr, lane, gw, NGW, base);
    }
}

__device__ __forceinline__ void aconv_phase(const Args& a, int j) {
    unsigned char* const wsl = ws_of(a); float* const outl = out_of(a); const int tidl = tid_l();
    const bf16_t* BG = (const bf16_t*)(wsl + WS_T1); const bf16_t* CV = (const bf16_t*)(wsl + WS_T2); bf16_t* ZB = (bf16_t*)(wsl + WS_T3);
    const float* cw = ldp(a, I_ACONV) + (size_t)j * 3 * D; const float* st = ldp(a, I_SSC) + (size_t)j * DECB * 2 * D;
    const int tid = tidl, c8 = (tid & 127) * 8, rsub = tid >> 7;
    f32x4 w[3][2];
#pragma unroll
    for (int k = 0; k < 3; ++k) { w[k][0] = *(const f32x4*)(cw + k * D + c8); w[k][1] = *(const f32x4*)(cw + k * D + c8 + 4); }
    for (int r4 = blockIdx.x; r4 < M / 4; r4 += gridDim.x) {
        const int row = r4 * 4 + rsub;
        int t; const float* sp = nullptr;
        if (row < MP) t = row & (SEQ - 1); else { const int rr = row - MP; t = rr & 7; sp = st + (size_t)(rr >> 3) * 2 * D + c8; }
        f32x4 x[3][2];
#pragma unroll
        for (int k = 0; k < 3; ++k) {
            const int tt = t - 2 + k;
            if (tt >= 0) { const u32x4 v = *(const u32x4*)(CV + (size_t)(row - 2 + k) * D + c8);
                x[k][0] = (f32x4){bf_lo(v.x), bf_hi(v.x), bf_lo(v.y), bf_hi(v.y)}; x[k][1] = (f32x4){bf_lo(v.z), bf_hi(v.z), bf_lo(v.w), bf_hi(v.w)}; }
            else if (sp) { x[k][0] = *(const f32x4*)(sp + (size_t)(2 + tt) * D); x[k][1] = *(const f32x4*)(sp + (size_t)(2 + tt) * D + 4); }
            else { x[k][0] = (f32x4){0.f, 0.f, 0.f, 0.f}; x[k][1] = x[k][0]; }
        }
        const u32x4 b = *(const u32x4*)(BG + (size_t)row * D + c8);
        const f32x4 b0 = (f32x4){bf_lo(b.x), bf_hi(b.x), bf_lo(b.y), bf_hi(b.y)}, b1 = (f32x4){bf_lo(b.z), bf_hi(b.z), bf_lo(b.w), bf_hi(b.w)};
        const f32x4 y0 = w[0][0] * x[0][0] + w[1][0] * x[1][0] + w[2][0] * x[2][0], y1 = w[0][1] * x[0][1] + w[1][1] * x[1][1] + w[2][1] * x[2][1];
        store_bf16x8(ZB + (size_t)row * D + c8, b0 * y0, b1 * y1);
    }
}

__device__ __forceinline__ void spatial_phase(const Args& a) {
    unsigned char* const wsl = ws_of(a); float* const outl = out_of(a); const int tidl = tid_l();
    const bf16_t* U = (const bf16_t*)(wsl + WS_T1); const bf16_t* VT = (const bf16_t*)(wsl + WS_T2); bf16_t* ZB = (bf16_t*)(wsl + WS_T3);
    const float* VS = (const float*)(wsl + WS_VS); const float* vss = (const float*)(wsl + WS_VSS);
    const float* Ws = ldp(a, I_BWS); const float* bias = ldp(a, I_BBIAS); const float* gv = ldp(a, I_BGV);
    const int tid = tidl, lane = tid & 63, w = tid >> 6, fr = lane & 15, fq = lane >> 4;
    for (int unit = blockIdx.x; unit < 512 + DECB; unit += gridDim.x) {
        if (unit < 512) {
            const int c = unit >> 2, h = unit & 3, rb = c * 128, t = 16 * w + fr;
            f32x4 acc[16];
#pragma unroll
            for (int i = 0; i < 16; ++i) acc[i] = (f32x4){0.f, 0.f, 0.f, 0.f};
            const int nks = (w >> 1) + 1;
            for (int ks = 0; ks < nks; ++ks) {
                const int s0 = ks * 32 + 8 * fq;
                const float* wp = Ws + ((size_t)(h * 128 + t) * 128 + s0);
                const f32x4 wa = *(const f32x4*)wp, wb = *(const f32x4*)(wp + 4);
                const f32x4 va = *(const f32x4*)(vss + rb + s0), vb = *(const f32x4*)(vss + rb + s0 + 4);
                float wv[8];
#pragma unroll
                for (int i = 0; i < 4; ++i) { wv[i] = (s0 + i <= t) ? wa[i] * rstd_of(va[i]) : 0.f; wv[4 + i] = (s0 + 4 + i <= t) ? wb[i] * rstd_of(vb[i]) : 0.f; }
                u32x4 wpk; wpk.x = cvt_pk_bf16(wv[0], wv[1]); wpk.y = cvt_pk_bf16(wv[2], wv[3]); wpk.z = cvt_pk_bf16(wv[4], wv[5]); wpk.w = cvt_pk_bf16(wv[6], wv[7]);
                const bf16x8 Wf = __builtin_bit_cast(bf16x8, wpk);
#pragma unroll
                for (int dt = 0; dt < 16; ++dt) {
                    const bf16x8 vf = *(const bf16x8*)(VT + (size_t)(h * 256 + dt * 16 + fr) * MP + rb + s0);
                    acc[dt] = __builtin_amdgcn_mfma_f32_16x16x32_bf16(vf, Wf, acc[dt], 0, 0, 0);
                }
            }
            const int row = rb + t; const float bs = bias[h * 128 + t];
#pragma unroll
            for (int dt = 0; dt < 16; ++dt) {
                const int ch = h * 256 + dt * 16 + 4 * fq;
                const f32x4 g4 = *(const f32x4*)(gv + ch);
                const u32x2 uu = *(const u32x2*)(U + (size_t)row * D + ch);
                const f32x4 u4 = (f32x4){bf_lo(uu.x), bf_hi(uu.x), bf_lo(uu.y), bf_hi(uu.y)};
                const f32x4 z = u4 * (acc[dt] * g4 + bs);
                u32x2 o; o.x = cvt_pk_bf16(z[0], z[1]); o.y = cvt_pk_bf16(z[2], z[3]);
                *(u32x2*)(ZB + (size_t)row * D + ch) = o;
            }
        } else {
            const int b = unit - 512, r0 = MP + 8 * b, ch = 2 * tid, h = ch >> 8;
            float v0[8], v1[8], rv[8];
#pragma unroll
            for (int s = 0; s < 8; ++s) { rv[s] = rstd_of(vss[r0 + s]); const f32x2 vv = *(const f32x2*)(VS + (size_t)(8 * b + s) * D + ch); v0[s] = vv.x * rv[s]; v1[s] = vv.y * rv[s]; }
            const f32x2 g2 = *(const f32x2*)(gv + ch);
            float* cvo = outl + O_CV + (size_t)(8 * b) * D + ch;
#pragma unroll
            for (int t = 0; t < 8; ++t) {
                float s0 = 0.f, s1 = 0.f;
#pragma unroll
                for (int s = 0; s <= t; ++s) { const float ww = Ws[(size_t)(h * 128 + t) * 128 + s]; s0 += ww * v0[s]; s1 += ww * v1[s]; }
                const float bs = bias[h * 128 + t];
                const unsigned uu = *(const unsigned*)(U + (size_t)(r0 + t) * D + ch);
                const float z0 = bf_lo(uu) * (s0 * g2.x + bs), z1 = bf_hi(uu) * (s1 * g2.y + bs);
                *(unsigned*)(ZB + (size_t)(r0 + t) * D + ch) = cvt_pk_bf16(z0, z1);
                *(f32x2*)(cvo + (size_t)t * D) = (f32x2){v0[t] * g2.x, v1[t] * g2.y};
            }
        }
    }
}

__device__ __forceinline__ void pool_phase(const Args& a, const float* ssk, const float* gm) {
    unsigned char* const wsl = ws_of(a); float* const outl = out_of(a); const int tidl = tid_l();
    const float* X = (const float*)(wsl + WS_X); bf16_t* DB = (bf16_t*)(wsl + WS_T1);
    const float* st = ldp(a, I_SPOOL);
    const int tid = tidl, c4 = (tid & 255) * 4, rsub = tid >> 8, win = 2 << (c4 >> 8);
    const f32x4 g4 = *(const f32x4*)(gm + c4);
    for (int r2 = blockIdx.x; r2 < M / 2; r2 += gridDim.x) {
        const int row = r2 * 2 + rsub;
        f32x4 sum = (f32x4){0.f, 0.f, 0.f, 0.f}, hcur = sum; float cnt;
        if (row < MP) {
            const int t = row & (SEQ - 1); const int n = (t + 1 < win) ? t + 1 : win; cnt = (float)n;
            for (int k = 0; k < n; ++k) { const int rr = row - k; const f32x4 hv = *(const f32x4*)(X + (size_t)rr * D + c4) * (g4 * rstd_of(ssk[rr])); if (k == 0) hcur = hv; sum += hv; }
            if (t >= SEQ - 15) *(f32x4*)(outl + O_PP + ((size_t)(row >> 11) * 15 + (t - (SEQ - 15))) * D + c4) = hcur;
        } else {
            const int rr0 = row - MP, b = rr0 >> 3, t = rr0 & 7; cnt = (float)win;
            for (int k = 0; k < win; ++k) { const int tt = t - k; f32x4 hv;
                if (tt >= 0) hv = *(const f32x4*)(X + (size_t)(row - k) * D + c4) * (g4 * rstd_of(ssk[row - k]));
                else hv = *(const f32x4*)(st + ((size_t)b * 15 + (15 + tt)) * D + c4);
                if (k == 0) hcur = hv; sum += hv; }
            float* po = outl + O_PS + (size_t)b * 15 * D + c4;
            *(f32x4*)(po + (size_t)(t + 7) * D) = hcur;
            if (t < 7) *(f32x4*)(po + (size_t)t * D) = *(const f32x4*)(st + ((size_t)b * 15 + 8 + t) * D + c4);
        }
        const f32x4 d = sum * (1.0f / cnt) - hcur;
        u32x2 o; o.x = cvt_pk_bf16(d[0], d[1]); o.y = cvt_pk_bf16(d[2], d[3]);
        *(u32x2*)(DB + (size_t)row * D + c4) = o;
    }
}

__device__ __forceinline__ void ffn_fix_phase(const Args& a, int layer) {
    unsigned char* const wsl = ws_of(a); float* const outl = out_of(a); const int tidl = tid_l();
    const float* fxp = (const float*)(wsl + WS_FXP); const float* fxa = (const float*)(wsl + WS_FXA); const float* gl = (const float*)(wsl + WS_GL);
    bf16_t* MB = (bf16_t*)(wsl + WS_MB); const float* cw = ldp(a, I_FCONV) + (size_t)layer * 3 * DFF;
    const int total = 256 * 2 * (DFF / 4);
    for (int i = blockIdx.x * NTHREADS + tidl; i < total; i += gridDim.x * NTHREADS) {
        const int c4 = (i % (DFF / 4)) * 4, gr = i / (DFF / 4), G = gr >> 1, r = gr & 1;
        if ((G & 31) == 0) continue;
        const f32x4 w0 = *(const f32x4*)(cw + c4), w1 = *(const f32x4*)(cw + DFF + c4);
        f32x4 pre = *(const f32x4*)(fxp + ((size_t)G * 2 + r) * DFF + c4);
        const f32x4 gm1 = *(const f32x4*)(gl + ((size_t)(G - 1) * 2 + 1) * DFF + c4);
        if (r == 0) { const f32x4 gm2 = *(const f32x4*)(gl + ((size_t)(G - 1) * 2 + 0) * DFF + c4); pre += w1 * gm1 + w0 * gm2; }
        else pre += w0 * gm1;
        const f32x4 av = *(const f32x4*)(fxa + ((size_t)G * 2 + r) * DFF + c4);
        u32x2 o; o.x = cvt_pk_bf16(silu_f(pre[0]) * av[0], silu_f(pre[1]) * av[1]); o.y = cvt_pk_bf16(silu_f(pre[2]) * av[2], silu_f(pre[3]) * av[3]);
        *(u32x2*)(MB + (size_t)(G * 64 + r) * DFF + c4) = o;
    }
}

__device__ __forceinline__ void final_phase(const Args& a) {
    unsigned char* const wsl = ws_of(a); float* const outl = out_of(a); const int tidl = tid_l();
    const float* X = (const float*)(wsl + WS_X); const float* ss8 = (const float*)(wsl + WS_SS) + (size_t)8 * M; const float* gf = ldp(a, I_GFIN);
    const int lane = tidl & 63, gw = blockIdx.x * NWAVES + (tidl >> 6), NGW = gridDim.x * NWAVES;
    f32x4 g[4];
#pragma unroll
    for (int j = 0; j < 4; ++j) g[j] = *(const f32x4*)(gf + j * 256 + lane * 4);
    for (int row = gw; row < M; row += NGW) {
        const float r = rstd_of(ss8[row]);
#pragma unroll
        for (int j = 0; j < 4; ++j) *(f32x4*)(outl + (size_t)row * D + j * 256 + lane * 4) = *(const f32x4*)(X + (size_t)row * D + j * 256 + lane * 4) * (g[j] * r);
    }
}


#define XB_TMO      128
#define XB_XCNT(j)  (256  + 64 * (j))
#define XB_XSUB(j)  (1280 + 64 * (j))
#define XB_XGEN(j)  (2304 + 64 * (j))
#define XB_TOP      3328
#define XB_TOPGEN   3392
#define XCD_BAR_WORDS 3456
#define XB_SPIN_CAP (1u << 22)
__device__ __forceinline__ unsigned xb_ld(unsigned* p)              { return __hip_atomic_load(p, __ATOMIC_RELAXED, __HIP_MEMORY_SCOPE_AGENT); }
__device__ __forceinline__ unsigned xb_add(unsigned* p, unsigned v) { return __hip_atomic_fetch_add(p, v, __ATOMIC_RELAXED, __HIP_MEMORY_SCOPE_AGENT); }
__device__ __forceinline__ unsigned xb_xcc_id() { return (unsigned)__builtin_amdgcn_s_getreg((3 << 11) | 20) & 0xFu; }
#define XB_SPIN(cond, bar) do { unsigned _sp = 0; while (cond) { __builtin_amdgcn_s_sleep(1); \
    if ((++_sp & 255u) == 0u) { if (xb_ld(&(bar)[XB_TMO])) break; if (_sp > XB_SPIN_CAP) { atomicAdd(&(bar)[XB_TMO], 1u); break; } } } } while (0)
struct XcdBarrier { unsigned* bar; unsigned x; volatile LAS unsigned* st; };
__device__ __forceinline__ XcdBarrier xcd_barrier_post(unsigned* bar, volatile LAS unsigned* st) {
    XcdBarrier b; b.bar = bar; b.x = xb_xcc_id(); b.st = st;
    if (threadIdx.x == 0) (void)xb_add(&bar[XB_XCNT(b.x)], 1u);
    return b;
}
__device__ __forceinline__ void xcd_barrier_complete(unsigned* bar, unsigned x, unsigned& nloc, unsigned& nx) {
    const unsigned G = gridDim.x * gridDim.y * gridDim.z;
    unsigned sum, cnt, mine, sp = 0u;
    for (;;) {
        sum = 0u; cnt = 0u; mine = 0u;
#pragma unroll
        for (unsigned j = 0; j < 16; ++j) { const unsigned c = xb_ld(&bar[XB_XCNT(j)]); sum += c; cnt += (c > 0u) ? 1u : 0u; mine = (j == x) ? c : mine; }
        if (sum == G) break;
        __builtin_amdgcn_s_sleep(1);
        if ((++sp & 255u) == 0u) { if (xb_ld(&bar[XB_TMO])) break; if (sp > XB_SPIN_CAP) { atomicAdd(&bar[XB_TMO], 1u); break; } }
    }
    nloc = mine > 0u ? mine : 1u; nx = cnt > 0u ? cnt : 1u;
}
__device__ __forceinline__ void xcd_barrier(const XcdBarrier& b) {
    asm volatile("s_waitcnt vmcnt(0)" ::: "memory");
    __syncthreads();
    if (threadIdx.x == 0) {
        unsigned* bar = b.bar;
        __builtin_amdgcn_s_waitcnt(0);
        unsigned nloc = b.st[0], nx = b.st[1];
        if (nloc == 0u) { xcd_barrier_complete(bar, b.x, nloc, nx); b.st[0] = nloc; b.st[1] = nx; }
        const unsigned old = xb_add(&bar[XB_XSUB(b.x)], 1u);
        const unsigned gen = old / nloc;
        if (old + 1u == (gen + 1u) * nloc) {
            __builtin_amdgcn_fence(__ATOMIC_RELEASE, "agent");
            asm volatile("s_waitcnt vmcnt(0)" ::: "memory");
            const unsigned og = xb_add(&bar[XB_TOP], 1u);
            const unsigned tg = og / nx;
            if (og + 1u == (tg + 1u) * nx) xb_add(&bar[XB_TOPGEN], 1u);
            else XB_SPIN(xb_ld(&bar[XB_TOPGEN]) == tg, bar);
            __builtin_amdgcn_fence(__ATOMIC_ACQUIRE, "agent");
            xb_add(&bar[XB_XGEN(b.x)], 1u);
            asm volatile("s_waitcnt vmcnt(0)" ::: "memory");
        } else {
            XB_SPIN(xb_ld(&bar[XB_XGEN(b.x)]) == gen, bar);
            __builtin_amdgcn_fence(__ATOMIC_ACQUIRE, "agent");
            asm volatile("s_waitcnt vmcnt(0)" ::: "memory");
        }
    }
    __syncthreads();
}

constexpr int LDS_BYTES = 147456;
constexpr int REP_SYNC = 1, REP_MISC = 1, REP_UP = 1, REP_IN = 1;
constexpr int N_PHASES = 25;

__global__ void __launch_bounds__(NTHREADS, 2) trunk_fwd(Args a) {
    extern __shared__ __attribute__((aligned(16))) unsigned char lds_raw[];
    LAS unsigned char* lds = (LAS unsigned char*)lds_raw;
    cg::grid_group grid = cg::this_grid();
    volatile LAS unsigned* misc = (volatile LAS unsigned*)(lds + 131072 + 512);
    if (threadIdx.x < 2) misc[threadIdx.x] = 0u;
    __syncthreads();
    const XcdBarrier xbar = xcd_barrier_post((unsigned*)(a.ws + WS_BAR), misc);
    int ph = 0;
#define GSYNC() do { if (ph == 0) grid.sync(); else xcd_barrier(xbar); } while (0)
#define PHASE_BEGIN_R(reps) if (ph >= a.ph_lo && ph < a.ph_hi) { for (int rep_ = 0; rep_ < (reps); ++rep_) { if (rep_) GSYNC(); unsigned char* const ws = ws_of(a); const int G = gridDim.x, bx = blockIdx.x; (void)ws; (void)G; (void)bx;
#define PHASE_BEGIN PHASE_BEGIN_R(1)
#define PHASE_END   } if (ph + 1 < a.ph_hi) { for (int s_ = 0; s_ < REP_SYNC; ++s_) GSYNC(); } } ++ph;
#define SSP(k) ((float*)(ws + WS_SS) + (size_t)(k) * M)
#define XP ((float*)(ws + WS_X))
#define XBP ((bf16_t*)(ws + WS_XB))
#define T1P ((bf16_t*)(ws + WS_T1))
#define T2P ((bf16_t*)(ws + WS_T2))
#define T3P ((bf16_t*)(ws + WS_T3))

    PHASE_BEGIN_R(REP_MISC) prep_phase(a, lds); PHASE_END

    for (int layer = 0; layer < 4; ++layer) {
        const int kind = layer % 3, j = layer / 3;
        if (kind == 0) {
            PHASE_BEGIN_R(REP_IN)
                pg8::Gemm g{XBP, (const bf16_t*)(ws + WS_AIN + j * SZ_AIN), D, D, D, 68, 12, 0}; pg8::StaticOrder S; S.init(68, 12, G, bx);
                EpiAin E{SSP(2 * layer), T1P, T2P, out_of(a) + O_SCP + (size_t)j * 8 * 2 * D, out_of(a) + O_SCS + (size_t)j * DECB * 2 * D};
                pg8::gemm_phase(lds, g, S, E);
            PHASE_END
            PHASE_BEGIN_R(REP_MISC) aconv_phase(a, j); PHASE_END
            PHASE_BEGIN
                pg8::Gemm g{T3P, (const bf16_t*)(ws + WS_AOUT + j * SZ_SQ), D, D, D, 68, 4, 0}; pg8::StaticOrder S; S.init(68, 4, G, bx);
                EpiRes E{layer == 0 ? ldp(a, I_XP) : XP, layer == 0 ? ldp(a, I_XS) : XP + (size_t)MP * D, XP, XBP, SSP(2 * layer + 1), nullptr};
                pg8::gemm_phase(lds, g, S, E);
            PHASE_END
        } else if (kind == 1) {
            PHASE_BEGIN
                pg8::Gemm g{XBP, (const bf16_t*)(ws + WS_BIN), D, D, D, 68, 8, 0}; pg8::StaticOrder S; S.init(68, 8, G, bx);
                EpiBin E{SSP(2 * layer), T1P, T2P, (float*)(ws + WS_VS), (float*)(ws + WS_VSS)};
                pg8::gemm_phase(lds, g, S, E);
            PHASE_END
            PHASE_BEGIN_R(REP_MISC) spatial_phase(a); PHASE_END
            PHASE_BEGIN
                pg8::Gemm g{T3P, (const bf16_t*)(ws + WS_BOUT), D, D, D, 68, 4, 0}; pg8::StaticOrder S; S.init(68, 4, G, bx);
                EpiRes E{XP, XP + (size_t)MP * D, XP, XBP, SSP(2 * layer + 1), nullptr};
                pg8::gemm_phase(lds, g, S, E);
            PHASE_END
        } else {
            PHASE_BEGIN_R(REP_MISC) pool_phase(a, SSP(2 * layer), ldp(a, I_GMIX) + (size_t)layer * D); PHASE_END
            PHASE_BEGIN
                pg8::Gemm g{T1P, (const bf16_t*)(ws + WS_CG), D, 256, 256, 68, 4, 256}; pg8::StaticOrder S; S.init(68, 4, G, bx);
                EpiRes E{XP, XP + (size_t)MP * D, XP, XBP, SSP(2 * layer + 1), ldp(a, I_CSCALE)};
                pg8::gemm_phase(lds, g, S, E);
            PHASE_END
        }
        PHASE_BEGIN_R(REP_UP)
            pg8::Gemm g{XBP, (const bf16_t*)(ws + WS_UP + layer * SZ_UP), D, D, D, 68, 22, 0}; pg8::StaticOrder S; S.init(68, 22, G, bx);
            EpiUp E{SSP(2 * layer + 1), (bf16_t*)(ws + WS_MB), ldp(a, I_FCONV) + (size_t)layer * 3 * DFF, ldp(a, I_FCONVB) + (size_t)layer * DFF, ldp(a, I_SFFN) + (size_t)layer * DECB * 2 * DFF,
                    (float*)(ws + WS_FXP), (float*)(ws + WS_FXA), (float*)(ws + WS_GL), out_of(a) + O_FP + (size_t)layer * 8 * 2 * DFF, out_of(a) + O_FS + (size_t)layer * DECB * 2 * DFF};
            pg8::gemm_phase(lds, g, S, E);
        PHASE_END
        PHASE_BEGIN_R(REP_MISC) ffn_fix_phase(a, layer); PHASE_END
        PHASE_BEGIN
            pg8::Gemm g{(const bf16_t*)(ws + WS_MB), (const bf16_t*)(ws + WS_DN + layer * SZ_DN), DFF, DFF, DFF, 68, 4, 0}; pg8::StaticOrder S; S.init(68, 4, G, bx);
            EpiRes E{XP, XP + (size_t)MP * D, XP, XBP, SSP(2 * layer + 2), nullptr};
            pg8::gemm_phase(lds, g, S, E);
        PHASE_END
    }
    PHASE_BEGIN_R(REP_MISC) final_phase(a); PHASE_END
#undef PHASE_BEGIN
#undef PHASE_BEGIN_R
#undef PHASE_END
}

extern "C" void kernel_launch(void* const* d_in, const int* in_sizes, int n_in, void* d_out, int out_size, void* d_ws, size_t ws_size, hipStream_t stream) {
    static int grid = 0;
    if (grid == 0) {
        if (n_in != 22 || (size_t)out_size != O_END || ws_size < WS_END) { fprintf(stderr, "kernel_launch: unexpected shapes (n_in %d, out %d, ws %zu; need out %zu ws %zu)\n", n_in, out_size, ws_size, (size_t)O_END, (size_t)WS_END); grid = -1; return; }
        int dev = 0, cus = 0, per_cu = 0;
        (void)hipGetDevice(&dev); (void)hipDeviceGetAttribute(&cus, hipDeviceAttributeMultiprocessorCount, dev);
        if (hipFuncSetAttribute((const void*)trunk_fwd, hipFuncAttributeMaxDynamicSharedMemorySize, LDS_BYTES) != hipSuccess) { fprintf(stderr, "kernel_launch: hipFuncSetAttribute failed\n"); grid = -1; return; }
        if (hipOccupancyMaxActiveBlocksPerMultiprocessor(&per_cu, (const void*)trunk_fwd, NTHREADS, LDS_BYTES) != hipSuccess || per_cu < 1) { fprintf(stderr, "kernel_launch: occupancy query says %d\n", per_cu); per_cu = 1; }
        (void)hipGetLastError();
        grid = cus * 1;
        if (grid <= 0) grid = 256;
    }
    if (grid < 0) return;
    Args a{};
    for (int i = 0; i < 22; ++i) a.in[i] = (const float*)d_in[i];
    a.out = (float*)d_out; a.ws = (unsigned char*)d_ws; a.ph_lo = 0; a.ph_hi = N_PHASES;
    if (hipMemsetAsync((char*)d_ws + WS_BAR, 0, BAR_BYTES, stream) != hipSuccess) { fprintf(stderr, "kernel_launch: memset failed\n"); return; }
    void* args[] = {&a};
    hipError_t e = hipLaunchCooperativeKernel((const void*)trunk_fwd, dim3(grid), dim3(NTHREADS), args, LDS_BYTES, stream);
    if (e != hipSuccess) fprintf(stderr, "kernel_launch: cooperative launch failed: %s (grid %d)\n", hipGetErrorString(e), grid);
}
```

```cpp
#include <hip/hip_runtime.h>
#include <hip/hip_cooperative_groups.h>
#include <cstdio>
#include <cstdint>
namespace cg = cooperative_groups;

#define LAS __attribute__((address_space(3)))
typedef unsigned short bf16_t;
typedef short bf16x8 __attribute__((ext_vector_type(8)));
typedef float f32x4 __attribute__((ext_vector_type(4)));
typedef float f32x2 __attribute__((ext_vector_type(2)));
typedef unsigned u32x4 __attribute__((ext_vector_type(4)));
typedef unsigned u32x2 __attribute__((ext_vector_type(2)));

constexpr int D = 1024, SEQ = 2048, MP = 16384, MS = 1024, M = MP + MS, DFF = 2816, NBATCH = 8, DECB = 128, DECS = 8;
constexpr float EPS = 1e-6f;
constexpr int NWAVES = 8, NTHREADS = 512;

constexpr size_t MiB = 1u << 20;
constexpr size_t WS_SS = 0;
constexpr size_t WS_VSS = WS_SS + (size_t)9 * M * 4;
constexpr size_t WS_BAR = 768 * 1024, BAR_BYTES = 16384;
constexpr size_t WS_W = 1 * MiB;
static_assert(WS_VSS + (size_t)M * 4 <= WS_BAR, "SS below the barrier words");
constexpr size_t SZ_AIN = (size_t)3072 * 1024 * 2, SZ_SQ = (size_t)1024 * 1024 * 2, SZ_BIN = (size_t)2048 * 1024 * 2, SZ_CG = (size_t)4 * 256 * 256 * 2;
constexpr size_t SZ_UP = (size_t)5632 * 1024 * 2, SZ_DN = (size_t)1024 * 2816 * 2;
constexpr size_t WS_AIN = WS_W, WS_AOUT = WS_AIN + 2 * SZ_AIN, WS_BIN = WS_AOUT + 2 * SZ_SQ, WS_BOUT = WS_BIN + SZ_BIN, WS_CG = WS_BOUT + SZ_SQ;
constexpr size_t WS_UP = WS_CG + SZ_CG, WS_DN = WS_UP + 4 * SZ_UP, WS_WEND = WS_DN + 4 * SZ_DN;
constexpr size_t WS_X = 90 * MiB;
constexpr size_t WS_XB = WS_X + (size_t)M * D * 4;
constexpr size_t WS_T1 = WS_XB + (size_t)M * D * 2;
constexpr size_t WS_T2 = WS_T1 + (size_t)M * D * 2, WS_T3 = WS_T2 + (size_t)M * D * 2;
constexpr size_t WS_MB = WS_T1;
constexpr size_t WS_VS = WS_T3 + (size_t)M * D * 2;
constexpr size_t WS_FXP = WS_VS + (size_t)MS * D * 4;
constexpr size_t SZ_FX = (size_t)256 * 2 * DFF * 4;
constexpr size_t WS_FXA = WS_FXP + SZ_FX, WS_GL = WS_FXA + SZ_FX;
constexpr size_t WS_PART = WS_FXP;
constexpr size_t WS_END = WS_PART + (size_t)176 * 65536 * 4;
static_assert(WS_END >= WS_GL + SZ_FX, "ws end");
static_assert(WS_WEND <= WS_X, "weights fit");
static_assert(WS_T1 + (size_t)M * DFF * 2 <= WS_VS, "MB overlays T1..T3");

constexpr size_t O_YP = 0, O_YS = O_YP + (size_t)MP * D, O_SCP = O_YS + (size_t)MS * D, O_SCS = O_SCP + 2 * 8 * 2 * 1024, O_PP = O_SCS + 2 * 128 * 2 * 1024;
constexpr size_t O_PS = O_PP + 8 * 15 * 1024, O_FP = O_PS + 128 * 15 * 1024, O_FS = O_FP + 4 * 8 * 2 * DFF, O_CV = O_FS + 4 * 128 * 2 * DFF, O_END = O_CV + 128 * 8 * 1024;

__device__ __forceinline__ unsigned cvt_pk_bf16(float lo, float hi) { unsigned r; asm volatile("v_cvt_pk_bf16_f32 %0, %1, %2" : "=v"(r) : "v"(lo), "v"(hi)); return r; }
__device__ __forceinline__ float bf_lo(unsigned w) { return __uint_as_float(w << 16); }
__device__ __forceinline__ float bf_hi(unsigned w) { return __uint_as_float(w & 0xffff0000u); }
__device__ __forceinline__ float rstd_of(float ss) { return rsqrtf(ss * (1.0f / 1024.0f) + EPS); }
__device__ __forceinline__ float silu_f(float x) { return x * __builtin_amdgcn_rcpf(1.0f + __builtin_amdgcn_exp2f(-1.4426950408889634f * x)); }
__device__ __forceinline__ void atomic_addf(float* p, float v) { (void)__hip_atomic_fetch_add(p, v, __ATOMIC_RELAXED, __HIP_MEMORY_SCOPE_AGENT); }
__device__ __forceinline__ float wave_sum(float v) {
#pragma unroll
    for (int o = 1; o < 64; o <<= 1) v += __shfl_xor(v, o);
    return v;
}

namespace pg8 {
constexpr int BM = 256, BK = 64, HALF = 128, HTB = HALF * BK * 2, STAGE_BYTES = 8 * HTB, NXCD = 8, WGM = 8;
__host__ __device__ __forceinline__ int lds_byte(int r, int c) { const int st = (r >> 4) * 2 + (c >> 5), rr = r & 15, cc = c & 31, ob = rr * 64 + cc * 2; return st * 1024 + (ob ^ (((ob >> 9) & 1) << 5)); }
__host__ __device__ __forceinline__ void stage_rc(int b, int& R, int& C) { const int st = b / 1024, sb = b % 1024, swz = sb ^ (((sb >> 9) & 1) << 5); R = (st >> 1) * 16 + swz / 64; C = (st & 1) * 32 + (swz % 64) / 2; }
__host__ __device__ __forceinline__ int perm32(int rho) { const int n = rho >> 4, i = rho & 15; return 8 * (i >> 2) + 4 * n + (i & 3); }

struct Unit { int pm, pn, k0, nt, split, split_id; };
struct Gemm { const bf16_t* A; const bf16_t* Bt; int lda, ldb, K, nM, nN, a_pn_off; };

struct StaticOrder {
    int nM, nN, nwg, G, c, K, nS, nsplit, klen;
    __device__ void init(int nM_, int nN_, int G_, int c_, int K_, int nS_ = 0, int nsplit_ = 0, int klen_ = 0) { nM = nM_; nN = nN_; nwg = nM * nN; G = G_; c = c_; K = K_; nS = nS_; nsplit = nsplit_; klen = klen_; }
    __device__ bool next(int i, Unit& u) const {
        const long L = (long)i * G + c;
        if (L >= nwg) {
            const int s = (int)(L - nwg); if (s >= nS * nN * nsplit) return false;
            const int su = s / nsplit, kc = s - su * nsplit;
            u.pm = nM + su / nN; u.pn = su % nN; u.k0 = kc * klen; u.nt = klen / BK; u.split = 1; u.split_id = s; return true;
        }
        int wgid = (int)L; { const int q = nwg / NXCD, r = nwg % NXCD, xcd = wgid % NXCD, off = wgid / NXCD; wgid = (xcd < r ? xcd * (q + 1) : r * (q + 1) + (xcd - r) * q) + off; }
        const int nig = WGM * nN, gid = wgid / nig, fm = gid * WGM, gsz = (nM - fm) < WGM ? (nM - fm) : WGM;
        u.pm = fm + ((wgid % nig) % gsz); u.pn = (wgid % nig) / gsz; u.k0 = 0; u.nt = K / BK; u.split = 0; u.split_id = 0; return true;
    }
};

template <class Epi>
__device__ __forceinline__ void gemm_phase(LAS unsigned char* lds, const Gemm g, const StaticOrder& S, const Epi& E) {
    int tid = threadIdx.x; asm volatile("" : "+v"(tid)); const int wid = __builtin_amdgcn_readfirstlane(tid >> 6), lane = tid & 63, wr = wid >> 2, wc = wid & 3, fr = lane & 15, fq = lane >> 4;
    unsigned voffA[2], voffB[2];
#pragma unroll
    for (int i = 0; i < 2; ++i) { int R, C; stage_rc(tid * 16 + i * 8192, R, C); const int Rb = (R & ~31) + perm32(R & 31);
        voffA[i] = (unsigned)(R * g.lda + C) * 2u; voffB[i] = (unsigned)(Rb * g.ldb + C) * 2u; }
    const unsigned kstep = (unsigned)(BK * 2);
    const unsigned hstepA = (unsigned)HALF * g.lda * 2, hstepB = (unsigned)HALF * g.ldb * 2;
    const unsigned tstepA = 2 * hstepA, tstepB = 2 * hstepB;
    const unsigned ldsw = (unsigned)wid * 1024u;
    const int aoff = lds_byte(wr * 64 + fr, fq * 8), boff = lds_byte(wc * 32 + fr, fq * 8);
#define PG8_SA(b, h) (((b) * 2 + (h)) * HTB)
#define PG8_SB(b, h) ((4 + (b) * 2 + (h)) * HTB)
#define PG8_STAGE(bufoff, gbase, voff) do { _Pragma("unroll") for (int _i = 0; _i < 2; ++_i) \
        __builtin_amdgcn_global_load_lds((const unsigned*)((const char*)(gbase) + (voff)[_i]), (LAS unsigned*)(lds + (bufoff) + ldsw + _i * 8192), 16, 0, 0); } while (0)
#define PG8_LDA(dst, b, h) do { _Pragma("unroll") for (int m = 0; m < 4; ++m) _Pragma("unroll") for (int k = 0; k < 2; ++k) dst[m][k] = *(const LAS bf16x8*)(lds + PG8_SA(b, h) + aoff + m * 2048 + k * 1024); } while (0)
#define PG8_LDB(dst, b, h) do { _Pragma("unroll") for (int n = 0; n < 2; ++n) _Pragma("unroll") for (int k = 0; k < 2; ++k) dst[n][k] = *(const LAS bf16x8*)(lds + PG8_SB(b, h) + boff + n * 2048 + k * 1024); } while (0)
#define PG8_MMA(ai, bj, At, Bt) do { __builtin_amdgcn_s_setprio(1); _Pragma("unroll") for (int m = 0; m < 4; ++m) _Pragma("unroll") for (int n = 0; n < 2; ++n) _Pragma("unroll") for (int k = 0; k < 2; ++k) \
        acc[ai][bj][m][n] = __builtin_amdgcn_mfma_f32_16x16x32_bf16(Bt[n][k], At[m][k], acc[ai][bj][m][n], 0, 0, 0); __builtin_amdgcn_s_setprio(0); } while (0)
#define PG8_WAIT_V(n) asm volatile("s_waitcnt vmcnt(" #n ")" ::: "memory")
#define PG8_WAIT_L(n) asm volatile("s_waitcnt lgkmcnt(" #n ")" ::: "memory")
#define PG8_BAR __builtin_amdgcn_s_barrier()
#define PG8_SCHED __builtin_amdgcn_sched_barrier(0)
    Unit cur, nxt; int ui = 0;
    if (!S.next(0, cur)) return;
    f32x4 acc[2][2][4][2];
#pragma unroll
    for (int a = 0; a < 2; ++a)
#pragma unroll
        for (int b = 0; b < 2; ++b)
#pragma unroll
            for (int m = 0; m < 4; ++m)
#pragma unroll
                for (int n = 0; n < 2; ++n) acc[a][b][m][n] = (f32x4){0.f, 0.f, 0.f, 0.f};
    bf16x8 At[4][2], B0[2][2], B1[2][2];
    const char* cA = (const char*)g.A + (size_t)cur.pm * tstepA + (size_t)(cur.pn * g.a_pn_off + cur.k0) * 2; const char* cB = (const char*)g.Bt + (size_t)cur.pn * tstepB + (size_t)cur.k0 * 2;
    PG8_STAGE(PG8_SB(0, 0), cB, voffB); PG8_STAGE(PG8_SB(0, 1), cB + hstepB, voffB); PG8_STAGE(PG8_SA(0, 0), cA, voffA); PG8_STAGE(PG8_SA(0, 1), cA + hstepA, voffA);
    if (wr == 1) PG8_BAR;
    PG8_WAIT_V(2); PG8_BAR;
    PG8_STAGE(PG8_SB(1, 0), cB + kstep, voffB); PG8_STAGE(PG8_SA(1, 0), cA + kstep, voffA); PG8_STAGE(PG8_SB(1, 1), cB + hstepB + kstep, voffB);
    PG8_WAIT_V(6); PG8_BAR;
    for (;;) {
        const bool has_next = S.next(ui + 1, nxt);
        const char* nA = has_next ? (const char*)g.A + (size_t)nxt.pm * tstepA + (size_t)(nxt.pn * g.a_pn_off + nxt.k0) * 2 : cA; const char* nB = has_next ? (const char*)g.Bt + (size_t)nxt.pn * tstepB + (size_t)nxt.k0 * 2 : cB;
        const int nt = cur.nt;
        for (int t = 0; t < nt; t += 2) {
            const bool last = (t == nt - 2);
            const char* a1 = cA + (unsigned)(t + 1) * kstep;
            const char* a2 = last ? nA : cA + (unsigned)(t + 2) * kstep; const char* b2 = last ? nB : cB + (unsigned)(t + 2) * kstep;
            const char* a3 = a2 + kstep; const char* b3 = b2 + kstep;
            PG8_LDB(B0, 0, 0); PG8_LDB(B1, 0, 1); PG8_SCHED; PG8_LDA(At, 0, 0); PG8_STAGE(PG8_SA(1, 1), a1 + hstepA, voffA);
            PG8_WAIT_V(8); PG8_WAIT_L(0); PG8_BAR; PG8_MMA(0, 0, At, B0); PG8_MMA(0, 1, At, B1); PG8_BAR; PG8_SCHED;
            PG8_LDA(At, 0, 1); PG8_STAGE(PG8_SB(0, 0), b2, voffB); PG8_STAGE(PG8_SB(0, 1), b2 + hstepB, voffB); PG8_STAGE(PG8_SA(0, 0), a2, voffA);
            PG8_WAIT_V(8); PG8_WAIT_L(0); PG8_BAR; PG8_MMA(1, 0, At, B0); PG8_MMA(1, 1, At, B1); PG8_BAR; PG8_SCHED;
            PG8_LDB(B0, 1, 0); PG8_LDB(B1, 1, 1); PG8_SCHED; PG8_LDA(At, 1, 0); PG8_STAGE(PG8_SA(0, 1), a2 + hstepA, voffA);
            PG8_WAIT_V(8); PG8_WAIT_L(0); PG8_BAR; PG8_MMA(0, 0, At, B0); PG8_MMA(0, 1, At, B1); PG8_BAR; PG8_SCHED;
            PG8_LDA(At, 1, 1); PG8_STAGE(PG8_SB(1, 0), b3, voffB); PG8_STAGE(PG8_SB(1, 1), b3 + hstepB, voffB); PG8_STAGE(PG8_SA(1, 0), a3, voffA);
            PG8_WAIT_V(8); PG8_WAIT_L(0); PG8_BAR; PG8_MMA(1, 0, At, B0); PG8_MMA(1, 1, At, B1); PG8_BAR; PG8_SCHED;
        }
        if (wr == 0) PG8_BAR;
        E(acc, cur, wr, wc, fr, fq);
        if (!has_next) break;
#pragma unroll
        for (int a = 0; a < 2; ++a)
#pragma unroll
            for (int b = 0; b < 2; ++b)
#pragma unroll
                for (int m = 0; m < 4; ++m)
#pragma unroll
                    for (int n = 0; n < 2; ++n) acc[a][b][m][n] = (f32x4){0.f, 0.f, 0.f, 0.f};
        cur = nxt; cA = nA; cB = nB; ++ui;
        if (wr == 1) PG8_BAR;
    }
    PG8_WAIT_V(0);
    PG8_BAR;
#undef PG8_SA
#undef PG8_SB
#undef PG8_STAGE
#undef PG8_LDA
#undef PG8_LDB
#undef PG8_MMA
#undef PG8_WAIT_V
#undef PG8_WAIT_L
#undef PG8_BAR
#undef PG8_SCHED
}
}

typedef f32x4 AccT[2][2][4][2];
__device__ __forceinline__ void store_bf16x8(bf16_t* p, f32x4 v0, f32x4 v1) {
    u32x4 w; w.x = cvt_pk_bf16(v0[0], v0[1]); w.y = cvt_pk_bf16(v0[2], v0[3]); w.z = cvt_pk_bf16(v1[0], v1[1]); w.w = cvt_pk_bf16(v1[2], v1[3]); *(u32x4*)p = w;
}

template <bool HAS_CS> struct EpiRes {
    const float* xin_p; const float* xin_s; float* xout; bf16_t* xb; float* ssn; const float* cs; float* part;
    __device__ __forceinline__ void operator()(const AccT& acc, const pg8::Unit& u, int wr, int wc, int fr, int fq) const {
        asm volatile("" : "+v"(fr), "+v"(fq));
        const int colb = u.pn * 256 + wc * 32 + 8 * fq;
        if (u.split) {
            float* pt = part + (size_t)u.split_id * 65536;
#pragma unroll
            for (int ai = 0; ai < 2; ++ai)
#pragma unroll
                for (int m = 0; m < 4; ++m) {
                    float* po = pt + (size_t)(ai * 128 + wr * 64 + m * 16 + fr) * 256 + wc * 32 + 8 * fq;
#pragma unroll
                    for (int bj = 0; bj < 2; ++bj) { *(f32x4*)(po + 128 * bj) = acc[ai][bj][m][0]; *(f32x4*)(po + 128 * bj + 4) = acc[ai][bj][m][1]; }
                }
            return;
        }
#pragma unroll
        for (int ai = 0; ai < 2; ++ai)
#pragma unroll
            for (int m = 0; m < 4; ++m) {
                const int row = u.pm * 256 + ai * 128 + wr * 64 + m * 16 + fr;
                const float* xi = (u.pm < 64) ? xin_p + (size_t)row * D : xin_s + (size_t)(row - MP) * D;
                float* xo = xout + (size_t)row * D; bf16_t* xbo = xb + (size_t)row * D;
                float s = 0.f;
#pragma unroll
                for (int bj = 0; bj < 2; ++bj) {
                    const int col = colb + 128 * bj;
                    f32x4 o0 = acc[ai][bj][m][0], o1 = acc[ai][bj][m][1];
                    if (HAS_CS) { o0 *= *(const f32x4*)(cs + col); o1 *= *(const f32x4*)(cs + col + 4); }
                    o0 += *(const f32x4*)(xi + col); o1 += *(const f32x4*)(xi + col + 4);
                    *(f32x4*)(xo + col) = o0; *(f32x4*)(xo + col + 4) = o1; store_bf16x8(xbo + col, o0, o1);
                    s += (o0[0] * o0[0] + o0[1] * o0[1]) + (o0[2] * o0[2] + o0[3] * o0[3]) + (o1[0] * o1[0] + o1[1] * o1[1]) + (o1[2] * o1[2] + o1[3] * o1[3]);
                }
                s += __shfl_xor(s, 16); s += __shfl_xor(s, 32);
                if (fq == 0) atomic_addf(ssn + row, s);
            }
    }
};
struct EpiAin {
    const float* ss; bf16_t* BG; bf16_t* CV; float* st_p; float* st_s;
    __device__ __forceinline__ void operator()(const AccT& acc, const pg8::Unit& u, int wr, int wc, int fr, int fq) const {
        asm volatile("" : "+v"(fr), "+v"(fq));
#pragma unroll
        for (int ai = 0; ai < 2; ++ai)
#pragma unroll
            for (int m = 0; m < 4; ++m) {
                const int row = u.pm * 256 + ai * 128 + wr * 64 + m * 16 + fr;
                const float r = rstd_of(ss[row]);
                if (u.pn < 4) {
#pragma unroll
                    for (int bj = 0; bj < 2; ++bj) store_bf16x8(BG + (size_t)row * D + u.pn * 256 + 128 * bj + wc * 32 + 8 * fq, acc[ai][bj][m][0] * r, acc[ai][bj][m][1] * r);
                } else {
                    const int ch = (u.pn - 4) * 128 + wc * 32 + 8 * fq; const float r2 = r * r;
                    const f32x4 c0 = acc[ai][0][m][0] * acc[ai][1][m][0] * r2, c1 = acc[ai][0][m][1] * acc[ai][1][m][1] * r2;
                    store_bf16x8(CV + (size_t)row * D + ch, c0, c1);
                    if (u.pm < 64) { const int t = row & (SEQ - 1); if (t >= SEQ - 2) { float* o = st_p + ((size_t)(row >> 11) * 2 + (t - (SEQ - 2))) * D + ch; *(f32x4*)o = c0; *(f32x4*)(o + 4) = c1; } }
                    else { const int rr = row - MP, t = rr & 7; if (t >= 6) { float* o = st_s + ((size_t)(rr >> 3) * 2 + (t - 6)) * D + ch; *(f32x4*)o = c0; *(f32x4*)(o + 4) = c1; } }
                }
            }
    }
};
struct EpiBin {
    const float* ss; bf16_t* U; bf16_t* VT; float* VS; float* vss;
    __device__ __forceinline__ void operator()(const AccT& acc, const pg8::Unit& u, int wr, int wc, int fr, int fq) const {
        asm volatile("" : "+v"(fr), "+v"(fq));
#pragma unroll
        for (int ai = 0; ai < 2; ++ai)
#pragma unroll
            for (int m = 0; m < 4; ++m) {
                const int row = u.pm * 256 + ai * 128 + wr * 64 + m * 16 + fr;
                const float r = rstd_of(ss[row]);
                if (u.pn < 4) {
#pragma unroll
                    for (int bj = 0; bj < 2; ++bj) store_bf16x8(U + (size_t)row * D + u.pn * 256 + 128 * bj + wc * 32 + 8 * fq, acc[ai][bj][m][0] * r, acc[ai][bj][m][1] * r);
                } else {
                    float s = 0.f;
#pragma unroll
                    for (int bj = 0; bj < 2; ++bj) {
                        const int ch = (u.pn - 4) * 256 + 128 * bj + wc * 32 + 8 * fq;
                        const f32x4 v0 = acc[ai][bj][m][0] * r, v1 = acc[ai][bj][m][1] * r;
                        s += (v0[0] * v0[0] + v0[1] * v0[1]) + (v0[2] * v0[2] + v0[3] * v0[3]) + (v1[0] * v1[0] + v1[1] * v1[1]) + (v1[2] * v1[2] + v1[3] * v1[3]);
                        if (u.pm < 64) {
                            const unsigned w0 = cvt_pk_bf16(v0[0], v0[1]), w1 = cvt_pk_bf16(v0[2], v0[3]), w2 = cvt_pk_bf16(v1[0], v1[1]), w3 = cvt_pk_bf16(v1[2], v1[3]);
                            bf16_t* o = VT + (size_t)ch * MP + row;
                            o[0] = (bf16_t)w0; o[(size_t)MP] = (bf16_t)(w0 >> 16); o[(size_t)2 * MP] = (bf16_t)w1; o[(size_t)3 * MP] = (bf16_t)(w1 >> 16);
                            o[(size_t)4 * MP] = (bf16_t)w2; o[(size_t)5 * MP] = (bf16_t)(w2 >> 16); o[(size_t)6 * MP] = (bf16_t)w3; o[(size_t)7 * MP] = (bf16_t)(w3 >> 16);
                        } else { float* o = VS + (size_t)(row - MP) * D + ch; *(f32x4*)o = v0; *(f32x4*)(o + 4) = v1; }
                    }
                    s += __shfl_xor(s, 16); s += __shfl_xor(s, 32);
                    if (fq == 0) atomic_addf(vss + row, s);
                }
            }
    }
};
struct EpiUp {
    const float* ss; bf16_t* MB; const float* cw; const float* cb; const float* st_in; float* fxp; float* fxa; float* gl; float* st_p; float* st_s;
    __device__ __forceinline__ void operator()(const AccT& acc, const pg8::Unit& u, int wr, int wc, int fr, int fq) const {
        asm volatile("" : "+v"(fr), "+v"(fq));
        const int lane = threadIdx.x & 63;
        const int src1 = (lane & 48) | ((fr - 1) & 15), src2 = (lane & 48) | ((fr - 2) & 15);
        const bool prompt = u.pm < 64;
#pragma unroll
        for (int n = 0; n < 2; ++n) {
            const int ch = u.pn * 128 + wc * 32 + 8 * fq + 4 * n;
            const f32x4 w0 = *(const f32x4*)(cw + ch), w1 = *(const f32x4*)(cw + DFF + ch), w2 = *(const f32x4*)(cw + 2 * DFF + ch), bb = *(const f32x4*)(cb + ch);
#pragma unroll
            for (int ai = 0; ai < 2; ++ai) {
                const int G = u.pm * 4 + ai * 2 + wr;
                f32x4 p1 = (f32x4){0.f, 0.f, 0.f, 0.f}, p2 = p1;
#pragma unroll
                for (int m = 0; m < 4; ++m) {
                    const int row = u.pm * 256 + ai * 128 + wr * 64 + m * 16 + fr;
                    const float r = rstd_of(ss[row]);
                    const f32x4 gg = acc[ai][0][m][n] * r, aa = acc[ai][1][m][n] * r;
                    f32x4 q1, q2, pv1, pv2;
#pragma unroll
                    for (int j = 0; j < 4; ++j) { q1[j] = __shfl(gg[j], src1); q2[j] = __shfl(gg[j], src2); }
                    if (prompt) { pv1 = (fr >= 1) ? q1 : p1; pv2 = (fr >= 2) ? q2 : p2; }
                    else {
                        const int rr = row - MP, t = rr & 7; const float* sp = st_in + (size_t)(rr >> 3) * 2 * DFF + ch;
                        pv1 = q1; pv2 = q2;
                        if (t == 0) { pv1 = *(const f32x4*)(sp + DFF); pv2 = *(const f32x4*)(sp); }
                        if (t == 1) { pv2 = *(const f32x4*)(sp + DFF); }
                    }
                    const f32x4 pre = w2 * gg + w1 * pv1 + w0 * pv2 + bb;
                    u32x2 o; o.x = cvt_pk_bf16(silu_f(pre[0]) * aa[0], silu_f(pre[1]) * aa[1]); o.y = cvt_pk_bf16(silu_f(pre[2]) * aa[2], silu_f(pre[3]) * aa[3]);
                    *(u32x2*)(MB + (size_t)row * DFF + ch) = o;
                    if (prompt) {
                        if (m == 0 && fr < 2 && (G & 31) != 0) { *(f32x4*)(fxp + ((size_t)G * 2 + fr) * DFF + ch) = pre; *(f32x4*)(fxa + ((size_t)G * 2 + fr) * DFF + ch) = aa; }
                        if (m == 3 && fr >= 14) {
                            *(f32x4*)(gl + ((size_t)G * 2 + (fr - 14)) * DFF + ch) = gg;
                            if ((G & 31) == 31) *(f32x4*)(st_p + ((size_t)(G >> 5) * 2 + (fr - 14)) * DFF + ch) = gg;
                        }
                    } else {
                        const int rr = row - MP, t = rr & 7;
                        if (t >= 6) *(f32x4*)(st_s + ((size_t)(rr >> 3) * 2 + (t - 6)) * DFF + ch) = gg;
                    }
                    p1 = q1; p2 = q2;
                }
            }
        }
    }
};

struct Args { const float* in[22]; float* out; unsigned char* ws; int ph_lo, ph_hi; };
__device__ __forceinline__ const float* ldp(const Args& a, int i) { asm volatile("" : "+s"(i)); return a.in[i]; }
__device__ __forceinline__ unsigned char* ws_of(const Args& a) { unsigned char* p = a.ws; asm volatile("" : "+s"(p)); return p; }
__device__ __forceinline__ float* out_of(const Args& a) { float* p = a.out; asm volatile("" : "+s"(p)); return p; }
__device__ __forceinline__ int tid_l() { int t = threadIdx.x; asm volatile("" : "+v"(t)); return t; }
enum { I_XP = 0, I_XS, I_SSC, I_SPOOL, I_SFFN, I_GMIX, I_GFFN, I_GFIN, I_AWIN, I_ACONV, I_AWOUT, I_BWIN, I_BGV, I_BWS, I_BBIAS, I_BWOUT, I_CWG, I_CSCALE, I_FWUP, I_FCONV, I_FCONVB, I_FWDN };

template <int MAP> __device__ __forceinline__ int colmap(int n0) {
    if (MAP == 1) { if (n0 < 1024) return n0; const int q = n0 - 1024, p = q >> 8, jj = q & 255; return jj < 128 ? 1024 + 128 * p + jj : 2048 + 128 * p + (jj - 128); }
    if (MAP == 2) { const int p = n0 >> 8, jj = n0 & 255; return jj < 128 ? 128 * p + jj : DFF + 128 * p + (jj - 128); }
    return n0;
}
template <int MAP>
__device__ __forceinline__ void prep_matrix(const float* W, int K, int N, bf16_t* WT, const float* gs, LAS float* scr, int lane, int gw, int NGW, int& base) {
    const int nblk = N / 32, nitems = (K / 64) * nblk;
    int first = gw - (base % NGW); if (first < 0) first += NGW;
    for (int item = first; item < nitems; item += NGW) {
        const int kb = item / nblk, nb = item % nblk, k0 = 64 * kb, n0 = 32 * nb, sc = colmap<MAP>(n0);
#pragma unroll 8
        for (int i = 0; i < 32; ++i) { const int kk = 2 * i + (lane >> 5); float v = W[(size_t)(k0 + kk) * N + sc + (lane & 31)]; if (gs) v *= gs[k0 + kk]; scr[kk * 33 + (lane & 31)] = v; }
        asm volatile("s_waitcnt lgkmcnt(0)" ::: "memory");
        const int c = lane & 7;
#pragma unroll
        for (int j = 0; j < 4; ++j) { const int n = (lane >> 3) + 8 * j; const LAS float* s = scr + (8 * c) * 33 + n;
            u32x4 o; o.x = cvt_pk_bf16(s[0 * 33], s[1 * 33]); o.y = cvt_pk_bf16(s[2 * 33], s[3 * 33]); o.z = cvt_pk_bf16(s[4 * 33], s[5 * 33]); o.w = cvt_pk_bf16(s[6 * 33], s[7 * 33]);
            *(u32x4*)(WT + (size_t)(n0 + n) * K + k0 + 8 * c) = o; }
        asm volatile("s_waitcnt lgkmcnt(0)" ::: "memory");
    }
    base += nitems;
}

__device__ __forceinline__ void prep_phase(const Args& a, LAS unsigned char* lds) {
    unsigned char* const wsl = ws_of(a); float* const outl = out_of(a); const int tidl = tid_l();
    const int tid = tidl, lane = tid & 63, wave = tid >> 6;
    const int gw = blockIdx.x * NWAVES + wave, NGW = gridDim.x * NWAVES;
    LAS float* scr = (LAS float*)(lds + wave * 16384);
    unsigned char* ws = wsl;
    { float* z = (float*)(ws + WS_SS) + M; const int nz = 9 * M; for (int i = blockIdx.x * NTHREADS + tid; i < nz; i += gridDim.x * NTHREADS) z[i] = 0.f; }
    { float* ss0 = (float*)(ws + WS_SS); bf16_t* xb = (bf16_t*)(ws + WS_XB);
      for (int row = gw; row < M; row += NGW) {
          const float* xr = row < MP ? ldp(a, I_XP) + (size_t)row * D : ldp(a, I_XS) + (size_t)(row - MP) * D;
          float s = 0.f;
#pragma unroll
          for (int j = 0; j < 2; ++j) { const f32x4 v0 = *(const f32x4*)(xr + j * 512 + lane * 8), v1 = *(const f32x4*)(xr + j * 512 + lane * 8 + 4);
              s += (v0[0] * v0[0] + v0[1] * v0[1]) + (v0[2] * v0[2] + v0[3] * v0[3]) + (v1[0] * v1[0] + v1[1] * v1[1]) + (v1[2] * v1[2] + v1[3] * v1[3]);
              store_bf16x8(xb + (size_t)row * D + j * 512 + lane * 8, v0, v1); }
          s = wave_sum(s); if (lane == 0) ss0[row] = s; } }
    int base = 0;
    for (int j = 0; j < 2; ++j) {
        prep_matrix<1>(ldp(a, I_AWIN) + (size_t)j * 1024 * 3072, 1024, 3072, (bf16_t*)(ws + WS_AIN + j * SZ_AIN), ldp(a, I_GMIX) + (size_t)(3 * j) * D, scr, lane, gw, NGW, base);
        prep_matrix<0>(ldp(a, I_AWOUT) + (size_t)j * 1024 * 1024, 1024, 1024, (bf16_t*)(ws + WS_AOUT + j * SZ_SQ), nullptr, scr, lane, gw, NGW, base);
    }
    prep_matrix<0>(ldp(a, I_BWIN), 1024, 2048, (bf16_t*)(ws + WS_BIN), ldp(a, I_GMIX) + (size_t)1 * D, scr, lane, gw, NGW, base);
    prep_matrix<0>(ldp(a, I_BWOUT), 1024, 1024, (bf16_t*)(ws + WS_BOUT), nullptr, scr, lane, gw, NGW, base);
    for (int g = 0; g < 4; ++g) prep_matrix<0>(ldp(a, I_CWG) + (size_t)g * 65536, 256, 256, (bf16_t*)(ws + WS_CG) + (size_t)g * 65536, nullptr, scr, lane, gw, NGW, base);
    for (int i = 0; i < 4; ++i) {
        prep_matrix<2>(ldp(a, I_FWUP) + (size_t)i * 1024 * 5632, 1024, 5632, (bf16_t*)(ws + WS_UP + i * SZ_UP), ldp(a, I_GFFN) + (size_t)i * D, scr, lane, gw, NGW, base);
        prep_matrix<0>(ldp(a, I_FWDN) + (size_t)i * 2816 * 1024, 2816, 1024, (bf16_t*)(ws + WS_DN + i * SZ_DN), nullptr, scr, lane, gw, NGW, base);
    }
}

__device__ __forceinline__ void aconv_phase(const Args& a, int j) {
    unsigned char* const wsl = ws_of(a); float* const outl = out_of(a); const int tidl = tid_l();
    const bf16_t* BG = (const bf16_t*)(wsl + WS_T1); const bf16_t* CV = (const bf16_t*)(wsl + WS_T2); bf16_t* ZB = (bf16_t*)(wsl + WS_T3);
    const float* cw = ldp(a, I_ACONV) + (size_t)j * 3 * D; const float* st = ldp(a, I_SSC) + (size_t)j * DECB * 2 * D;
    const int tid = tidl, c8 = (tid & 127) * 8, rsub = tid >> 7;
    f32x4 w[3][2];
#pragma unroll
    for (int k = 0; k < 3; ++k) { w[k][0] = *(const f32x4*)(cw + k * D + c8); w[k][1] = *(const f32x4*)(cw + k * D + c8 + 4); }
    for (int r4 = blockIdx.x; r4 < M / 4; r4 += gridDim.x) {
        const int row = r4 * 4 + rsub;
        int t; const float* sp = nullptr;
        if (row < MP) t = row & (SEQ - 1); else { const int rr = row - MP; t = rr & 7; sp = st + (size_t)(rr >> 3) * 2 * D + c8; }
        f32x4 x[3][2];
#pragma unroll
        for (int k = 0; k < 3; ++k) {
            const int tt = t - 2 + k;
            if (tt >= 0) { const u32x4 v = *(const u32x4*)(CV + (size_t)(row - 2 + k) * D + c8);
                x[k][0] = (f32x4){bf_lo(v.x), bf_hi(v.x), bf_lo(v.y), bf_hi(v.y)}; x[k][1] = (f32x4){bf_lo(v.z), bf_hi(v.z), bf_lo(v.w), bf_hi(v.w)}; }
            else if (sp) { x[k][0] = *(const f32x4*)(sp + (size_t)(2 + tt) * D); x[k][1] = *(const f32x4*)(sp + (size_t)(2 + tt) * D + 4); }
            else { x[k][0] = (f32x4){0.f, 0.f, 0.f, 0.f}; x[k][1] = x[k][0]; }
        }
        const u32x4 b = *(const u32x4*)(BG + (size_t)row * D + c8);
        const f32x4 b0 = (f32x4){bf_lo(b.x), bf_hi(b.x), bf_lo(b.y), bf_hi(b.y)}, b1 = (f32x4){bf_lo(b.z), bf_hi(b.z), bf_lo(b.w), bf_hi(b.w)};
        const f32x4 y0 = w[0][0] * x[0][0] + w[1][0] * x[1][0] + w[2][0] * x[2][0], y1 = w[0][1] * x[0][1] + w[1][1] * x[1][1] + w[2][1] * x[2][1];
        store_bf16x8(ZB + (size_t)row * D + c8, b0 * y0, b1 * y1);
    }
}

__device__ __forceinline__ void spatial_phase(const Args& a) {
    unsigned char* const wsl = ws_of(a); float* const outl = out_of(a); const int tidl = tid_l();
    const bf16_t* U = (const bf16_t*)(wsl + WS_T1); const bf16_t* VT = (const bf16_t*)(wsl + WS_T2); bf16_t* ZB = (bf16_t*)(wsl + WS_T3);
    const float* VS = (const float*)(wsl + WS_VS); const float* vss = (const float*)(wsl + WS_VSS);
    const float* Ws = ldp(a, I_BWS); const float* bias = ldp(a, I_BBIAS); const float* gv = ldp(a, I_BGV);
    const int tid = tidl, lane = tid & 63, w = tid >> 6, fr = lane & 15, fq = lane >> 4;
    for (int unit = blockIdx.x; unit < 512 + DECB; unit += gridDim.x) {
        if (unit < 512) {
            const int c = unit >> 2, h = unit & 3, rb = c * 128, t = 16 * w + fr;
            f32x4 acc[16];
#pragma unroll
            for (int i = 0; i < 16; ++i) acc[i] = (f32x4){0.f, 0.f, 0.f, 0.f};
            const int nks = (w >> 1) + 1;
            for (int ks = 0; ks < nks; ++ks) {
                const int s0 = ks * 32 + 8 * fq;
                const float* wp = Ws + ((size_t)(h * 128 + t) * 128 + s0);
                const f32x4 wa = *(const f32x4*)wp, wb = *(const f32x4*)(wp + 4);
                const f32x4 va = *(const f32x4*)(vss + rb + s0), vb = *(const f32x4*)(vss + rb + s0 + 4);
                float wv[8];
#pragma unroll
                for (int i = 0; i < 4; ++i) { wv[i] = (s0 + i <= t) ? wa[i] * rstd_of(va[i]) : 0.f; wv[4 + i] = (s0 + 4 + i <= t) ? wb[i] * rstd_of(vb[i]) : 0.f; }
                u32x4 wpk; wpk.x = cvt_pk_bf16(wv[0], wv[1]); wpk.y = cvt_pk_bf16(wv[2], wv[3]); wpk.z = cvt_pk_bf16(wv[4], wv[5]); wpk.w = cvt_pk_bf16(wv[6], wv[7]);
                const bf16x8 Wf = __builtin_bit_cast(bf16x8, wpk);
                bf16x8 vf[16];
#pragma unroll
                for (int dt = 0; dt < 16; ++dt) vf[dt] = *(const bf16x8*)(VT + (size_t)(h * 256 + dt * 16 + fr) * MP + rb + s0);
                __builtin_amdgcn_sched_barrier(0);
#pragma unroll
                for (int dt = 0; dt < 16; ++dt) acc[dt] = __builtin_amdgcn_mfma_f32_16x16x32_bf16(vf[dt], Wf, acc[dt], 0, 0, 0);
            }
            const int row = rb + t; const float bs = bias[h * 128 + t];
#pragma unroll
            for (int dt = 0; dt < 16; ++dt) {
                const int ch = h * 256 + dt * 16 + 4 * fq;
                const f32x4 g4 = *(const f32x4*)(gv + ch);
                const u32x2 uu = *(const u32x2*)(U + (size_t)row * D + ch);
                const f32x4 u4 = (f32x4){bf_lo(uu.x), bf_hi(uu.x), bf_lo(uu.y), bf_hi(uu.y)};
                const f32x4 z = u4 * (acc[dt] * g4 + bs);
                u32x2 o; o.x = cvt_pk_bf16(z[0], z[1]); o.y = cvt_pk_bf16(z[2], z[3]);
                *(u32x2*)(ZB + (size_t)row * D + ch) = o;
            }
        } else {
            const int b = unit - 512, r0 = MP + 8 * b, ch = 2 * tid, h = ch >> 8;
            float v0[8], v1[8], rv[8];
#pragma unroll
            for (int s = 0; s < 8; ++s) { rv[s] = rstd_of(vss[r0 + s]); const f32x2 vv = *(const f32x2*)(VS + (size_t)(8 * b + s) * D + ch); v0[s] = vv.x * rv[s]; v1[s] = vv.y * rv[s]; }
            const f32x2 g2 = *(const f32x2*)(gv + ch);
            float* cvo = outl + O_CV + (size_t)(8 * b) * D + ch;
#pragma unroll
            for (int t = 0; t < 8; ++t) {
                float s0 = 0.f, s1 = 0.f;
#pragma unroll
                for (int s = 0; s <= t; ++s) { const float ww = Ws[(size_t)(h * 128 + t) * 128 + s]; s0 += ww * v0[s]; s1 += ww * v1[s]; }
                const float bs = bias[h * 128 + t];
                const unsigned uu = *(const unsigned*)(U + (size_t)(r0 + t) * D + ch);
                const float z0 = bf_lo(uu) * (s0 * g2.x + bs), z1 = bf_hi(uu) * (s1 * g2.y + bs);
                *(unsigned*)(ZB + (size_t)(r0 + t) * D + ch) = cvt_pk_bf16(z0, z1);
                *(f32x2*)(cvo + (size_t)t * D) = (f32x2){v0[t] * g2.x, v1[t] * g2.y};
            }
        }
    }
}

__device__ __forceinline__ void pool_phase(const Args& a, const float* ssk, const float* gm) {
    unsigned char* const wsl = ws_of(a); float* const outl = out_of(a); const int tidl = tid_l();
    const float* X = (const float*)(wsl + WS_X); bf16_t* DB = (bf16_t*)(wsl + WS_T1);
    const float* st = ldp(a, I_SPOOL);
    const int tid = tidl, c4 = (tid & 255) * 4, rsub = tid >> 8, win = 2 << (c4 >> 8);
    const f32x4 g4 = *(const f32x4*)(gm + c4);
    for (int r2 = blockIdx.x; r2 < M / 2; r2 += gridDim.x) {
        const int row = r2 * 2 + rsub;
        f32x4 sum = (f32x4){0.f, 0.f, 0.f, 0.f}, hcur = sum; float cnt;
        if (row < MP) {
            const int t = row & (SEQ - 1); const int n = (t + 1 < win) ? t + 1 : win; cnt = (float)n;
            for (int k = 0; k < n; ++k) { const int rr = row - k; const f32x4 hv = *(const f32x4*)(X + (size_t)rr * D + c4) * (g4 * rstd_of(ssk[rr])); if (k == 0) hcur = hv; sum += hv; }
            if (t >= SEQ - 15) *(f32x4*)(outl + O_PP + ((size_t)(row >> 11) * 15 + (t - (SEQ - 15))) * D + c4) = hcur;
        } else {
            const int rr0 = row - MP, b = rr0 >> 3, t = rr0 & 7; cnt = (float)win;
            for (int k = 0; k < win; ++k) { const int tt = t - k; f32x4 hv;
                if (tt >= 0) hv = *(const f32x4*)(X + (size_t)(row - k) * D + c4) * (g4 * rstd_of(ssk[row - k]));
                else hv = *(const f32x4*)(st + ((size_t)b * 15 + (15 + tt)) * D + c4);
                if (k == 0) hcur = hv; sum += hv; }
            float* po = outl + O_PS + (size_t)b * 15 * D + c4;
            *(f32x4*)(po + (size_t)(t + 7) * D) = hcur;
            if (t < 7) *(f32x4*)(po + (size_t)t * D) = *(const f32x4*)(st + ((size_t)b * 15 + 8 + t) * D + c4);
        }
        const f32x4 d = sum * (1.0f / cnt) - hcur;
        u32x2 o; o.x = cvt_pk_bf16(d[0], d[1]); o.y = cvt_pk_bf16(d[2], d[3]);
        *(u32x2*)(DB + (size_t)row * D + c4) = o;
    }
}

__device__ __forceinline__ void ffn_fix_phase(const Args& a, int layer) {
    unsigned char* const wsl = ws_of(a); float* const outl = out_of(a); const int tidl = tid_l();
    const float* fxp = (const float*)(wsl + WS_FXP); const float* fxa = (const float*)(wsl + WS_FXA); const float* gl = (const float*)(wsl + WS_GL);
    bf16_t* MB = (bf16_t*)(wsl + WS_MB); const float* cw = ldp(a, I_FCONV) + (size_t)layer * 3 * DFF;
    const int total = 256 * 2 * (DFF / 4);
    for (int i = blockIdx.x * NTHREADS + tidl; i < total; i += gridDim.x * NTHREADS) {
        const int c4 = (i % (DFF / 4)) * 4, gr = i / (DFF / 4), G = gr >> 1, r = gr & 1;
        if ((G & 31) == 0) continue;
        const f32x4 w0 = *(const f32x4*)(cw + c4), w1 = *(const f32x4*)(cw + DFF + c4);
        f32x4 pre = *(const f32x4*)(fxp + ((size_t)G * 2 + r) * DFF + c4);
        const f32x4 gm1 = *(const f32x4*)(gl + ((size_t)(G - 1) * 2 + 1) * DFF + c4);
        if (r == 0) { const f32x4 gm2 = *(const f32x4*)(gl + ((size_t)(G - 1) * 2 + 0) * DFF + c4); pre += w1 * gm1 + w0 * gm2; }
        else pre += w0 * gm1;
        const f32x4 av = *(const f32x4*)(fxa + ((size_t)G * 2 + r) * DFF + c4);
        u32x2 o; o.x = cvt_pk_bf16(silu_f(pre[0]) * av[0], silu_f(pre[1]) * av[1]); o.y = cvt_pk_bf16(silu_f(pre[2]) * av[2], silu_f(pre[3]) * av[3]);
        *(u32x2*)(MB + (size_t)(G * 64 + r) * DFF + c4) = o;
    }
}


__device__ __forceinline__ void sample_fin_phase(const Args& a, float* ssn, const float* xin_s, int nsplit) {
    unsigned char* const wsl = ws_of(a); const int tidl = tid_l();
    float* X = (float*)(wsl + WS_X); bf16_t* XB = (bf16_t*)(wsl + WS_XB); const float* part = (const float*)(wsl + WS_PART);
    const int lane = tidl & 63, gw = blockIdx.x * NWAVES + (tidl >> 6), NGW = gridDim.x * NWAVES;
    for (int r = gw; r < MS; r += NGW) {
        const int row = MP + r, pmq = r >> 8, rl = r & 255; float s = 0.f;
        f32x4 v[4];
#pragma unroll
        for (int j = 0; j < 4; ++j) v[j] = *(const f32x4*)(xin_s + (size_t)r * D + j * 256 + lane * 4);
        for (int kc = 0; kc < nsplit; ++kc) {
#pragma unroll
            for (int j = 0; j < 4; ++j) v[j] += *(const f32x4*)(part + ((size_t)((pmq * 4 + j) * nsplit + kc) * 65536) + (size_t)rl * 256 + lane * 4);
        }
#pragma unroll
        for (int j = 0; j < 4; ++j) {
            *(f32x4*)(X + (size_t)row * D + j * 256 + lane * 4) = v[j];
            u32x2 o; o.x = cvt_pk_bf16(v[j][0], v[j][1]); o.y = cvt_pk_bf16(v[j][2], v[j][3]);
            *(u32x2*)(XB + (size_t)row * D + j * 256 + lane * 4) = o;
            s += (v[j][0] * v[j][0] + v[j][1] * v[j][1]) + (v[j][2] * v[j][2] + v[j][3] * v[j][3]);
        }
        s = wave_sum(s); if (lane == 0) ssn[row] = s;
    }
}

__device__ __forceinline__ void final_phase(const Args& a) {
    unsigned char* const wsl = ws_of(a); float* const outl = out_of(a); const int tidl = tid_l();
    const float* X = (const float*)(wsl + WS_X); const float* ss8 = (const float*)(wsl + WS_SS) + (size_t)8 * M; const float* gf = ldp(a, I_GFIN);
    const int lane = tidl & 63, gw = blockIdx.x * NWAVES + (tidl >> 6), NGW = gridDim.x * NWAVES;
    f32x4 g[4];
#pragma unroll
    for (int j = 0; j < 4; ++j) g[j] = *(const f32x4*)(gf + j * 256 + lane * 4);
    for (int row = gw; row < M; row += NGW) {
        const float r = rstd_of(ss8[row]);
#pragma unroll
        for (int j = 0; j < 4; ++j) *(f32x4*)(outl + (size_t)row * D + j * 256 + lane * 4) = *(const f32x4*)(X + (size_t)row * D + j * 256 + lane * 4) * (g[j] * r);
    }
}


#define XB_TMO      128
#define XB_XCNT(j)  (256  + 64 * (j))
#define XB_XSUB(j)  (1280 + 64 * (j))
#define XB_XGEN(j)  (2304 + 64 * (j))
#define XB_TOP      3328
#define XB_TOPGEN   3392
#define XCD_BAR_WORDS 3456
#define XB_SPIN_CAP (1u << 22)
__device__ __forceinline__ unsigned xb_ld(unsigned* p)              { return __hip_atomic_load(p, __ATOMIC_RELAXED, __HIP_MEMORY_SCOPE_AGENT); }
__device__ __forceinline__ unsigned xb_add(unsigned* p, unsigned v) { return __hip_atomic_fetch_add(p, v, __ATOMIC_RELAXED, __HIP_MEMORY_SCOPE_AGENT); }
__device__ __forceinline__ unsigned xb_xcc_id() { return (unsigned)__builtin_amdgcn_s_getreg((3 << 11) | 20) & 0xFu; }
#define XB_SPIN(cond, bar) do { unsigned _sp = 0; while (cond) { __builtin_amdgcn_s_sleep(1); \
    if ((++_sp & 255u) == 0u) { if (xb_ld(&(bar)[XB_TMO])) break; if (_sp > XB_SPIN_CAP) { atomicAdd(&(bar)[XB_TMO], 1u); break; } } } } while (0)
struct XcdBarrier { unsigned* bar; unsigned x; volatile LAS unsigned* st; };
__device__ __forceinline__ XcdBarrier xcd_barrier_post(unsigned* bar, volatile LAS unsigned* st) {
    XcdBarrier b; b.bar = bar; b.x = xb_xcc_id(); b.st = st;
    if (threadIdx.x == 0) (void)xb_add(&bar[XB_XCNT(b.x)], 1u);
    return b;
}
__device__ __forceinline__ void xcd_barrier_complete(unsigned* bar, unsigned x, unsigned& nloc, unsigned& nx) {
    const unsigned G = gridDim.x * gridDim.y * gridDim.z;
    unsigned sum, cnt, mine, sp = 0u;
    for (;;) {
        sum = 0u; cnt = 0u; mine = 0u;
#pragma unroll
        for (unsigned j = 0; j < 16; ++j) { const unsigned c = xb_ld(&bar[XB_XCNT(j)]); sum += c; cnt += (c > 0u) ? 1u : 0u; mine = (j == x) ? c : mine; }
        if (sum == G) break;
        __builtin_amdgcn_s_sleep(1);
        if ((++sp & 255u) == 0u) { if (xb_ld(&bar[XB_TMO])) break; if (sp > XB_SPIN_CAP) { atomicAdd(&bar[XB_TMO], 1u); break; } }
    }
    nloc = mine > 0u ? mine : 1u; nx = cnt > 0u ? cnt : 1u;
}
__device__ __forceinline__ void xcd_barrier(const XcdBarrier& b) {
    asm volatile("s_waitcnt vmcnt(0)" ::: "memory");
    __syncthreads();
    if (threadIdx.x == 0) {
        unsigned* bar = b.bar;
        __builtin_amdgcn_s_waitcnt(0);
        unsigned nloc = b.st[0], nx = b.st[1];
        if (nloc == 0u) { xcd_barrier_complete(bar, b.x, nloc, nx); b.st[0] = nloc; b.st[1] = nx; }
        const unsigned old = xb_add(&bar[XB_XSUB(b.x)], 1u);
        const unsigned gen = old / nloc;
        if (old + 1u == (gen + 1u) * nloc) {
            __builtin_amdgcn_fence(__ATOMIC_RELEASE, "agent");
            asm volatile("s_waitcnt vmcnt(0)" ::: "memory");
            const unsigned og = xb_add(&bar[XB_TOP], 1u);
            const unsigned tg = og / nx;
            if (og + 1u == (tg + 1u) * nx) xb_add(&bar[XB_TOPGEN], 1u);
            else XB_SPIN(xb_ld(&bar[XB_TOPGEN]) == tg, bar);
            __builtin_amdgcn_fence(__ATOMIC_ACQUIRE, "agent");
            xb_add(&bar[XB_XGEN(b.x)], 1u);
            asm volatile("s_waitcnt vmcnt(0)" ::: "memory");
        } else {
            XB_SPIN(xb_ld(&bar[XB_XGEN(b.x)]) == gen, bar);
            __builtin_amdgcn_fence(__ATOMIC_ACQUIRE, "agent");
            asm volatile("s_waitcnt vmcnt(0)" ::: "memory");
        }
    }
    __syncthreads();
}

constexpr int LDS_BYTES = 147456;
constexpr int REP_SYNC = 1, REP_MISC = 1, REP_UP = 1, REP_IN = 1;
constexpr int N_PHASES = 32;

__global__ void __launch_bounds__(NTHREADS, 2) trunk_fwd(Args a) {
    extern __shared__ __attribute__((aligned(16))) unsigned char lds_raw[];
    LAS unsigned char* lds = (LAS unsigned char*)lds_raw;
    cg::grid_group grid = cg::this_grid();
    volatile LAS unsigned* misc = (volatile LAS unsigned*)(lds + 131072 + 512);
    if (threadIdx.x < 2) misc[threadIdx.x] = 0u;
    __syncthreads();
    const XcdBarrier xbar = xcd_barrier_post((unsigned*)(a.ws + WS_BAR), misc);
    int ph = 0;
#define GSYNC() do { if (ph == 0) grid.sync(); else xcd_barrier(xbar); } while (0)
#define PHASE_BEGIN_R(reps) if (ph >= a.ph_lo && ph < a.ph_hi) { for (int rep_ = 0; rep_ < (reps); ++rep_) { if (rep_) GSYNC(); unsigned char* const ws = ws_of(a); const int G = gridDim.x, bx = blockIdx.x; (void)ws; (void)G; (void)bx;
#define PHASE_BEGIN PHASE_BEGIN_R(1)
#define PHASE_END   } if (ph + 1 < a.ph_hi) { for (int s_ = 0; s_ < REP_SYNC; ++s_) GSYNC(); } } ++ph;
#define SSP(k) ((float*)(ws + WS_SS) + (size_t)(k) * M)
#define XP ((float*)(ws + WS_X))
#define XBP ((bf16_t*)(ws + WS_XB))
#define T1P ((bf16_t*)(ws + WS_T1))
#define T2P ((bf16_t*)(ws + WS_T2))
#define T3P ((bf16_t*)(ws + WS_T3))

    PHASE_BEGIN_R(REP_MISC) prep_phase(a, lds); PHASE_END

    for (int layer = 0; layer < 4; ++layer) {
        const int kind = layer % 3, j = layer / 3;
        if (kind == 0) {
            PHASE_BEGIN_R(REP_IN)
                pg8::Gemm g{XBP, (const bf16_t*)(ws + WS_AIN + j * SZ_AIN), D, D, D, 68, 12, 0}; pg8::StaticOrder S; S.init(68, 12, G, bx, D);
                EpiAin E{SSP(2 * layer), T1P, T2P, out_of(a) + O_SCP + (size_t)j * 8 * 2 * D, out_of(a) + O_SCS + (size_t)j * DECB * 2 * D};
                pg8::gemm_phase(lds, g, S, E);
            PHASE_END
            PHASE_BEGIN_R(REP_MISC) aconv_phase(a, j); PHASE_END
            PHASE_BEGIN
                pg8::Gemm g{T3P, (const bf16_t*)(ws + WS_AOUT + j * SZ_SQ), D, D, D, 68, 4, 0}; pg8::StaticOrder S; S.init(64, 4, G, bx, D, 4, 4, 256);
                EpiRes<false> E{layer == 0 ? ldp(a, I_XP) : XP, layer == 0 ? ldp(a, I_XS) : XP + (size_t)MP * D, XP, XBP, SSP(2 * layer + 1), nullptr, (float*)(ws + WS_PART)};
                pg8::gemm_phase(lds, g, S, E);
            PHASE_END
            PHASE_BEGIN sample_fin_phase(a, SSP(2 * layer + 1), layer == 0 ? ldp(a, I_XS) : (const float*)(XP + (size_t)MP * D), 4); PHASE_END
        } else if (kind == 1) {
            PHASE_BEGIN
                pg8::Gemm g{XBP, (const bf16_t*)(ws + WS_BIN), D, D, D, 68, 8, 0}; pg8::StaticOrder S; S.init(68, 8, G, bx, D);
                EpiBin E{SSP(2 * layer), T1P, T2P, (float*)(ws + WS_VS), (float*)(ws + WS_VSS)};
                pg8::gemm_phase(lds, g, S, E);
            PHASE_END
            PHASE_BEGIN_R(REP_MISC) spatial_phase(a); PHASE_END
            PHASE_BEGIN
                pg8::Gemm g{T3P, (const bf16_t*)(ws + WS_BOUT), D, D, D, 68, 4, 0}; pg8::StaticOrder S; S.init(64, 4, G, bx, D, 4, 4, 256);
                EpiRes<false> E{XP, XP + (size_t)MP * D, XP, XBP, SSP(2 * layer + 1), nullptr, (float*)(ws + WS_PART)};
                pg8::gemm_phase(lds, g, S, E);
            PHASE_END
            PHASE_BEGIN sample_fin_phase(a, SSP(2 * layer + 1), layer == 0 ? ldp(a, I_XS) : (const float*)(XP + (size_t)MP * D), 4); PHASE_END
        } else {
            PHASE_BEGIN_R(REP_MISC) pool_phase(a, SSP(2 * layer), ldp(a, I_GMIX) + (size_t)layer * D); PHASE_END
            PHASE_BEGIN
                pg8::Gemm g{T1P, (const bf16_t*)(ws + WS_CG), D, 256, 256, 68, 4, 256}; pg8::StaticOrder S; S.init(68, 4, G, bx, 256);
                EpiRes<true> E{XP, XP + (size_t)MP * D, XP, XBP, SSP(2 * layer + 1), ldp(a, I_CSCALE), (float*)(ws + WS_PART)};
                pg8::gemm_phase(lds, g, S, E);
            PHASE_END
        }
        PHASE_BEGIN_R(REP_UP)
            pg8::Gemm g{XBP, (const bf16_t*)(ws + WS_UP + layer * SZ_UP), D, D, D, 68, 22, 0}; pg8::StaticOrder S; S.init(68, 22, G, bx, D);
            EpiUp E{SSP(2 * layer + 1), (bf16_t*)(ws + WS_MB), ldp(a, I_FCONV) + (size_t)layer * 3 * DFF, ldp(a, I_FCONVB) + (size_t)layer * DFF, ldp(a, I_SFFN) + (size_t)layer * DECB * 2 * DFF,
                    (float*)(ws + WS_FXP), (float*)(ws + WS_FXA), (float*)(ws + WS_GL), out_of(a) + O_FP + (size_t)layer * 8 * 2 * DFF, out_of(a) + O_FS + (size_t)layer * DECB * 2 * DFF};
            pg8::gemm_phase(lds, g, S, E);
        PHASE_END
        PHASE_BEGIN_R(REP_MISC) ffn_fix_phase(a, layer); PHASE_END
        PHASE_BEGIN
            pg8::Gemm g{(const bf16_t*)(ws + WS_MB), (const bf16_t*)(ws + WS_DN + layer * SZ_DN), DFF, DFF, DFF, 68, 4, 0}; pg8::StaticOrder S; S.init(64, 4, G, bx, DFF, 4, 11, 256);
            EpiRes<false> E{XP, XP + (size_t)MP * D, XP, XBP, SSP(2 * layer + 2), nullptr, (float*)(ws + WS_PART)};
            pg8::gemm_phase(lds, g, S, E);
        PHASE_END
        PHASE_BEGIN sample_fin_phase(a, SSP(2 * layer + 2), (const float*)(XP + (size_t)MP * D), 11); PHASE_END
    }
    PHASE_BEGIN_R(REP_MISC) final_phase(a); PHASE_END
#undef PHASE_BEGIN
#undef PHASE_BEGIN_R
#undef PHASE_END
}

extern "C" void kernel_launch(void* const* d_in, const int* in_sizes, int n_in, void* d_out, int out_size, void* d_ws, size_t ws_size, hipStream_t stream) {
    static int grid = 0;
    if (grid == 0) {
        if (n_in != 22 || (size_t)out_size != O_END || ws_size < WS_END) { fprintf(stderr, "kernel_launch: unexpected shapes (n_in %d, out %d, ws %zu; need out %zu ws %zu)\n", n_in, out_size, ws_size, (size_t)O_END, (size_t)WS_END); grid = -1; return; }
        int dev = 0, cus = 0, per_cu = 0;
        (void)hipGetDevice(&dev); (void)hipDeviceGetAttribute(&cus, hipDeviceAttributeMultiprocessorCount, dev);
        if (hipFuncSetAttribute((const void*)trunk_fwd, hipFuncAttributeMaxDynamicSharedMemorySize, LDS_BYTES) != hipSuccess) { fprintf(stderr, "kernel_launch: hipFuncSetAttribute failed\n"); grid = -1; return; }
        if (hipOccupancyMaxActiveBlocksPerMultiprocessor(&per_cu, (const void*)trunk_fwd, NTHREADS, LDS_BYTES) != hipSuccess || per_cu < 1) { fprintf(stderr, "kernel_launch: occupancy query says %d\n", per_cu); per_cu = 1; }
        (void)hipGetLastError();
        grid = cus * 1;
        if (grid <= 0) grid = 256;
    }
    if (grid < 0) return;
    Args a{};
    for (int i = 0; i < 22; ++i) a.in[i] = (const float*)d_in[i];
    a.out = (float*)d_out; a.ws = (unsigned char*)d_ws; a.ph_lo = 0; a.ph_hi = N_PHASES;
    if (hipMemsetAsync((char*)d_ws + WS_BAR, 0, BAR_BYTES, stream) != hipSuccess) { fprintf(stderr, "kernel_launch: memset failed\n"); return; }
    void* args[] = {&a};
    hipError_t e = hipLaunchCooperativeKernel((const void*)trunk_fwd, dim3(grid), dim3(NTHREADS), args, LDS_BYTES, stream);
    if (e != hipSuccess) fprintf(stderr, "kernel_launch: cooperative launch failed: %s (grid %d)\n", hipGetErrorString(e), grid);
}
```

```cpp
#include <hip/hip_runtime.h>
#include <hip/hip_cooperative_groups.h>
#include <cstdio>
#include <cstdint>
namespace cg = cooperative_groups;

#define LAS __attribute__((address_space(3)))
typedef unsigned short bf16_t;
typedef short bf16x8 __attribute__((ext_vector_type(8)));
typedef float f32x4 __attribute__((ext_vector_type(4)));
typedef float f32x2 __attribute__((ext_vector_type(2)));
typedef unsigned u32x4 __attribute__((ext_vector_type(4)));
typedef unsigned u32x2 __attribute__((ext_vector_type(2)));

constexpr int D = 1024, SEQ = 2048, MP = 16384, MS = 1024, M = MP + MS, DFF = 2816, NBATCH = 8, DECB = 128, DECS = 8;
constexpr float EPS = 1e-6f;
constexpr int NWAVES = 8, NTHREADS = 512;

constexpr size_t MiB = 1u << 20;
constexpr size_t WS_SS = 0;
constexpr size_t WS_VSS = WS_SS + (size_t)9 * M * 4;
constexpr size_t WS_BAR = 768 * 1024, BAR_BYTES = 16384;
constexpr size_t WS_W = 1 * MiB;
static_assert(WS_VSS + (size_t)M * 4 <= WS_BAR, "SS below the barrier words");
constexpr size_t SZ_AIN = (size_t)3072 * 1024 * 2, SZ_SQ = (size_t)1024 * 1024 * 2, SZ_BIN = (size_t)2048 * 1024 * 2, SZ_CG = (size_t)4 * 256 * 256 * 2;
constexpr size_t SZ_UP = (size_t)5632 * 1024 * 2, SZ_DN = (size_t)1024 * 2816 * 2;
constexpr size_t WS_AIN = WS_W, WS_AOUT = WS_AIN + 2 * SZ_AIN, WS_BIN = WS_AOUT + 2 * SZ_SQ, WS_BOUT = WS_BIN + SZ_BIN, WS_CG = WS_BOUT + SZ_SQ;
constexpr size_t WS_UP = WS_CG + SZ_CG, WS_DN = WS_UP + 4 * SZ_UP, WS_WEND = WS_DN + 4 * SZ_DN;
constexpr size_t WS_X = 90 * MiB;
constexpr size_t WS_XB = WS_X + (size_t)M * D * 4;
constexpr size_t WS_T1 = WS_XB + (size_t)M * D * 2;
constexpr size_t WS_T2 = WS_T1 + (size_t)M * D * 2, WS_T3 = WS_T2 + (size_t)M * D * 2;
constexpr size_t WS_MB = WS_T1;
constexpr size_t WS_VS = WS_T3 + (size_t)M * D * 2;
constexpr size_t WS_FXP = WS_VS + (size_t)MS * D * 4;
constexpr size_t SZ_FX = (size_t)256 * 2 * DFF * 4;
constexpr size_t WS_FXA = WS_FXP + SZ_FX, WS_GL = WS_FXA + SZ_FX;
constexpr size_t WS_PART = WS_FXP;
constexpr size_t WS_END = WS_PART + (size_t)176 * 65536 * 4;
static_assert(WS_END >= WS_GL + SZ_FX, "ws end");
static_assert(WS_WEND <= WS_X, "weights fit");
static_assert(WS_T1 + (size_t)M * DFF * 2 <= WS_VS, "MB overlays T1..T3");

constexpr size_t O_YP = 0, O_YS = O_YP + (size_t)MP * D, O_SCP = O_YS + (size_t)MS * D, O_SCS = O_SCP + 2 * 8 * 2 * 1024, O_PP = O_SCS + 2 * 128 * 2 * 1024;
constexpr size_t O_PS = O_PP + 8 * 15 * 1024, O_FP = O_PS + 128 * 15 * 1024, O_FS = O_FP + 4 * 8 * 2 * DFF, O_CV = O_FS + 4 * 128 * 2 * DFF, O_END = O_CV + 128 * 8 * 1024;

__device__ __forceinline__ unsigned cvt_pk_bf16(float lo, float hi) { unsigned r; asm volatile("v_cvt_pk_bf16_f32 %0, %1, %2" : "=v"(r) : "v"(lo), "v"(hi)); return r; }
__device__ __forceinline__ float bf_lo(unsigned w) { return __uint_as_float(w << 16); }
__device__ __forceinline__ float bf_hi(unsigned w) { return __uint_as_float(w & 0xffff0000u); }
__device__ __forceinline__ float rstd_of(float ss) { return rsqrtf(ss * (1.0f / 1024.0f) + EPS); }
__device__ __forceinline__ float silu_f(float x) { return x * __builtin_amdgcn_rcpf(1.0f + __builtin_amdgcn_exp2f(-1.4426950408889634f * x)); }
__device__ __forceinline__ void atomic_addf(float* p, float v) { (void)__hip_atomic_fetch_add(p, v, __ATOMIC_RELAXED, __HIP_MEMORY_SCOPE_AGENT); }
__device__ __forceinline__ float wave_sum(float v) {
#pragma unroll
    for (int o = 1; o < 64; o <<= 1) v += __shfl_xor(v, o);
    return v;
}

namespace pg8 {
constexpr int BM = 256, BK = 64, HALF = 128, HTB = HALF * BK * 2, STAGE_BYTES = 8 * HTB, NXCD = 8, WGM = 8;
__host__ __device__ __forceinline__ int lds_byte(int r, int c) { const int st = (r >> 4) * 2 + (c >> 5), rr = r & 15, cc = c & 31, ob = rr * 64 + cc * 2; return st * 1024 + (ob ^ (((ob >> 9) & 1) << 5)); }
__host__ __device__ __forceinline__ void stage_rc(int b, int& R, int& C) { const int st = b / 1024, sb = b % 1024, swz = sb ^ (((sb >> 9) & 1) << 5); R = (st >> 1) * 16 + swz / 64; C = (st & 1) * 32 + (swz % 64) / 2; }
__host__ __device__ __forceinline__ int perm32(int rho) { const int n = rho >> 4, i = rho & 15; return 8 * (i >> 2) + 4 * n + (i & 3); }

struct Unit { int pm, pn, k0, nt, split, split_id; };
struct Gemm { const bf16_t* A; const bf16_t* Bt; int lda, ldb, K, nM, nN, a_pn_off; };

struct StaticOrder {
    int nM, nN, nwg, G, c, K, nS, nsplit, klen;
    __device__ void init(int nM_, int nN_, int G_, int c_, int K_, int nS_ = 0, int nsplit_ = 0, int klen_ = 0) { nM = nM_; nN = nN_; nwg = nM * nN; G = G_; c = c_; K = K_; nS = nS_; nsplit = nsplit_; klen = klen_; }
    __device__ bool next(int i, Unit& u) const {
        const long L = (long)i * G + c;
        if (L >= nwg) {
            const int s = (int)(L - nwg); if (s >= nS * nN * nsplit) return false;
            const int su = s / nsplit, kc = s - su * nsplit;
            u.pm = nM + su / nN; u.pn = su % nN; u.k0 = kc * klen; u.nt = klen / BK; u.split = 1; u.split_id = s; return true;
        }
        int wgid = (int)L; { const int q = nwg / NXCD, r = nwg % NXCD, xcd = wgid % NXCD, off = wgid / NXCD; wgid = (xcd < r ? xcd * (q + 1) : r * (q + 1) + (xcd - r) * q) + off; }
        const int nig = WGM * nN, gid = wgid / nig, fm = gid * WGM, gsz = (nM - fm) < WGM ? (nM - fm) : WGM;
        u.pm = fm + ((wgid % nig) % gsz); u.pn = (wgid % nig) / gsz; u.k0 = 0; u.nt = K / BK; u.split = 0; u.split_id = 0; return true;
    }
};

template <class Epi>
__device__ __forceinline__ void gemm_phase(LAS unsigned char* lds, const Gemm g, const StaticOrder& S, const Epi& E) {
    int tid = threadIdx.x; asm volatile("" : "+v"(tid)); const int wid = __builtin_amdgcn_readfirstlane(tid >> 6), lane = tid & 63, wr = wid >> 2, wc = wid & 3, fr = lane & 15, fq = lane >> 4;
    unsigned voffA[2], voffB[2];
#pragma unroll
    for (int i = 0; i < 2; ++i) { int R, C; stage_rc(tid * 16 + i * 8192, R, C); const int Rb = (R & ~31) + perm32(R & 31);
        voffA[i] = (unsigned)(R * g.lda + C) * 2u; voffB[i] = (unsigned)(Rb * g.ldb + C) * 2u; }
    const unsigned kstep = (unsigned)(BK * 2);
    const unsigned hstepA = (unsigned)HALF * g.lda * 2, hstepB = (unsigned)HALF * g.ldb * 2;
    const unsigned tstepA = 2 * hstepA, tstepB = 2 * hstepB;
    const unsigned ldsw = (unsigned)wid * 1024u;
    const int aoff = lds_byte(wr * 64 + fr, fq * 8), boff = lds_byte(wc * 32 + fr, fq * 8);
#define PG8_SA(b, h) (((b) * 2 + (h)) * HTB)
#define PG8_SB(b, h) ((4 + (b) * 2 + (h)) * HTB)
#define PG8_STAGE(bufoff, gbase, voff) do { _Pragma("unroll") for (int _i = 0; _i < 2; ++_i) \
        __builtin_amdgcn_global_load_lds((const unsigned*)((const char*)(gbase) + (voff)[_i]), (LAS unsigned*)(lds + (bufoff) + ldsw + _i * 8192), 16, 0, 0); } while (0)
#define PG8_LDA(dst, b, h) do { _Pragma("unroll") for (int m = 0; m < 4; ++m) _Pragma("unroll") for (int k = 0; k < 2; ++k) dst[m][k] = *(const LAS bf16x8*)(lds + PG8_SA(b, h) + aoff + m * 2048 + k * 1024); } while (0)
#define PG8_LDB(dst, b, h) do { _Pragma("unroll") for (int n = 0; n < 2; ++n) _Pragma("unroll") for (int k = 0; k < 2; ++k) dst[n][k] = *(const LAS bf16x8*)(lds + PG8_SB(b, h) + boff + n * 2048 + k * 1024); } while (0)
#define PG8_MMA(ai, bj, At, Bt) do { __builtin_amdgcn_s_setprio(1); _Pragma("unroll") for (int m = 0; m < 4; ++m) _Pragma("unroll") for (int n = 0; n < 2; ++n) _Pragma("unroll") for (int k = 0; k < 2; ++k) \
        acc[ai][bj][m][n] = __builtin_amdgcn_mfma_f32_16x16x32_bf16(Bt[n][k], At[m][k], acc[ai][bj][m][n], 0, 0, 0); __builtin_amdgcn_s_setprio(0); } while (0)
#define PG8_WAIT_V(n) asm volatile("s_waitcnt vmcnt(" #n ")" ::: "memory")
#define PG8_WAIT_L(n) asm volatile("s_waitcnt lgkmcnt(" #n ")" ::: "memory")
#define PG8_BAR __builtin_amdgcn_s_barrier()
#define PG8_SCHED __builtin_amdgcn_sched_barrier(0)
    Unit cur, nxt; int ui = 0;
    if (!S.next(0, cur)) return;
    f32x4 acc[2][2][4][2];
#pragma unroll
    for (int a = 0; a < 2; ++a)
#pragma unroll
        for (int b = 0; b < 2; ++b)
#pragma unroll
            for (int m = 0; m < 4; ++m)
#pragma unroll
                for (int n = 0; n < 2; ++n) acc[a][b][m][n] = (f32x4){0.f, 0.f, 0.f, 0.f};
    bf16x8 At[4][2], B0[2][2], B1[2][2];
    const char* cA = (const char*)g.A + (size_t)cur.pm * tstepA + (size_t)(cur.pn * g.a_pn_off + cur.k0) * 2; const char* cB = (const char*)g.Bt + (size_t)cur.pn * tstepB + (size_t)cur.k0 * 2;
    PG8_STAGE(PG8_SB(0, 0), cB, voffB); PG8_STAGE(PG8_SB(0, 1), cB + hstepB, voffB); PG8_STAGE(PG8_SA(0, 0), cA, voffA); PG8_STAGE(PG8_SA(0, 1), cA + hstepA, voffA);
    if (wr == 1) PG8_BAR;
    PG8_WAIT_V(2); PG8_BAR;
    PG8_STAGE(PG8_SB(1, 0), cB + kstep, voffB); PG8_STAGE(PG8_SA(1, 0), cA + kstep, voffA); PG8_STAGE(PG8_SB(1, 1), cB + hstepB + kstep, voffB);
    PG8_WAIT_V(6); PG8_BAR;
    for (;;) {
        const bool has_next = S.next(ui + 1, nxt);
        const char* nA = has_next ? (const char*)g.A + (size_t)nxt.pm * tstepA + (size_t)(nxt.pn * g.a_pn_off + nxt.k0) * 2 : cA; const char* nB = has_next ? (const char*)g.Bt + (size_t)nxt.pn * tstepB + (size_t)nxt.k0 * 2 : cB;
        const int nt = cur.nt;
        for (int t = 0; t < nt; t += 2) {
            const bool last = (t == nt - 2);
            const char* a1 = cA + (unsigned)(t + 1) * kstep;
            const char* a2 = last ? nA : cA + (unsigned)(t + 2) * kstep; const char* b2 = last ? nB : cB + (unsigned)(t + 2) * kstep;
            const char* a3 = a2 + kstep; const char* b3 = b2 + kstep;
            PG8_LDB(B0, 0, 0); PG8_LDB(B1, 0, 1); PG8_SCHED; PG8_LDA(At, 0, 0); PG8_STAGE(PG8_SA(1, 1), a1 + hstepA, voffA);
            PG8_WAIT_V(8); PG8_WAIT_L(0); PG8_BAR; PG8_MMA(0, 0, At, B0); PG8_MMA(0, 1, At, B1); PG8_BAR; PG8_SCHED;
            PG8_LDA(At, 0, 1); PG8_STAGE(PG8_SB(0, 0), b2, voffB); PG8_STAGE(PG8_SB(0, 1), b2 + hstepB, voffB); PG8_STAGE(PG8_SA(0, 0), a2, voffA);
            PG8_WAIT_V(8); PG8_WAIT_L(0); PG8_BAR; PG8_MMA(1, 0, At, B0); PG8_MMA(1, 1, At, B1); PG8_BAR; PG8_SCHED;
            PG8_LDB(B0, 1, 0); PG8_LDB(B1, 1, 1); PG8_SCHED; PG8_LDA(At, 1, 0); PG8_STAGE(PG8_SA(0, 1), a2 + hstepA, voffA);
            PG8_WAIT_V(8); PG8_WAIT_L(0); PG8_BAR; PG8_MMA(0, 0, At, B0); PG8_MMA(0, 1, At, B1); PG8_BAR; PG8_SCHED;
            PG8_LDA(At, 1, 1); PG8_STAGE(PG8_SB(1, 0), b3, voffB); PG8_STAGE(PG8_SB(1, 1), b3 + hstepB, voffB); PG8_STAGE(PG8_SA(1, 0), a3, voffA);
            PG8_WAIT_V(8); PG8_WAIT_L(0); PG8_BAR; PG8_MMA(1, 0, At, B0); PG8_MMA(1, 1, At, B1); PG8_BAR; PG8_SCHED;
        }
        if (wr == 0) PG8_BAR;
        E(acc, cur, wr, wc, fr, fq);
        if (!has_next) break;
#pragma unroll
        for (int a = 0; a < 2; ++a)
#pragma unroll
            for (int b = 0; b < 2; ++b)
#pragma unroll
                for (int m = 0; m < 4; ++m)
#pragma unroll
                    for (int n = 0; n < 2; ++n) acc[a][b][m][n] = (f32x4){0.f, 0.f, 0.f, 0.f};
        cur = nxt; cA = nA; cB = nB; ++ui;
        if (wr == 1) PG8_BAR;
    }
    PG8_WAIT_V(0);
    PG8_BAR;
#undef PG8_SA
#undef PG8_SB
#undef PG8_STAGE
#undef PG8_LDA
#undef PG8_LDB
#undef PG8_MMA
#undef PG8_WAIT_V
#undef PG8_WAIT_L
#undef PG8_BAR
#undef PG8_SCHED
}
}

typedef f32x4 AccT[2][2][4][2];
__device__ __forceinline__ void store_bf16x8(bf16_t* p, f32x4 v0, f32x4 v1) {
    u32x4 w; w.x = cvt_pk_bf16(v0[0], v0[1]); w.y = cvt_pk_bf16(v0[2], v0[3]); w.z = cvt_pk_bf16(v1[0], v1[1]); w.w = cvt_pk_bf16(v1[2], v1[3]); *(u32x4*)p = w;
}

__device__ __forceinline__ void load_rstd8(const float* ss, int pm, int wr, int fr, float (&r)[2][4]) {
    float t[2][4];
#pragma unroll
    for (int ai = 0; ai < 2; ++ai)
#pragma unroll
        for (int m = 0; m < 4; ++m) t[ai][m] = ss[pm * 256 + ai * 128 + wr * 64 + m * 16 + fr];
#pragma unroll
    for (int ai = 0; ai < 2; ++ai)
#pragma unroll
        for (int m = 0; m < 4; ++m) r[ai][m] = rstd_of(t[ai][m]);
}

template <bool HAS_CS> struct EpiRes {
    const float* xin_p; const float* xin_s; float* xout; bf16_t* xb; float* ssn; const float* cs; float* part;
    __device__ __forceinline__ void operator()(const AccT& acc, const pg8::Unit& u, int wr, int wc, int fr, int fq) const {
        asm volatile("" : "+v"(fr), "+v"(fq));
        const int colb = u.pn * 256 + wc * 32 + 8 * fq;
        if (u.split) {
            float* pt = part + (size_t)u.split_id * 65536;
#pragma unroll
            for (int ai = 0; ai < 2; ++ai)
#pragma unroll
                for (int m = 0; m < 4; ++m) {
                    float* po = pt + (size_t)(ai * 128 + wr * 64 + m * 16 + fr) * 256 + wc * 32 + 8 * fq;
#pragma unroll
                    for (int bj = 0; bj < 2; ++bj) { *(f32x4*)(po + 128 * bj) = acc[ai][bj][m][0]; *(f32x4*)(po + 128 * bj + 4) = acc[ai][bj][m][1]; }
                }
            return;
        }
#pragma unroll
        for (int ai = 0; ai < 2; ++ai)
#pragma unroll
            for (int mp = 0; mp < 4; mp += 2) {
                f32x4 xr[2][2][2];
#pragma unroll
                for (int mm = 0; mm < 2; ++mm) {
                    const int row = u.pm * 256 + ai * 128 + wr * 64 + (mp + mm) * 16 + fr;
                    const float* xi = (u.pm < 64) ? xin_p + (size_t)row * D : xin_s + (size_t)(row - MP) * D;
#pragma unroll
                    for (int bj = 0; bj < 2; ++bj) { xr[mm][bj][0] = *(const f32x4*)(xi + colb + 128 * bj); xr[mm][bj][1] = *(const f32x4*)(xi + colb + 128 * bj + 4); }
                }
#pragma unroll
                for (int mm = 0; mm < 2; ++mm) {
                    const int m = mp + mm;
                    const int row = u.pm * 256 + ai * 128 + wr * 64 + m * 16 + fr;
                    float* xo = xout + (size_t)row * D; bf16_t* xbo = xb + (size_t)row * D;
                    float s = 0.f;
#pragma unroll
                    for (int bj = 0; bj < 2; ++bj) {
                        const int col = colb + 128 * bj;
                        f32x4 o0 = acc[ai][bj][m][0], o1 = acc[ai][bj][m][1];
                        if (HAS_CS) { o0 *= *(const f32x4*)(cs + col); o1 *= *(const f32x4*)(cs + col + 4); }
                        o0 += xr[mm][bj][0]; o1 += xr[mm][bj][1];
                        *(f32x4*)(xo + col) = o0; *(f32x4*)(xo + col + 4) = o1; store_bf16x8(xbo + col, o0, o1);
                        s += (o0[0] * o0[0] + o0[1] * o0[1]) + (o0[2] * o0[2] + o0[3] * o0[3]) + (o1[0] * o1[0] + o1[1] * o1[1]) + (o1[2] * o1[2] + o1[3] * o1[3]);
                    }
                    s += __shfl_xor(s, 16); s += __shfl_xor(s, 32);
                    if (fq == 0) atomic_addf(ssn + row, s);
                }
            }
    }
};
struct EpiAin {
    const float* ss; bf16_t* BG; bf16_t* CV; float* st_p; float* st_s;
    __device__ __forceinline__ void operator()(const AccT& acc, const pg8::Unit& u, int wr, int wc, int fr, int fq) const {
        asm volatile("" : "+v"(fr), "+v"(fq));
        float rs[2][4]; load_rstd8(ss, u.pm, wr, fr, rs);
#pragma unroll
        for (int ai = 0; ai < 2; ++ai)
#pragma unroll
            for (int m = 0; m < 4; ++m) {
                const int row = u.pm * 256 + ai * 128 + wr * 64 + m * 16 + fr;
                const float r = rs[ai][m];
                if (u.pn < 4) {
#pragma unroll
                    for (int bj = 0; bj < 2; ++bj) store_bf16x8(BG + (size_t)row * D + u.pn * 256 + 128 * bj + wc * 32 + 8 * fq, acc[ai][bj][m][0] * r, acc[ai][bj][m][1] * r);
                } else {
                    const int ch = (u.pn - 4) * 128 + wc * 32 + 8 * fq; const float r2 = r * r;
                    const f32x4 c0 = acc[ai][0][m][0] * acc[ai][1][m][0] * r2, c1 = acc[ai][0][m][1] * acc[ai][1][m][1] * r2;
                    store_bf16x8(CV + (size_t)row * D + ch, c0, c1);
                    if (u.pm < 64) { const int t = row & (SEQ - 1); if (t >= SEQ - 2) { float* o = st_p + ((size_t)(row >> 11) * 2 + (t - (SEQ - 2))) * D + ch; *(f32x4*)o = c0; *(f32x4*)(o + 4) = c1; } }
                    else { const int rr = row - MP, t = rr & 7; if (t >= 6) { float* o = st_s + ((size_t)(rr >> 3) * 2 + (t - 6)) * D + ch; *(f32x4*)o = c0; *(f32x4*)(o + 4) = c1; } }
                }
            }
    }
};
struct EpiBin {
    const float* ss; bf16_t* U; bf16_t* VT; float* VS; float* vss;
    __device__ __forceinline__ void operator()(const AccT& acc, const pg8::Unit& u, int wr, int wc, int fr, int fq) const {
        asm volatile("" : "+v"(fr), "+v"(fq));
        float rs[2][4]; load_rstd8(ss, u.pm, wr, fr, rs);
#pragma unroll
        for (int ai = 0; ai < 2; ++ai)
#pragma unroll
            for (int m = 0; m < 4; ++m) {
                const int row = u.pm * 256 + ai * 128 + wr * 64 + m * 16 + fr;
                const float r = rs[ai][m];
                if (u.pn < 4) {
#pragma unroll
                    for (int bj = 0; bj < 2; ++bj) store_bf16x8(U + (size_t)row * D + u.pn * 256 + 128 * bj + wc * 32 + 8 * fq, acc[ai][bj][m][0] * r, acc[ai][bj][m][1] * r);
                } else {
                    float s = 0.f;
#pragma unroll
                    for (int bj = 0; bj < 2; ++bj) {
                        const int ch = (u.pn - 4) * 256 + 128 * bj + wc * 32 + 8 * fq;
                        const f32x4 v0 = acc[ai][bj][m][0] * r, v1 = acc[ai][bj][m][1] * r;
                        s += (v0[0] * v0[0] + v0[1] * v0[1]) + (v0[2] * v0[2] + v0[3] * v0[3]) + (v1[0] * v1[0] + v1[1] * v1[1]) + (v1[2] * v1[2] + v1[3] * v1[3]);
                        if (u.pm < 64) {
                            const unsigned w0 = cvt_pk_bf16(v0[0], v0[1]), w1 = cvt_pk_bf16(v0[2], v0[3]), w2 = cvt_pk_bf16(v1[0], v1[1]), w3 = cvt_pk_bf16(v1[2], v1[3]);
                            bf16_t* o = VT + (size_t)ch * MP + row;
                            o[0] = (bf16_t)w0; o[(size_t)MP] = (bf16_t)(w0 >> 16); o[(size_t)2 * MP] = (bf16_t)w1; o[(size_t)3 * MP] = (bf16_t)(w1 >> 16);
                            o[(size_t)4 * MP] = (bf16_t)w2; o[(size_t)5 * MP] = (bf16_t)(w2 >> 16); o[(size_t)6 * MP] = (bf16_t)w3; o[(size_t)7 * MP] = (bf16_t)(w3 >> 16);
                        } else { float* o = VS + (size_t)(row - MP) * D + ch; *(f32x4*)o = v0; *(f32x4*)(o + 4) = v1; }
                    }
                    s += __shfl_xor(s, 16); s += __shfl_xor(s, 32);
                    if (fq == 0) atomic_addf(vss + row, s);
                }
            }
    }
};
struct EpiUp {
    const float* ss; bf16_t* MB; const float* cw; const float* cb; const float* st_in; float* fxp; float* fxa; float* gl; float* st_p; float* st_s;
    __device__ __forceinline__ void operator()(const AccT& acc, const pg8::Unit& u, int wr, int wc, int fr, int fq) const {
        asm volatile("" : "+v"(fr), "+v"(fq));
        const int lane = threadIdx.x & 63;
        const int src1 = (lane & 48) | ((fr - 1) & 15), src2 = (lane & 48) | ((fr - 2) & 15);
        const bool prompt = u.pm < 64;
        float rs[2][4]; load_rstd8(ss, u.pm, wr, fr, rs);
#pragma unroll
        for (int n = 0; n < 2; ++n) {
            const int ch = u.pn * 128 + wc * 32 + 8 * fq + 4 * n;
            const f32x4 w0 = *(const f32x4*)(cw + ch), w1 = *(const f32x4*)(cw + DFF + ch), w2 = *(const f32x4*)(cw + 2 * DFF + ch), bb = *(const f32x4*)(cb + ch);
#pragma unroll
            for (int ai = 0; ai < 2; ++ai) {
                const int G = u.pm * 4 + ai * 2 + wr;
                f32x4 p1 = (f32x4){0.f, 0.f, 0.f, 0.f}, p2 = p1;
#pragma unroll
                for (int m = 0; m < 4; ++m) {
                    const int row = u.pm * 256 + ai * 128 + wr * 64 + m * 16 + fr;
                    const float r = rs[ai][m];
                    const f32x4 gg = acc[ai][0][m][n] * r, aa = acc[ai][1][m][n] * r;
                    f32x4 q1, q2, pv1, pv2;
#pragma unroll
                    for (int j = 0; j < 4; ++j) { q1[j] = __shfl(gg[j], src1); q2[j] = __shfl(gg[j], src2); }
                    if (prompt) { pv1 = (fr >= 1) ? q1 : p1; pv2 = (fr >= 2) ? q2 : p2; }
                    else {
                        const int rr = row - MP, t = rr & 7; const float* sp = st_in + (size_t)(rr >> 3) * 2 * DFF + ch;
                        pv1 = q1; pv2 = q2;
                        if (t == 0) { pv1 = *(const f32x4*)(sp + DFF); pv2 = *(const f32x4*)(sp); }
                        if (t == 1) { pv2 = *(const f32x4*)(sp + DFF); }
                    }
                    const f32x4 pre = w2 * gg + w1 * pv1 + w0 * pv2 + bb;
                    u32x2 o; o.x = cvt_pk_bf16(silu_f(pre[0]) * aa[0], silu_f(pre[1]) * aa[1]); o.y = cvt_pk_bf16(silu_f(pre[2]) * aa[2], silu_f(pre[3]) * aa[3]);
                    *(u32x2*)(MB + (size_t)row * DFF + ch) = o;
                    if (prompt) {
                        if (m == 0 && fr < 2 && (G & 31) != 0) { *(f32x4*)(fxp + ((size_t)G * 2 + fr) * DFF + ch) = pre; *(f32x4*)(fxa + ((size_t)G * 2 + fr) * DFF + ch) = aa; }
                        if (m == 3 && fr >= 14) {
                            *(f32x4*)(gl + ((size_t)G * 2 + (fr - 14)) * DFF + ch) = gg;
                            if ((G & 31) == 31) *(f32x4*)(st_p + ((size_t)(G >> 5) * 2 + (fr - 14)) * DFF + ch) = gg;
                        }
                    } else {
                        const int rr = row - MP, t = rr & 7;
                        if (t >= 6) *(f32x4*)(st_s + ((size_t)(rr >> 3) * 2 + (t - 6)) * DFF + ch) = gg;
                    }
                    p1 = q1; p2 = q2;
                }
            }
        }
    }
};

struct Args { const float* in[22]; float* out; unsigned char* ws; int ph_lo, ph_hi; };
__device__ __forceinline__ const float* ldp(const Args& a, int i) { asm volatile("" : "+s"(i)); return a.in[i]; }
__device__ __forceinline__ unsigned char* ws_of(const Args& a) { unsigned char* p = a.ws; asm volatile("" : "+s"(p)); return p; }
__device__ __forceinline__ float* out_of(const Args& a) { float* p = a.out; asm volatile("" : "+s"(p)); return p; }
__device__ __forceinline__ int tid_l() { int t = threadIdx.x; asm volatile("" : "+v"(t)); return t; }
enum { I_XP = 0, I_XS, I_SSC, I_SPOOL, I_SFFN, I_GMIX, I_GFFN, I_GFIN, I_AWIN, I_ACONV, I_AWOUT, I_BWIN, I_BGV, I_BWS, I_BBIAS, I_BWOUT, I_CWG, I_CSCALE, I_FWUP, I_FCONV, I_FCONVB, I_FWDN };

template <int MAP> __device__ __forceinline__ int colmap(int n0) {
    if (MAP == 1) { if (n0 < 1024) return n0; const int q = n0 - 1024, p = q >> 8, jj = q & 255; return jj < 128 ? 1024 + 128 * p + jj : 2048 + 128 * p + (jj - 128); }
    if (MAP == 2) { const int p = n0 >> 8, jj = n0 & 255; return jj < 128 ? 128 * p + jj : DFF + 128 * p + (jj - 128); }
    return n0;
}
template <int MAP>
__device__ __forceinline__ void prep_matrix(const float* W, int K, int N, bf16_t* WT, const float* gs, LAS float* scr, int lane, int gw, int NGW, int& base) {
    const int nblk = N / 32, nitems = (K / 64) * nblk;
    int first = gw - (base % NGW); if (first < 0) first += NGW;
    for (int item = first; item < nitems; item += NGW) {
        const int kb = item / nblk, nb = item % nblk, k0 = 64 * kb, n0 = 32 * nb, sc = colmap<MAP>(n0);
        float wv[32];
#pragma unroll
        for (int i = 0; i < 32; ++i) { const int kk = 2 * i + (lane >> 5); wv[i] = W[(size_t)(k0 + kk) * N + sc + (lane & 31)]; }
        if (gs) {
#pragma unroll
            for (int i = 0; i < 32; ++i) wv[i] *= gs[k0 + 2 * i + (lane >> 5)];
        }
#pragma unroll
        for (int i = 0; i < 32; ++i) scr[(2 * i + (lane >> 5)) * 33 + (lane & 31)] = wv[i];
        asm volatile("s_waitcnt lgkmcnt(0)" ::: "memory");
        const int c = lane & 7;
#pragma unroll
        for (int j = 0; j < 4; ++j) { const int n = (lane >> 3) + 8 * j; const LAS float* s = scr + (8 * c) * 33 + n;
            u32x4 o; o.x = cvt_pk_bf16(s[0 * 33], s[1 * 33]); o.y = cvt_pk_bf16(s[2 * 33], s[3 * 33]); o.z = cvt_pk_bf16(s[4 * 33], s[5 * 33]); o.w = cvt_pk_bf16(s[6 * 33], s[7 * 33]);
            *(u32x4*)(WT + (size_t)(n0 + n) * K + k0 + 8 * c) = o; }
        asm volatile("s_waitcnt lgkmcnt(0)" ::: "memory");
    }
    base += nitems;
}

__device__ __forceinline__ void prep_phase(const Args& a, LAS unsigned char* lds) {
    unsigned char* const wsl = ws_of(a); float* const outl = out_of(a); const int tidl = tid_l();
    const int tid = tidl, lane = tid & 63, wave = tid >> 6;
    const int gw = blockIdx.x * NWAVES + wave, NGW = gridDim.x * NWAVES;
    LAS float* scr = (LAS float*)(lds + wave * 16384);
    unsigned char* ws = wsl;
    { float* z = (float*)(ws + WS_SS) + M; const int nz = 9 * M; for (int i = blockIdx.x * NTHREADS + tid; i < nz; i += gridDim.x * NTHREADS) z[i] = 0.f; }
    { float* ss0 = (float*)(ws + WS_SS); bf16_t* xb = (bf16_t*)(ws + WS_XB);
      for (int row = gw; row < M; row += NGW) {
          const float* xr = row < MP ? ldp(a, I_XP) + (size_t)row * D : ldp(a, I_XS) + (size_t)(row - MP) * D;
          float s = 0.f;
#pragma unroll
          for (int j = 0; j < 2; ++j) { const f32x4 v0 = *(const f32x4*)(xr + j * 512 + lane * 8), v1 = *(const f32x4*)(xr + j * 512 + lane * 8 + 4);
              s += (v0[0] * v0[0] + v0[1] * v0[1]) + (v0[2] * v0[2] + v0[3] * v0[3]) + (v1[0] * v1[0] + v1[1] * v1[1]) + (v1[2] * v1[2] + v1[3] * v1[3]);
              store_bf16x8(xb + (size_t)row * D + j * 512 + lane * 8, v0, v1); }
          s = wave_sum(s); if (lane == 0) ss0[row] = s; } }
    int base = 0;
    for (int j = 0; j < 2; ++j) {
        prep_matrix<1>(ldp(a, I_AWIN) + (size_t)j * 1024 * 3072, 1024, 3072, (bf16_t*)(ws + WS_AIN + j * SZ_AIN), ldp(a, I_GMIX) + (size_t)(3 * j) * D, scr, lane, gw, NGW, base);
        prep_matrix<0>(ldp(a, I_AWOUT) + (size_t)j * 1024 * 1024, 1024, 1024, (bf16_t*)(ws + WS_AOUT + j * SZ_SQ), nullptr, scr, lane, gw, NGW, base);
    }
    prep_matrix<0>(ldp(a, I_BWIN), 1024, 2048, (bf16_t*)(ws + WS_BIN), ldp(a, I_GMIX) + (size_t)1 * D, scr, lane, gw, NGW, base);
    prep_matrix<0>(ldp(a, I_BWOUT), 1024, 1024, (bf16_t*)(ws + WS_BOUT), nullptr, scr, lane, gw, NGW, base);
    for (int g = 0; g < 4; ++g) prep_matrix<0>(ldp(a, I_CWG) + (size_t)g * 65536, 256, 256, (bf16_t*)(ws + WS_CG) + (size_t)g * 65536, nullptr, scr, lane, gw, NGW, base);
    for (int i = 0; i < 4; ++i) {
        prep_matrix<2>(ldp(a, I_FWUP) + (size_t)i * 1024 * 5632, 1024, 5632, (bf16_t*)(ws + WS_UP + i * SZ_UP), ldp(a, I_GFFN) + (size_t)i * D, scr, lane, gw, NGW, base);
        prep_matrix<0>(ldp(a, I_FWDN) + (size_t)i * 2816 * 1024, 2816, 1024, (bf16_t*)(ws + WS_DN + i * SZ_DN), nullptr, scr, lane, gw, NGW, base);
    }
}

__device__ __forceinline__ void aconv_phase(const Args& a, int j) {
    unsigned char* const wsl = ws_of(a); float* const outl = out_of(a); const int tidl = tid_l();
    const bf16_t* BG = (const bf16_t*)(wsl + WS_T1); const bf16_t* CV = (const bf16_t*)(wsl + WS_T2); bf16_t* ZB = (bf16_t*)(wsl + WS_T3);
    const float* cw = ldp(a, I_ACONV) + (size_t)j * 3 * D; const float* st = ldp(a, I_SSC) + (size_t)j * DECB * 2 * D;
    const int tid = tidl, c8 = (tid & 127) * 8, rsub = tid >> 7;
    f32x4 w[3][2];
#pragma unroll
    for (int k = 0; k < 3; ++k) { w[k][0] = *(const f32x4*)(cw + k * D + c8); w[k][1] = *(const f32x4*)(cw + k * D + c8 + 4); }
    for (int r4 = blockIdx.x; r4 < M / 4; r4 += gridDim.x) {
        const int row = r4 * 4 + rsub;
        int t; const float* sp = nullptr;
        if (row < MP) t = row & (SEQ - 1); else { const int rr = row - MP; t = rr & 7; sp = st + (size_t)(rr >> 3) * 2 * D + c8; }
        f32x4 x[3][2];
#pragma unroll
        for (int k = 0; k < 3; ++k) {
            const int tt = t - 2 + k;
            if (tt >= 0) { const u32x4 v = *(const u32x4*)(CV + (size_t)(row - 2 + k) * D + c8);
                x[k][0] = (f32x4){bf_lo(v.x), bf_hi(v.x), bf_lo(v.y), bf_hi(v.y)}; x[k][1] = (f32x4){bf_lo(v.z), bf_hi(v.z), bf_lo(v.w), bf_hi(v.w)}; }
            else if (sp) { x[k][0] = *(const f32x4*)(sp + (size_t)(2 + tt) * D); x[k][1] = *(const f32x4*)(sp + (size_t)(2 + tt) * D + 4); }
            else { x[k][0] = (f32x4){0.f, 0.f, 0.f, 0.f}; x[k][1] = x[k][0]; }
        }
        const u32x4 b = *(const u32x4*)(BG + (size_t)row * D + c8);
        const f32x4 b0 = (f32x4){bf_lo(b.x), bf_hi(b.x), bf_lo(b.y), bf_hi(b.y)}, b1 = (f32x4){bf_lo(b.z), bf_hi(b.z), bf_lo(b.w), bf_hi(b.w)};
        const f32x4 y0 = w[0][0] * x[0][0] + w[1][0] * x[1][0] + w[2][0] * x[2][0], y1 = w[0][1] * x[0][1] + w[1][1] * x[1][1] + w[2][1] * x[2][1];
        store_bf16x8(ZB + (size_t)row * D + c8, b0 * y0, b1 * y1);
    }
}

__device__ __forceinline__ void spatial_phase(const Args& a) {
    unsigned char* const wsl = ws_of(a); float* const outl = out_of(a); const int tidl = tid_l();
    const bf16_t* U = (const bf16_t*)(wsl + WS_T1); const bf16_t* VT = (const bf16_t*)(wsl + WS_T2); bf16_t* ZB = (bf16_t*)(wsl + WS_T3);
    const float* VS = (const float*)(wsl + WS_VS); const float* vss = (const float*)(wsl + WS_VSS);
    const float* Ws = ldp(a, I_BWS); const float* bias = ldp(a, I_BBIAS); const float* gv = ldp(a, I_BGV);
    const int tid = tidl, lane = tid & 63, w = tid >> 6, fr = lane & 15, fq = lane >> 4;
    for (int unit = blockIdx.x; unit < 512 + DECB; unit += gridDim.x) {
        if (unit < 512) {
            const int c = unit >> 2, h = unit & 3, rb = c * 128, t = 16 * w + fr;
            f32x4 acc[16];
#pragma unroll
            for (int i = 0; i < 16; ++i) acc[i] = (f32x4){0.f, 0.f, 0.f, 0.f};
            const int nks = (w >> 1) + 1;
            for (int ks = 0; ks < nks; ++ks) {
                const int s0 = ks * 32 + 8 * fq;
                const float* wp = Ws + ((size_t)(h * 128 + t) * 128 + s0);
                const f32x4 wa = *(const f32x4*)wp, wb = *(const f32x4*)(wp + 4);
                const f32x4 va = *(const f32x4*)(vss + rb + s0), vb = *(const f32x4*)(vss + rb + s0 + 4);
                float wv[8];
#pragma unroll
                for (int i = 0; i < 4; ++i) { wv[i] = (s0 + i <= t) ? wa[i] * rstd_of(va[i]) : 0.f; wv[4 + i] = (s0 + 4 + i <= t) ? wb[i] * rstd_of(vb[i]) : 0.f; }
                u32x4 wpk; wpk.x = cvt_pk_bf16(wv[0], wv[1]); wpk.y = cvt_pk_bf16(wv[2], wv[3]); wpk.z = cvt_pk_bf16(wv[4], wv[5]); wpk.w = cvt_pk_bf16(wv[6], wv[7]);
                const bf16x8 Wf = __builtin_bit_cast(bf16x8, wpk);
                bf16x8 vf[16];
#pragma unroll
                for (int dt = 0; dt < 16; ++dt) vf[dt] = *(const bf16x8*)(VT + (size_t)(h * 256 + dt * 16 + fr) * MP + rb + s0);
                __builtin_amdgcn_sched_barrier(0);
#pragma unroll
                for (int dt = 0; dt < 16; ++dt) acc[dt] = __builtin_amdgcn_mfma_f32_16x16x32_bf16(vf[dt], Wf, acc[dt], 0, 0, 0);
            }
            const int row = rb + t; const float bs = bias[h * 128 + t];
#pragma unroll
            for (int dt = 0; dt < 16; ++dt) {
                const int ch = h * 256 + dt * 16 + 4 * fq;
                const f32x4 g4 = *(const f32x4*)(gv + ch);
                const u32x2 uu = *(const u32x2*)(U + (size_t)row * D + ch);
                const f32x4 u4 = (f32x4){bf_lo(uu.x), bf_hi(uu.x), bf_lo(uu.y), bf_hi(uu.y)};
                const f32x4 z = u4 * (acc[dt] * g4 + bs);
                u32x2 o; o.x = cvt_pk_bf16(z[0], z[1]); o.y = cvt_pk_bf16(z[2], z[3]);
                *(u32x2*)(ZB + (size_t)row * D + ch) = o;
            }
        } else {
            const int b = unit - 512, r0 = MP + 8 * b, ch = 2 * tid, h = ch >> 8;
            float v0[8], v1[8], rv[8];
#pragma unroll
            for (int s = 0; s < 8; ++s) { rv[s] = rstd_of(vss[r0 + s]); const f32x2 vv = *(const f32x2*)(VS + (size_t)(8 * b + s) * D + ch); v0[s] = vv.x * rv[s]; v1[s] = vv.y * rv[s]; }
            const f32x2 g2 = *(const f32x2*)(gv + ch);
            float* cvo = outl + O_CV + (size_t)(8 * b) * D + ch;
#pragma unroll
            for (int t = 0; t < 8; ++t) {
                float s0 = 0.f, s1 = 0.f;
#pragma unroll
                for (int s = 0; s <= t; ++s) { const float ww = Ws[(size_t)(h * 128 + t) * 128 + s]; s0 += ww * v0[s]; s1 += ww * v1[s]; }
                const float bs = bias[h * 128 + t];
                const unsigned uu = *(const unsigned*)(U + (size_t)(r0 + t) * D + ch);
                const float z0 = bf_lo(uu) * (s0 * g2.x + bs), z1 = bf_hi(uu) * (s1 * g2.y + bs);
                *(unsigned*)(ZB + (size_t)(r0 + t) * D + ch) = cvt_pk_bf16(z0, z1);
                *(f32x2*)(cvo + (size_t)t * D) = (f32x2){v0[t] * g2.x, v1[t] * g2.y};
            }
        }
    }
}

__device__ __forceinline__ void pool_phase(const Args& a, LAS unsigned char* lds, const float* ssk, const float* gm) {
    unsigned char* const wsl = ws_of(a); float* const outl = out_of(a); const int tidl = tid_l();
    const float* X = (const float*)(wsl + WS_X); bf16_t* DB = (bf16_t*)(wsl + WS_T1);
    const float* st = ldp(a, I_SPOOL);
    LAS float* H = (LAS float*)lds;
    const int tid = tidl, q = tid & 255, c4 = q * 4, rsub = tid >> 8, win = 2 << (c4 >> 8);
    const f32x4 g4 = *(const f32x4*)(gm + c4);
    for (int strip = blockIdx.x; strip < 1024 + DECB; strip += gridDim.x) {
        const bool prompt = strip < 1024;
        const int b = strip - 1024;
        const int row0 = prompt ? strip * 16 : MP + b * 8;
        const int t0 = prompt ? (row0 & (SEQ - 1)) : 0;
        f32x4 v[16]; float sv[16];
#pragma unroll
        for (int k = 0; k < 16; ++k) {
            const int i = rsub + 2 * k;
            v[k] = (f32x4){0.f, 0.f, 0.f, 0.f}; sv[k] = -1.f;
            if (prompt) { if (i < 31 && t0 - 15 + i >= 0) { const int row = row0 - 15 + i; v[k] = *(const f32x4*)(X + (size_t)row * D + c4); sv[k] = ssk[row]; } }
            else { if (i < 15) v[k] = *(const f32x4*)(st + ((size_t)b * 15 + i) * D + c4);
                   else if (i < 23) { const int row = row0 + (i - 15); v[k] = *(const f32x4*)(X + (size_t)row * D + c4); sv[k] = ssk[row]; } }
        }
#pragma unroll
        for (int k = 0; k < 16; ++k) { const int i = rsub + 2 * k; if (i < 31) { const f32x4 hv = sv[k] >= 0.f ? v[k] * (g4 * rstd_of(sv[k])) : v[k]; *(LAS f32x4*)(H + i * 1024 + c4) = hv; } }
        __syncthreads();
        const int nper = prompt ? 8 : 4, r0 = rsub * nper;
        f32x4 s = (f32x4){0.f, 0.f, 0.f, 0.f};
        for (int k = 0; k < win; ++k) s += *(const LAS f32x4*)(H + (15 + r0 - k) * 1024 + c4);
        for (int rr = 0; rr < nper; ++rr) {
            const int r = r0 + rr, t = t0 + r;
            const f32x4 hc = *(const LAS f32x4*)(H + (15 + r) * 1024 + c4);
            const float cnt = prompt ? (float)((t + 1 < win) ? t + 1 : win) : (float)win;
            const f32x4 d = s * (1.0f / cnt) - hc;
            u32x2 o; o.x = cvt_pk_bf16(d[0], d[1]); o.y = cvt_pk_bf16(d[2], d[3]);
            *(u32x2*)(DB + (size_t)(row0 + r) * D + c4) = o;
            if (rr + 1 < nper) s += *(const LAS f32x4*)(H + (15 + r + 1) * 1024 + c4) - *(const LAS f32x4*)(H + (15 + r + 1 - win) * 1024 + c4);
        }
        if (prompt) {
            if (t0 == SEQ - 16) { for (int r = 1 + rsub; r < 16; r += 2) *(f32x4*)(outl + O_PP + ((size_t)(row0 >> 11) * 15 + (r - 1)) * D + c4) = *(const LAS f32x4*)(H + (15 + r) * 1024 + c4); }
        } else {
            for (int kk = rsub; kk < 15; kk += 2) *(f32x4*)(outl + O_PS + ((size_t)b * 15 + kk) * D + c4) = *(const LAS f32x4*)(H + (8 + kk) * 1024 + c4);
        }
        __syncthreads();
    }
}

__device__ __forceinline__ void ffn_fix_phase(const Args& a, int layer) {
    unsigned char* const wsl = ws_of(a); float* const outl = out_of(a); const int tidl = tid_l();
    const float* fxp = (const float*)(wsl + WS_FXP); const float* fxa = (const float*)(wsl + WS_FXA); const float* gl = (const float*)(wsl + WS_GL);
    bf16_t* MB = (bf16_t*)(wsl + WS_MB); const float* cw = ldp(a, I_FCONV) + (size_t)layer * 3 * DFF;
    const int total = 256 * 2 * (DFF / 4);
    for (int i = blockIdx.x * NTHREADS + tidl; i < total; i += gridDim.x * NTHREADS) {
        const int c4 = (i % (DFF / 4)) * 4, gr = i / (DFF / 4), G = gr >> 1, r = gr & 1;
        if ((G & 31) == 0) continue;
        const f32x4 w0 = *(const f32x4*)(cw + c4), w1 = *(const f32x4*)(cw + DFF + c4);
        f32x4 pre = *(const f32x4*)(fxp + ((size_t)G * 2 + r) * DFF + c4);
        const f32x4 gm1 = *(const f32x4*)(gl + ((size_t)(G - 1) * 2 + 1) * DFF + c4);
        if (r == 0) { const f32x4 gm2 = *(const f32x4*)(gl + ((size_t)(G - 1) * 2 + 0) * DFF + c4); pre += w1 * gm1 + w0 * gm2; }
        else pre += w0 * gm1;
        const f32x4 av = *(const f32x4*)(fxa + ((size_t)G * 2 + r) * DFF + c4);
        u32x2 o; o.x = cvt_pk_bf16(silu_f(pre[0]) * av[0], silu_f(pre[1]) * av[1]); o.y = cvt_pk_bf16(silu_f(pre[2]) * av[2], silu_f(pre[3]) * av[3]);
        *(u32x2*)(MB + (size_t)(G * 64 + r) * DFF + c4) = o;
    }
}


template <int nsplit> __device__ __forceinline__ void sample_fin_phase(const Args& a, float* ssn, const float* xin_s) {
    unsigned char* const wsl = ws_of(a); const int tidl = tid_l();
    float* X = (float*)(wsl + WS_X); bf16_t* XB = (bf16_t*)(wsl + WS_XB); const float* part = (const float*)(wsl + WS_PART);
    const int lane = tidl & 63, gw = blockIdx.x * NWAVES + (tidl >> 6), NGW = gridDim.x * NWAVES;
    for (int r = gw; r < MS; r += NGW) {
        const int row = MP + r, pmq = r >> 8, rl = r & 255; float s = 0.f;
        f32x4 v[4];
#pragma unroll
        for (int j = 0; j < 4; ++j) v[j] = *(const f32x4*)(xin_s + (size_t)r * D + j * 256 + lane * 4);
#pragma unroll
        for (int kc = 0; kc < nsplit; ++kc) {
#pragma unroll
            for (int j = 0; j < 4; ++j) v[j] += *(const f32x4*)(part + ((size_t)((pmq * 4 + j) * nsplit + kc) * 65536) + (size_t)rl * 256 + lane * 4);
        }
#pragma unroll
        for (int j = 0; j < 4; ++j) {
            *(f32x4*)(X + (size_t)row * D + j * 256 + lane * 4) = v[j];
            u32x2 o; o.x = cvt_pk_bf16(v[j][0], v[j][1]); o.y = cvt_pk_bf16(v[j][2], v[j][3]);
            *(u32x2*)(XB + (size_t)row * D + j * 256 + lane * 4) = o;
            s += (v[j][0] * v[j][0] + v[j][1] * v[j][1]) + (v[j][2] * v[j][2] + v[j][3] * v[j][3]);
        }
        s = wave_sum(s); if (lane == 0) ssn[row] = s;
    }
}

__device__ __forceinline__ void final_phase(const Args& a) {
    unsigned char* const wsl = ws_of(a); float* const outl = out_of(a); const int tidl = tid_l();
    const float* X = (const float*)(wsl + WS_X); const float* ss8 = (const float*)(wsl + WS_SS) + (size_t)8 * M; const float* gf = ldp(a, I_GFIN);
    const int lane = tidl & 63, gw = blockIdx.x * NWAVES + (tidl >> 6), NGW = gridDim.x * NWAVES;
    f32x4 g[4];
#pragma unroll
    for (int j = 0; j < 4; ++j) g[j] = *(const f32x4*)(gf + j * 256 + lane * 4);
    for (int row = gw; row < M; row += NGW) {
        const float r = rstd_of(ss8[row]);
        f32x4 xv[4];
#pragma unroll
        for (int j = 0; j < 4; ++j) xv[j] = *(const f32x4*)(X + (size_t)row * D + j * 256 + lane * 4);
#pragma unroll
        for (int j = 0; j < 4; ++j) *(f32x4*)(outl + (size_t)row * D + j * 256 + lane * 4) = xv[j] * (g[j] * r);
    }
}


#define XB_TMO      128
#define XB_XCNT(j)  (256  + 64 * (j))
#define XB_XSUB(j)  (1280 + 64 * (j))
#define XB_XGEN(j)  (2304 + 64 * (j))
#define XB_TOP      3328
#define XB_TOPGEN   3392
#define XCD_BAR_WORDS 3456
#define XB_SPIN_CAP (1u << 22)
__device__ __forceinline__ unsigned xb_ld(unsigned* p)              { return __hip_atomic_load(p, __ATOMIC_RELAXED, __HIP_MEMORY_SCOPE_AGENT); }
__device__ __forceinline__ unsigned xb_add(unsigned* p, unsigned v) { return __hip_atomic_fetch_add(p, v, __ATOMIC_RELAXED, __HIP_MEMORY_SCOPE_AGENT); }
__device__ __forceinline__ unsigned xb_xcc_id() { return (unsigned)__builtin_amdgcn_s_getreg((3 << 11) | 20) & 0xFu; }
#define XB_SPIN(cond, bar) do { unsigned _sp = 0; while (cond) { __builtin_amdgcn_s_sleep(1); \
    if ((++_sp & 255u) == 0u) { if (xb_ld(&(bar)[XB_TMO])) break; if (_sp > XB_SPIN_CAP) { atomicAdd(&(bar)[XB_TMO], 1u); break; } } } } while (0)
struct XcdBarrier { unsigned* bar; unsigned x; volatile LAS unsigned* st; };
__device__ __forceinline__ XcdBarrier xcd_barrier_post(unsigned* bar, volatile LAS unsigned* st) {
    XcdBarrier b; b.bar = bar; b.x = xb_xcc_id(); b.st = st;
    if (threadIdx.x == 0) (void)xb_add(&bar[XB_XCNT(b.x)], 1u);
    return b;
}
__device__ __forceinline__ void xcd_barrier_complete(unsigned* bar, unsigned x, unsigned& nloc, unsigned& nx) {
    const unsigned G = gridDim.x * gridDim.y * gridDim.z;
    unsigned sum, cnt, mine, sp = 0u;
    for (;;) {
        sum = 0u; cnt = 0u; mine = 0u;
#pragma unroll
        for (unsigned j = 0; j < 16; ++j) { const unsigned c = xb_ld(&bar[XB_XCNT(j)]); sum += c; cnt += (c > 0u) ? 1u : 0u; mine = (j == x) ? c : mine; }
        if (sum == G) break;
        __builtin_amdgcn_s_sleep(1);
        if ((++sp & 255u) == 0u) { if (xb_ld(&bar[XB_TMO])) break; if (sp > XB_SPIN_CAP) { atomicAdd(&bar[XB_TMO], 1u); break; } }
    }
    nloc = mine > 0u ? mine : 1u; nx = cnt > 0u ? cnt : 1u;
}
__device__ __forceinline__ void xcd_barrier(const XcdBarrier& b) {
    asm volatile("s_waitcnt vmcnt(0)" ::: "memory");
    __syncthreads();
    if (threadIdx.x == 0) {
        unsigned* bar = b.bar;
        __builtin_amdgcn_s_waitcnt(0);
        unsigned nloc = b.st[0], nx = b.st[1];
        if (nloc == 0u) { xcd_barrier_complete(bar, b.x, nloc, nx); b.st[0] = nloc; b.st[1] = nx; }
        const unsigned old = xb_add(&bar[XB_XSUB(b.x)], 1u);
        const unsigned gen = old / nloc;
        if (old + 1u == (gen + 1u) * nloc) {
            __builtin_amdgcn_fence(__ATOMIC_RELEASE, "agent");
            asm volatile("s_waitcnt vmcnt(0)" ::: "memory");
            const unsigned og = xb_add(&bar[XB_TOP], 1u);
            const unsigned tg = og / nx;
            if (og + 1u == (tg + 1u) * nx) xb_add(&bar[XB_TOPGEN], 1u);
            else XB_SPIN(xb_ld(&bar[XB_TOPGEN]) == tg, bar);
            __builtin_amdgcn_fence(__ATOMIC_ACQUIRE, "agent");
            xb_add(&bar[XB_XGEN(b.x)], 1u);
            asm volatile("s_waitcnt vmcnt(0)" ::: "memory");
        } else {
            XB_SPIN(xb_ld(&bar[XB_XGEN(b.x)]) == gen, bar);
            __builtin_amdgcn_fence(__ATOMIC_ACQUIRE, "agent");
            asm volatile("s_waitcnt vmcnt(0)" ::: "memory");
        }
    }
    __syncthreads();
}

constexpr int LDS_BYTES = 147456;
constexpr int REP_SYNC = 1, REP_MISC = 1, REP_UP = 1, REP_IN = 1;
constexpr int N_PHASES = 32;

__global__ void __launch_bounds__(NTHREADS, 2) trunk_fwd(Args a) {
    extern __shared__ __attribute__((aligned(16))) unsigned char lds_raw[];
    LAS unsigned char* lds = (LAS unsigned char*)lds_raw;
    cg::grid_group grid = cg::this_grid();
    volatile LAS unsigned* misc = (volatile LAS unsigned*)(lds + 131072 + 512);
    if (threadIdx.x < 2) misc[threadIdx.x] = 0u;
    __syncthreads();
    const XcdBarrier xbar = xcd_barrier_post((unsigned*)(a.ws + WS_BAR), misc);
    int ph = 0;
#define GSYNC() do { if (ph == 0) grid.sync(); else xcd_barrier(xbar); } while (0)
#define PHASE_BEGIN_R(reps) if (ph >= a.ph_lo && ph < a.ph_hi) { for (int rep_ = 0; rep_ < (reps); ++rep_) { if (rep_) GSYNC(); unsigned char* const ws = ws_of(a); const int G = gridDim.x, bx = blockIdx.x; (void)ws; (void)G; (void)bx;
#define PHASE_BEGIN PHASE_BEGIN_R(1)
#define PHASE_END   } if (ph + 1 < a.ph_hi) { for (int s_ = 0; s_ < REP_SYNC; ++s_) GSYNC(); } } ++ph;
#define SSP(k) ((float*)(ws + WS_SS) + (size_t)(k) * M)
#define XP ((float*)(ws + WS_X))
#define XBP ((bf16_t*)(ws + WS_XB))
#define T1P ((bf16_t*)(ws + WS_T1))
#define T2P ((bf16_t*)(ws + WS_T2))
#define T3P ((bf16_t*)(ws + WS_T3))

    PHASE_BEGIN_R(REP_MISC) prep_phase(a, lds); PHASE_END

    for (int layer = 0; layer < 4; ++layer) {
        const int kind = layer % 3, j = layer / 3;
        if (kind == 0) {
            PHASE_BEGIN_R(REP_IN)
                pg8::Gemm g{XBP, (const bf16_t*)(ws + WS_AIN + j * SZ_AIN), D, D, D, 68, 12, 0}; pg8::StaticOrder S; S.init(68, 12, G, bx, D);
                EpiAin E{SSP(2 * layer), T1P, T2P, out_of(a) + O_SCP + (size_t)j * 8 * 2 * D, out_of(a) + O_SCS + (size_t)j * DECB * 2 * D};
                pg8::gemm_phase(lds, g, S, E);
            PHASE_END
            PHASE_BEGIN_R(REP_MISC) aconv_phase(a, j); PHASE_END
            PHASE_BEGIN
                pg8::Gemm g{T3P, (const bf16_t*)(ws + WS_AOUT + j * SZ_SQ), D, D, D, 68, 4, 0}; pg8::StaticOrder S; S.init(64, 4, G, bx, D, 4, 4, 256);
                EpiRes<false> E{layer == 0 ? ldp(a, I_XP) : XP, layer == 0 ? ldp(a, I_XS) : XP + (size_t)MP * D, XP, XBP, SSP(2 * layer + 1), nullptr, (float*)(ws + WS_PART)};
                pg8::gemm_phase(lds, g, S, E);
            PHASE_END
            PHASE_BEGIN sample_fin_phase<4>(a, SSP(2 * layer + 1), layer == 0 ? ldp(a, I_XS) : (const float*)(XP + (size_t)MP * D)); PHASE_END
        } else if (kind == 1) {
            PHASE_BEGIN
                pg8::Gemm g{XBP, (const bf16_t*)(ws + WS_BIN), D, D, D, 68, 8, 0}; pg8::StaticOrder S; S.init(68, 8, G, bx, D);
                EpiBin E{SSP(2 * layer), T1P, T2P, (float*)(ws + WS_VS), (float*)(ws + WS_VSS)};
                pg8::gemm_phase(lds, g, S, E);
            PHASE_END
            PHASE_BEGIN_R(REP_MISC) spatial_phase(a); PHASE_END
            PHASE_BEGIN
                pg8::Gemm g{T3P, (const bf16_t*)(ws + WS_BOUT), D, D, D, 68, 4, 0}; pg8::StaticOrder S; S.init(64, 4, G, bx, D, 4, 4, 256);
                EpiRes<false> E{XP, XP + (size_t)MP * D, XP, XBP, SSP(2 * layer + 1), nullptr, (float*)(ws + WS_PART)};
                pg8::gemm_phase(lds, g, S, E);
            PHASE_END
            PHASE_BEGIN sample_fin_phase<4>(a, SSP(2 * layer + 1), layer == 0 ? ldp(a, I_XS) : (const float*)(XP + (size_t)MP * D)); PHASE_END
        } else {
            PHASE_BEGIN_R(REP_MISC) pool_phase(a, lds, SSP(2 * layer), ldp(a, I_GMIX) + (size_t)layer * D); PHASE_END
            PHASE_BEGIN
                pg8::Gemm g{T1P, (const bf16_t*)(ws + WS_CG), D, 256, 256, 68, 4, 256}; pg8::StaticOrder S; S.init(68, 4, G, bx, 256);
                EpiRes<true> E{XP, XP + (size_t)MP * D, XP, XBP, SSP(2 * layer + 1), ldp(a, I_CSCALE), (float*)(ws + WS_PART)};
                pg8::gemm_phase(lds, g, S, E);
            PHASE_END
        }
        PHASE_BEGIN_R(REP_UP)
            pg8::Gemm g{XBP, (const bf16_t*)(ws + WS_UP + layer * SZ_UP), D, D, D, 68, 22, 0}; pg8::StaticOrder S; S.init(68, 22, G, bx, D);
            EpiUp E{SSP(2 * layer + 1), (bf16_t*)(ws + WS_MB), ldp(a, I_FCONV) + (size_t)layer * 3 * DFF, ldp(a, I_FCONVB) + (size_t)layer * DFF, ldp(a, I_SFFN) + (size_t)layer * DECB * 2 * DFF,
                    (float*)(ws + WS_FXP), (float*)(ws + WS_FXA), (float*)(ws + WS_GL), out_of(a) + O_FP + (size_t)layer * 8 * 2 * DFF, out_of(a) + O_FS + (size_t)layer * DECB * 2 * DFF};
            pg8::gemm_phase(lds, g, S, E);
        PHASE_END
        PHASE_BEGIN_R(REP_MISC) ffn_fix_phase(a, layer); PHASE_END
        PHASE_BEGIN
            pg8::Gemm g{(const bf16_t*)(ws + WS_MB), (const bf16_t*)(ws + WS_DN + layer * SZ_DN), DFF, DFF, DFF, 68, 4, 0}; pg8::StaticOrder S; S.init(64, 4, G, bx, DFF, 4, 11, 256);
            EpiRes<false> E{XP, XP + (size_t)MP * D, XP, XBP, SSP(2 * layer + 2), nullptr, (float*)(ws + WS_PART)};
            pg8::gemm_phase(lds, g, S, E);
        PHASE_END
        PHASE_BEGIN sample_fin_phase<11>(a, SSP(2 * layer + 2), (const float*)(XP + (size_t)MP * D)); PHASE_END
    }
    PHASE_BEGIN_R(REP_MISC) final_phase(a); PHASE_END
#undef PHASE_BEGIN
#undef PHASE_BEGIN_R
#undef PHASE_END
}

extern "C" void kernel_launch(void* const* d_in, const int* in_sizes, int n_in, void* d_out, int out_size, void* d_ws, size_t ws_size, hipStream_t stream) {
    static int grid = 0;
    if (grid == 0) {
        if (n_in != 22 || (size_t)out_size != O_END || ws_size < WS_END) { fprintf(stderr, "kernel_launch: unexpected shapes (n_in %d, out %d, ws %zu; need out %zu ws %zu)\n", n_in, out_size, ws_size, (size_t)O_END, (size_t)WS_END); grid = -1; return; }
        int dev = 0, cus = 0, per_cu = 0;
        (void)hipGetDevice(&dev); (void)hipDeviceGetAttribute(&cus, hipDeviceAttributeMultiprocessorCount, dev);
        if (hipFuncSetAttribute((const void*)trunk_fwd, hipFuncAttributeMaxDynamicSharedMemorySize, LDS_BYTES) != hipSuccess) { fprintf(stderr, "kernel_launch: hipFuncSetAttribute failed\n"); grid = -1; return; }
        if (hipOccupancyMaxActiveBlocksPerMultiprocessor(&per_cu, (const void*)trunk_fwd, NTHREADS, LDS_BYTES) != hipSuccess || per_cu < 1) { fprintf(stderr, "kernel_launch: occupancy query says %d\n", per_cu); per_cu = 1; }
        (void)hipGetLastError();
        grid = cus * 1;
        if (grid <= 0) grid = 256;
    }
    if (grid < 0) return;
    Args a{};
    for (int i = 0; i < 22; ++i) a.in[i] = (const float*)d_in[i];
    a.out = (float*)d_out; a.ws = (unsigned char*)d_ws; a.ph_lo = 0; a.ph_hi = N_PHASES;
    if (hipMemsetAsync((char*)d_ws + WS_BAR, 0, BAR_BYTES, stream) != hipSuccess) { fprintf(stderr, "kernel_launch: memset failed\n"); return; }
    void* args[] = {&a};
    hipError_t e = hipLaunchCooperativeKernel((const void*)trunk_fwd, dim3(grid), dim3(NTHREADS), args, LDS_BYTES, stream);
    if (e != hipSuccess) fprintf(stderr, "kernel_launch: cooperative launch failed: %s (grid %d)\n", hipGetErrorString(e), grid);
}
```

```cpp
#include <hip/hip_runtime.h>
#include <hip/hip_cooperative_groups.h>
#include <cstdio>
#include <cstdint>
namespace cg = cooperative_groups;

#define LAS __attribute__((address_space(3)))
typedef unsigned short bf16_t;
typedef short bf16x8 __attribute__((ext_vector_type(8)));
typedef float f32x4 __attribute__((ext_vector_type(4)));
typedef float f32x2 __attribute__((ext_vector_type(2)));
typedef unsigned u32x4 __attribute__((ext_vector_type(4)));
typedef unsigned u32x2 __attribute__((ext_vector_type(2)));

constexpr int D = 1024, SEQ = 2048, MP = 16384, MS = 1024, M = MP + MS, DFF = 2816, NBATCH = 8, DECB = 128, DECS = 8;
constexpr float EPS = 1e-6f;
constexpr int NWAVES = 8, NTHREADS = 512;

constexpr size_t MiB = 1u << 20;
constexpr size_t WS_SS = 0;
constexpr size_t WS_VSS = WS_SS + (size_t)9 * M * 4;
constexpr size_t WS_BAR = 768 * 1024, BAR_BYTES = 16384;
constexpr size_t WS_W = 1 * MiB;
static_assert(WS_VSS + (size_t)M * 4 <= WS_BAR, "SS below the barrier words");
constexpr size_t SZ_AIN = (size_t)3072 * 1024 * 2, SZ_SQ = (size_t)1024 * 1024 * 2, SZ_BIN = (size_t)2048 * 1024 * 2, SZ_CG = (size_t)4 * 256 * 256 * 2;
constexpr size_t SZ_UP = (size_t)5632 * 1024 * 2, SZ_DN = (size_t)1024 * 2816 * 2;
constexpr size_t WS_AIN = WS_W, WS_AOUT = WS_AIN + 2 * SZ_AIN, WS_BIN = WS_AOUT + 2 * SZ_SQ, WS_BOUT = WS_BIN + SZ_BIN, WS_CG = WS_BOUT + SZ_SQ;
constexpr size_t WS_UP = WS_CG + SZ_CG, WS_DN = WS_UP + 4 * SZ_UP, WS_WEND = WS_DN + 4 * SZ_DN;
constexpr size_t WS_X = 90 * MiB;
constexpr size_t WS_XB = WS_X + (size_t)M * D * 4;
constexpr size_t WS_T1 = WS_XB + (size_t)M * D * 2;
constexpr size_t WS_T2 = WS_T1 + (size_t)M * D * 2, WS_T3 = WS_T2 + (size_t)M * D * 2;
constexpr size_t WS_MB = WS_T1;
constexpr size_t WS_VS = WS_T3 + (size_t)M * D * 2;
constexpr size_t WS_FXP = WS_VS + (size_t)MS * D * 4;
constexpr size_t SZ_FX = (size_t)256 * 2 * DFF * 4;
constexpr size_t WS_FXA = WS_FXP + SZ_FX, WS_GL = WS_FXA + SZ_FX;
constexpr size_t WS_PART = WS_X;
constexpr size_t WS_END = WS_GL + SZ_FX;
static_assert(WS_PART + (size_t)176 * 65536 * 4 <= WS_XB, "partial tiles fit");
static_assert(WS_WEND <= WS_X, "weights fit");
static_assert(WS_T1 + (size_t)M * DFF * 2 <= WS_VS, "MB overlays T1..T3");

constexpr size_t O_YP = 0, O_YS = O_YP + (size_t)MP * D, O_SCP = O_YS + (size_t)MS * D, O_SCS = O_SCP + 2 * 8 * 2 * 1024, O_PP = O_SCS + 2 * 128 * 2 * 1024;
constexpr size_t O_PS = O_PP + 8 * 15 * 1024, O_FP = O_PS + 128 * 15 * 1024, O_FS = O_FP + 4 * 8 * 2 * DFF, O_CV = O_FS + 4 * 128 * 2 * DFF, O_END = O_CV + 128 * 8 * 1024;

__device__ __forceinline__ unsigned cvt_pk_bf16(float lo, float hi) { unsigned r; asm volatile("v_cvt_pk_bf16_f32 %0, %1, %2" : "=v"(r) : "v"(lo), "v"(hi)); return r; }
__device__ __forceinline__ float bf_lo(unsigned w) { return __uint_as_float(w << 16); }
__device__ __forceinline__ float bf_hi(unsigned w) { return __uint_as_float(w & 0xffff0000u); }
__device__ __forceinline__ f32x4 bf4_lo(u32x4 v) { return (f32x4){bf_lo(v.x), bf_hi(v.x), bf_lo(v.y), bf_hi(v.y)}; }
__device__ __forceinline__ f32x4 bf4_hi(u32x4 v) { return (f32x4){bf_lo(v.z), bf_hi(v.z), bf_lo(v.w), bf_hi(v.w)}; }
constexpr float SS_FX = 1024.0f;
__device__ __forceinline__ float ss_fix(float s) { return __uint_as_float((unsigned)(s * SS_FX + 0.5f)); }
__device__ __forceinline__ float rstd_of(float ss_raw) { return __builtin_amdgcn_rsqf((float)__float_as_uint(ss_raw) * (1.0f / (SS_FX * 1024.0f)) + EPS); }
__device__ __forceinline__ float silu_f(float x) { return x * __builtin_amdgcn_rcpf(1.0f + __builtin_amdgcn_exp2f(-1.4426950408889634f * x)); }
__device__ __forceinline__ void atomic_addf(float* p, float v) { (void)__hip_atomic_fetch_add((unsigned*)p, (unsigned)(v * SS_FX + 0.5f), __ATOMIC_RELAXED, __HIP_MEMORY_SCOPE_AGENT); }
__device__ __forceinline__ float bperm(float v, int byte_idx) { return __int_as_float(__builtin_amdgcn_ds_bpermute(byte_idx, __float_as_int(v))); }
__device__ __forceinline__ float wave_sum(float v) {
#pragma unroll
    for (int o = 1; o < 64; o <<= 1) v += __shfl_xor(v, o);
    return v;
}

__device__ __forceinline__ int tid_l() { int t = threadIdx.x; asm volatile("" : "+v"(t)); return t; }

namespace pg8 {
constexpr int BM = 256, BK = 64, HALF = 128, HTB = HALF * BK * 2, STAGE_BYTES = 8 * HTB, NXCD = 8, WGM = 8;
__host__ __device__ __forceinline__ int lds_byte(int r, int c) { const int st = (r >> 4) * 2 + (c >> 5), rr = r & 15, cc = c & 31, ob = rr * 64 + cc * 2; return st * 1024 + (ob ^ (((ob >> 9) & 1) << 5)); }
__host__ __device__ __forceinline__ void stage_rc(int b, int& R, int& C) { const int st = b / 1024, sb = b % 1024, swz = sb ^ (((sb >> 9) & 1) << 5); R = (st >> 1) * 16 + swz / 64; C = (st & 1) * 32 + (swz % 64) / 2; }
__host__ __device__ __forceinline__ int perm32(int rho) { const int n = rho >> 4, i = rho & 15; return 8 * (i >> 2) + 4 * n + (i & 3); }

struct Unit { int pm, pn, k0, nt, split, split_id; };
struct Gemm { const bf16_t* A; const bf16_t* Bt; int lda, ldb, K, nM, nN, a_pn_off; };

struct StaticOrder {
    int nM, nN, nwg, G, c, K, nS, nsplit, klen;
    __device__ __forceinline__ void init(int nM_, int nN_, int G_, int c_, int K_, int nS_ = 0, int nsplit_ = 0, int klen_ = 0) { nM = nM_; nN = nN_; nwg = nM * nN; G = G_; c = c_; K = K_; nS = nS_; nsplit = nsplit_; klen = klen_; }
    __device__ __forceinline__ bool next(int i, Unit& u) const {
        const long L = (long)i * G + c;
        if (L >= nwg) {
            const int s = (int)(L - nwg); if (s >= nS * nN * nsplit) return false;
            const int su = s / nsplit, kc = s - su * nsplit;
            u.pm = nM + su / nN; u.pn = su % nN; u.k0 = kc * klen; u.nt = klen / BK; u.split = (nsplit > 1) ? 1 : 0; u.split_id = s; return true;
        }
        int wgid = (int)L; { const int q = nwg / NXCD, r = nwg % NXCD, xcd = wgid % NXCD, off = wgid / NXCD; wgid = (xcd < r ? xcd * (q + 1) : r * (q + 1) + (xcd - r) * q) + off; }
        const int nig = WGM * nN, gid = wgid / nig, fm = gid * WGM, gsz = (nM - fm) < WGM ? (nM - fm) : WGM;
        u.pm = fm + ((wgid % nig) % gsz); u.pn = (wgid % nig) / gsz; u.k0 = 0; u.nt = K / BK; u.split = 0; u.split_id = 0; return true;
    }
};

template <class Epi>
__device__ __forceinline__ void gemm_phase(LAS unsigned char* lds, const Gemm g, const StaticOrder& S, const Epi& E) {
    int tid = threadIdx.x; asm volatile("" : "+v"(tid)); const int wid = __builtin_amdgcn_readfirstlane(tid >> 6), lane = tid & 63, wr = wid >> 2, wc = wid & 3, fr = lane & 15, fq = lane >> 4;
    unsigned voffA[2], voffB[2];
#pragma unroll
    for (int i = 0; i < 2; ++i) { int R, C; stage_rc(tid * 16 + i * 8192, R, C); const int Rb = (R & ~31) + perm32(R & 31);
        voffA[i] = (unsigned)(R * g.lda + C) * 2u; voffB[i] = (unsigned)(Rb * g.ldb + C) * 2u; }
    const unsigned kstep = (unsigned)(BK * 2);
    const unsigned hstepA = (unsigned)HALF * g.lda * 2, hstepB = (unsigned)HALF * g.ldb * 2;
    const unsigned tstepA = 2 * hstepA, tstepB = 2 * hstepB;
    const unsigned ldsw = (unsigned)wid * 1024u;
    const int aoff = lds_byte(wr * 64 + fr, fq * 8), boff = lds_byte(wc * 32 + fr, fq * 8);
#define PG8_SA(b, h) (((b) * 2 + (h)) * HTB)
#define PG8_SB(b, h) ((4 + (b) * 2 + (h)) * HTB)
#define PG8_STAGE(bufoff, gbase, voff) do { _Pragma("unroll") for (int _i = 0; _i < 2; ++_i) \
        __builtin_amdgcn_global_load_lds((const unsigned*)((const char*)(gbase) + (voff)[_i]), (LAS unsigned*)(lds + (bufoff) + ldsw + _i * 8192), 16, 0, 0); } while (0)
#define PG8_LDA(dst, b, h) do { _Pragma("unroll") for (int m = 0; m < 4; ++m) _Pragma("unroll") for (int k = 0; k < 2; ++k) dst[m][k] = *(const LAS bf16x8*)(lds + PG8_SA(b, h) + aoff + m * 2048 + k * 1024); } while (0)
#define PG8_LDB(dst, b, h) do { _Pragma("unroll") for (int n = 0; n < 2; ++n) _Pragma("unroll") for (int k = 0; k < 2; ++k) dst[n][k] = *(const LAS bf16x8*)(lds + PG8_SB(b, h) + boff + n * 2048 + k * 1024); } while (0)
#define PG8_MMA(ai, bj, At, Bt) do { __builtin_amdgcn_s_setprio(1); _Pragma("unroll") for (int m = 0; m < 4; ++m) _Pragma("unroll") for (int n = 0; n < 2; ++n) _Pragma("unroll") for (int k = 0; k < 2; ++k) \
        acc[ai][bj][m][n] = __builtin_amdgcn_mfma_f32_16x16x32_bf16(Bt[n][k], At[m][k], acc[ai][bj][m][n], 0, 0, 0); __builtin_amdgcn_s_setprio(0); } while (0)
#define PG8_WAIT_V(n) asm volatile("s_waitcnt vmcnt(" #n ")" ::: "memory")
#define PG8_WAIT_L(n) asm volatile("s_waitcnt lgkmcnt(" #n ")" ::: "memory")
#define PG8_BAR __builtin_amdgcn_s_barrier()
#define PG8_SCHED __builtin_amdgcn_sched_barrier(0)
    Unit cur, nxt; int ui = 0;
    if (!S.next(0, cur)) return;
    f32x4 acc[2][2][4][2];
#pragma unroll
    for (int a = 0; a < 2; ++a)
#pragma unroll
        for (int b = 0; b < 2; ++b)
#pragma unroll
            for (int m = 0; m < 4; ++m)
#pragma unroll
                for (int n = 0; n < 2; ++n) acc[a][b][m][n] = (f32x4){0.f, 0.f, 0.f, 0.f};
    bf16x8 At[4][2], B0[2][2], B1[2][2];
    const char* cA = (const char*)g.A + (size_t)cur.pm * tstepA + (size_t)(cur.pn * g.a_pn_off + cur.k0) * 2; const char* cB = (const char*)g.Bt + (size_t)cur.pn * tstepB + (size_t)cur.k0 * 2;
    PG8_STAGE(PG8_SB(0, 0), cB, voffB); PG8_STAGE(PG8_SB(0, 1), cB + hstepB, voffB); PG8_STAGE(PG8_SA(0, 0), cA, voffA); PG8_STAGE(PG8_SA(0, 1), cA + hstepA, voffA);
    if (wr == 1) PG8_BAR;
    PG8_WAIT_V(2); PG8_BAR;
    PG8_STAGE(PG8_SB(1, 0), cB + kstep, voffB); PG8_STAGE(PG8_SA(1, 0), cA + kstep, voffA); PG8_STAGE(PG8_SB(1, 1), cB + hstepB + kstep, voffB);
    PG8_WAIT_V(6); PG8_BAR;
    for (;;) {
        const bool has_next = S.next(ui + 1, nxt);
        const char* nA = has_next ? (const char*)g.A + (size_t)nxt.pm * tstepA + (size_t)(nxt.pn * g.a_pn_off + nxt.k0) * 2 : cA; const char* nB = has_next ? (const char*)g.Bt + (size_t)nxt.pn * tstepB + (size_t)nxt.k0 * 2 : cB;
        const int nt = cur.nt;
        for (int t = 0; t < nt; t += 2) {
            const bool last = (t == nt - 2);
            const char* a1 = cA + (unsigned)(t + 1) * kstep;
            const char* a2 = last ? nA : cA + (unsigned)(t + 2) * kstep; const char* b2 = last ? nB : cB + (unsigned)(t + 2) * kstep;
            const char* a3 = a2 + kstep; const char* b3 = b2 + kstep;
            PG8_LDB(B0, 0, 0); PG8_LDB(B1, 0, 1); PG8_SCHED; PG8_LDA(At, 0, 0); PG8_STAGE(PG8_SA(1, 1), a1 + hstepA, voffA);
            PG8_WAIT_V(8); PG8_WAIT_L(0); PG8_BAR; PG8_MMA(0, 0, At, B0); PG8_MMA(0, 1, At, B1); PG8_BAR; PG8_SCHED;
            PG8_LDA(At, 0, 1); PG8_STAGE(PG8_SB(0, 0), b2, voffB); PG8_STAGE(PG8_SB(0, 1), b2 + hstepB, voffB); PG8_STAGE(PG8_SA(0, 0), a2, voffA);
            PG8_WAIT_V(8); PG8_WAIT_L(0); PG8_BAR; PG8_MMA(1, 0, At, B0); PG8_MMA(1, 1, At, B1); PG8_BAR; PG8_SCHED;
            PG8_LDB(B0, 1, 0); PG8_LDB(B1, 1, 1); PG8_SCHED; PG8_LDA(At, 1, 0); PG8_STAGE(PG8_SA(0, 1), a2 + hstepA, voffA);
            PG8_WAIT_V(8); PG8_WAIT_L(0); PG8_BAR; PG8_MMA(0, 0, At, B0); PG8_MMA(0, 1, At, B1); PG8_BAR; PG8_SCHED;
            PG8_LDA(At, 1, 1); PG8_STAGE(PG8_SB(1, 0), b3, voffB); PG8_STAGE(PG8_SB(1, 1), b3 + hstepB, voffB); PG8_STAGE(PG8_SA(1, 0), a3, voffA);
            PG8_WAIT_V(8); PG8_WAIT_L(0); PG8_BAR; PG8_MMA(1, 0, At, B0); PG8_MMA(1, 1, At, B1); PG8_BAR; PG8_SCHED;
        }
        if (wr == 0) PG8_BAR;
        { const int tl = tid_l(); E(acc, cur, wr, wc, tl & 15, (tl >> 4) & 3); }
        if (!has_next) break;
#pragma unroll
        for (int a = 0; a < 2; ++a)
#pragma unroll
            for (int b = 0; b < 2; ++b)
#pragma unroll
                for (int m = 0; m < 4; ++m)
#pragma unroll
                    for (int n = 0; n < 2; ++n) acc[a][b][m][n] = (f32x4){0.f, 0.f, 0.f, 0.f};
        cur = nxt; cA = nA; cB = nB; ++ui;
        if (wr == 1) PG8_BAR;
    }
    PG8_WAIT_V(0);
    PG8_BAR;
#undef PG8_SA
#undef PG8_SB
#undef PG8_STAGE
#undef PG8_LDA
#undef PG8_LDB
#undef PG8_MMA
#undef PG8_WAIT_V
#undef PG8_WAIT_L
#undef PG8_BAR
#undef PG8_SCHED
}
}

typedef f32x4 AccT[2][2][4][2];
__device__ __forceinline__ void store_bf16x8(bf16_t* p, f32x4 v0, f32x4 v1) {
    u32x4 w; w.x = cvt_pk_bf16(v0[0], v0[1]); w.y = cvt_pk_bf16(v0[2], v0[3]); w.z = cvt_pk_bf16(v1[0], v1[1]); w.w = cvt_pk_bf16(v1[2], v1[3]); *(u32x4*)p = w;
}

__device__ __forceinline__ void load_rstd8(const float* ss, int pm, int wr, int fr, float (&r)[2][4]) {
    float t[2][4];
#pragma unroll
    for (int ai = 0; ai < 2; ++ai)
#pragma unroll
        for (int m = 0; m < 4; ++m) t[ai][m] = ss[pm * 256 + ai * 128 + wr * 64 + m * 16 + fr];
#pragma unroll
    for (int ai = 0; ai < 2; ++ai)
#pragma unroll
        for (int m = 0; m < 4; ++m) r[ai][m] = rstd_of(t[ai][m]);
}

template <bool HAS_CS, bool IN_F32> struct EpiRes {
    const float* xin_p; const float* xin_s; bf16_t* xb; float* ssn; const float* cs; float* part;
    __device__ __forceinline__ void operator()(const AccT& acc, const pg8::Unit& u, int wr, int wc, int fr, int fq) const {
        asm volatile("" : "+v"(fr), "+v"(fq));
        const int colb = u.pn * 256 + wc * 32 + 8 * fq;
        if (u.split) {
            float* pt = part + (size_t)u.split_id * 65536;
#pragma unroll
            for (int ai = 0; ai < 2; ++ai)
#pragma unroll
                for (int m = 0; m < 4; ++m) {
                    float* po = pt + (size_t)(ai * 128 + wr * 64 + m * 16 + fr) * 256 + wc * 32 + 8 * fq;
#pragma unroll
                    for (int bj = 0; bj < 2; ++bj) { *(f32x4*)(po + 128 * bj) = acc[ai][bj][m][0]; *(f32x4*)(po + 128 * bj + 4) = acc[ai][bj][m][1]; }
                }
            return;
        }
        char* xbu = (char*)(xb + (size_t)(u.pm * 256 + wr * 64) * D + u.pn * 256);
        const unsigned lofs = (unsigned)(fr * D + wc * 32 + 8 * fq) * 2u;
#pragma unroll
        for (int ai = 0; ai < 2; ++ai) {
            f32x4 x0[4][2], x1[4][2];
            if (IN_F32) {
#pragma unroll
                for (int m = 0; m < 4; ++m) {
                    const int row = u.pm * 256 + ai * 128 + wr * 64 + m * 16 + fr;
                    const float* xi = (u.pm < 64) ? xin_p + (size_t)row * D : xin_s + (size_t)(row - MP) * D;
#pragma unroll
                    for (int bj = 0; bj < 2; ++bj) { x0[m][bj] = *(const f32x4*)(xi + colb + 128 * bj); x1[m][bj] = *(const f32x4*)(xi + colb + 128 * bj + 4); }
                }
            } else {
                u32x4 xr[4][2];
#pragma unroll
                for (int m = 0; m < 4; ++m)
#pragma unroll
                    for (int bj = 0; bj < 2; ++bj) xr[m][bj] = *(const u32x4*)(xbu + (lofs + (unsigned)(((ai * 128 + m * 16) * D + 128 * bj) * 2)));
#pragma unroll
                for (int m = 0; m < 4; ++m)
#pragma unroll
                    for (int bj = 0; bj < 2; ++bj) { x0[m][bj] = bf4_lo(xr[m][bj]); x1[m][bj] = bf4_hi(xr[m][bj]); }
            }
#pragma unroll
            for (int m = 0; m < 4; ++m) {
                const int row = u.pm * 256 + ai * 128 + wr * 64 + m * 16 + fr;
                float s = 0.f;
#pragma unroll
                for (int bj = 0; bj < 2; ++bj) {
                    f32x4 o0 = acc[ai][bj][m][0], o1 = acc[ai][bj][m][1];
                    if (HAS_CS) { o0 *= *(const f32x4*)(cs + colb + 128 * bj); o1 *= *(const f32x4*)(cs + colb + 128 * bj + 4); }
                    o0 += x0[m][bj]; o1 += x1[m][bj];
                    u32x4 w; w.x = cvt_pk_bf16(o0[0], o0[1]); w.y = cvt_pk_bf16(o0[2], o0[3]); w.z = cvt_pk_bf16(o1[0], o1[1]); w.w = cvt_pk_bf16(o1[2], o1[3]);
                    *(u32x4*)(xbu + (lofs + (unsigned)(((ai * 128 + m * 16) * D + 128 * bj) * 2))) = w;
                    s += (o0[0] * o0[0] + o0[1] * o0[1]) + (o0[2] * o0[2] + o0[3] * o0[3]) + (o1[0] * o1[0] + o1[1] * o1[1]) + (o1[2] * o1[2] + o1[3] * o1[3]);
                }
                s += bperm(s, (((fq ^ 1) << 4) | fr) << 2); s += bperm(s, (((fq ^ 2) << 4) | fr) << 2);
                if (fq == 0) atomic_addf(ssn + row, s);
            }
        }
    }
};
struct EpiAin {
    const float* ss; bf16_t* BG; bf16_t* CV; float* st_p; float* st_s;
    __device__ __forceinline__ void operator()(const AccT& acc, const pg8::Unit& u, int wr, int wc, int fr, int fq) const {
        asm volatile("" : "+v"(fr), "+v"(fq));
        float rs[2][4]; load_rstd8(ss, u.pm, wr, fr, rs);
#pragma unroll
        for (int ai = 0; ai < 2; ++ai)
#pragma unroll
            for (int m = 0; m < 4; ++m) {
                const int row = u.pm * 256 + ai * 128 + wr * 64 + m * 16 + fr;
                const float r = rs[ai][m];
                if (u.pn < 4) {
#pragma unroll
                    for (int bj = 0; bj < 2; ++bj) store_bf16x8(BG + (size_t)row * D + u.pn * 256 + 128 * bj + wc * 32 + 8 * fq, acc[ai][bj][m][0] * r, acc[ai][bj][m][1] * r);
                } else {
                    const int ch = (u.pn - 4) * 128 + wc * 32 + 8 * fq; const float r2 = r * r;
                    const f32x4 c0 = acc[ai][0][m][0] * acc[ai][1][m][0] * r2, c1 = acc[ai][0][m][1] * acc[ai][1][m][1] * r2;
                    store_bf16x8(CV + (size_t)row * D + ch, c0, c1);
                    if (u.pm < 64) { const int t = row & (SEQ - 1); if (t >= SEQ - 2) { float* o = st_p + ((size_t)(row >> 11) * 2 + (t - (SEQ - 2))) * D + ch; *(f32x4*)o = c0; *(f32x4*)(o + 4) = c1; } }
                    else { const int rr = row - MP, t = rr & 7; if (t >= 6) { float* o = st_s + ((size_t)(rr >> 3) * 2 + (t - 6)) * D + ch; *(f32x4*)o = c0; *(f32x4*)(o + 4) = c1; } }
                }
            }
    }
};
struct EpiBin {
    const float* ss; bf16_t* U; bf16_t* VT; float* VS; float* vss;
    __device__ __forceinline__ void operator()(const AccT& acc, const pg8::Unit& u, int wr, int wc, int fr, int fq) const {
        asm volatile("" : "+v"(fr), "+v"(fq));
        float rs[2][4]; load_rstd8(ss, u.pm, wr, fr, rs);
#pragma unroll
        for (int ai = 0; ai < 2; ++ai)
#pragma unroll
            for (int m = 0; m < 4; ++m) {
                const int row = u.pm * 256 + ai * 128 + wr * 64 + m * 16 + fr;
                const float r = rs[ai][m];
                if (u.pn < 4) {
#pragma unroll
                    for (int bj = 0; bj < 2; ++bj) store_bf16x8(U + (size_t)row * D + u.pn * 256 + 128 * bj + wc * 32 + 8 * fq, acc[ai][bj][m][0] * r, acc[ai][bj][m][1] * r);
                } else {
                    float s = 0.f;
#pragma unroll
                    for (int bj = 0; bj < 2; ++bj) {
                        const int ch = (u.pn - 4) * 256 + 128 * bj + wc * 32 + 8 * fq;
                        const f32x4 v0 = acc[ai][bj][m][0] * r, v1 = acc[ai][bj][m][1] * r;
                        s += (v0[0] * v0[0] + v0[1] * v0[1]) + (v0[2] * v0[2] + v0[3] * v0[3]) + (v1[0] * v1[0] + v1[1] * v1[1]) + (v1[2] * v1[2] + v1[3] * v1[3]);
                        if (u.pm < 64) {
                            const unsigned w0 = cvt_pk_bf16(v0[0], v0[1]), w1 = cvt_pk_bf16(v0[2], v0[3]), w2 = cvt_pk_bf16(v1[0], v1[1]), w3 = cvt_pk_bf16(v1[2], v1[3]);
                            bf16_t* o = VT + (size_t)ch * MP + row;
                            o[0] = (bf16_t)w0; o[(size_t)MP] = (bf16_t)(w0 >> 16); o[(size_t)2 * MP] = (bf16_t)w1; o[(size_t)3 * MP] = (bf16_t)(w1 >> 16);
                            o[(size_t)4 * MP] = (bf16_t)w2; o[(size_t)5 * MP] = (bf16_t)(w2 >> 16); o[(size_t)6 * MP] = (bf16_t)w3; o[(size_t)7 * MP] = (bf16_t)(w3 >> 16);
                        } else { float* o = VS + (size_t)(row - MP) * D + ch; *(f32x4*)o = v0; *(f32x4*)(o + 4) = v1; }
                    }
                    s += bperm(s, (((fq ^ 1) << 4) | fr) << 2); s += bperm(s, (((fq ^ 2) << 4) | fr) << 2);
                    if (fq == 0) atomic_addf(vss + row, s);
                }
            }
    }
};
__device__ __forceinline__ float dpp_shr1(float old, float v) { return __int_as_float(__builtin_amdgcn_update_dpp(__float_as_int(old), __float_as_int(v), 0x111, 0xf, 0xf, false)); }
__device__ __forceinline__ float dpp_shr2(float old, float v) { return __int_as_float(__builtin_amdgcn_update_dpp(__float_as_int(old), __float_as_int(v), 0x112, 0xf, 0xf, false)); }
__device__ __forceinline__ float dpp_ror1(float v) { return __int_as_float(__builtin_amdgcn_update_dpp(0, __float_as_int(v), 0x121, 0xf, 0xf, false)); }
__device__ __forceinline__ float dpp_ror2(float v) { return __int_as_float(__builtin_amdgcn_update_dpp(0, __float_as_int(v), 0x122, 0xf, 0xf, false)); }

struct EpiUp {
    const float* ss; bf16_t* MB; const float* cw; const float* cb; const float* st_in; float* fxp; float* fxa; float* gl; float* st_p; float* st_s;
    __device__ __forceinline__ void prompt_body(const AccT& acc, const pg8::Unit& u, int wr, int wc, int fr, int fq) const {
        constexpr float NL2E = -1.4426950408889634f, NLN2 = -0.6931471805599453f;
        const int chl = wc * 32 + 8 * fq;
        const float* ssu = ss + u.pm * 256 + wr * 64;
        float rs[2][4];
        {
            float t[2][4];
#pragma unroll
            for (int ai = 0; ai < 2; ++ai)
#pragma unroll
                for (int m = 0; m < 4; ++m) t[ai][m] = ssu[fr + ai * 128 + m * 16];
#pragma unroll
            for (int ai = 0; ai < 2; ++ai)
#pragma unroll
                for (int m = 0; m < 4; ++m) rs[ai][m] = rstd_of(t[ai][m]);
        }
        const char* cwu = (const char*)(cw + u.pn * 128); const char* cbu = (const char*)(cb + u.pn * 128);
        char* mbu = (char*)(MB + (size_t)(u.pm * 256 + wr * 64) * DFF + u.pn * 128);
        const unsigned mofs = (unsigned)(fr * DFF + chl) * 2u;
        const int G0 = u.pm * 4 + wr;
        f32x4 w0n[2], w1n[2], w2n[2], bbn[2];
#pragma unroll
        for (int n = 0; n < 2; ++n) {
            const unsigned cofs = (unsigned)(chl + 4 * n) * 4u;
            w0n[n] = *(const f32x4*)(cwu + cofs) * NL2E; w1n[n] = *(const f32x4*)(cwu + DFF * 4 + cofs) * NL2E; w2n[n] = *(const f32x4*)(cwu + 2 * DFF * 4 + cofs) * NL2E; bbn[n] = *(const f32x4*)(cbu + cofs) * NL2E;
        }
#pragma unroll
        for (int ai = 0; ai < 2; ++ai) {
            const int G = G0 + 2 * ai;
            f32x4 p1[2], p2[2];
#pragma unroll
            for (int n = 0; n < 2; ++n) { p1[n] = (f32x4){0.f, 0.f, 0.f, 0.f}; p2[n] = p1[n]; }
#pragma unroll
            for (int m = 0; m < 4; ++m) {
                const float r = rs[ai][m];
                u32x4 o;
#pragma unroll
                for (int n = 0; n < 2; ++n) {
                    const f32x4 gg = acc[ai][0][m][n] * r, an = acc[ai][1][m][n] * (r * NLN2);
                    f32x4 pv1, pv2;
#pragma unroll
                    for (int j = 0; j < 4; ++j) { pv1[j] = dpp_shr1(p1[n][j], gg[j]); pv2[j] = dpp_shr2(p2[n][j], gg[j]); }
                    const f32x4 pre = w2n[n] * gg + w1n[n] * pv1 + w0n[n] * pv2 + bbn[n];
                    f32x4 ov;
#pragma unroll
                    for (int j = 0; j < 4; ++j) ov[j] = (pre[j] * an[j]) * __builtin_amdgcn_rcpf(1.0f + __builtin_amdgcn_exp2f(pre[j]));
                    if (n == 0) { o.x = cvt_pk_bf16(ov[0], ov[1]); o.y = cvt_pk_bf16(ov[2], ov[3]); } else { o.z = cvt_pk_bf16(ov[0], ov[1]); o.w = cvt_pk_bf16(ov[2], ov[3]); }
                    if (m == 0) {
                        if ((G & 31) != 0 && fr < 2) {
                            const size_t fo = ((size_t)G * 2 + fr) * DFF + u.pn * 128 + chl + 4 * n;
                            *(f32x4*)(fxp + fo) = pre * NLN2; *(f32x4*)(fxa + fo) = an * (1.0f / NLN2);
                        }
                    }
                    if (m == 3) {
                        if (fr >= 14) {
                            const size_t go = ((size_t)G * 2 + (fr - 14)) * DFF + u.pn * 128 + chl + 4 * n;
                            *(f32x4*)(gl + go) = gg;
                            if ((G & 31) == 31) *(f32x4*)(st_p + ((size_t)(G >> 5) * 2 + (fr - 14)) * DFF + u.pn * 128 + chl + 4 * n) = gg;
                        }
                    } else {
#pragma unroll
                        for (int j = 0; j < 4; ++j) { p1[n][j] = dpp_ror1(gg[j]); p2[n][j] = dpp_ror2(gg[j]); }
                    }
                }
                *(u32x4*)(mbu + (mofs + (unsigned)(((ai * 128 + m * 16) * DFF) * 2))) = o;
            }
        }
    }
    __device__ __forceinline__ void sample_body(const AccT& acc, const pg8::Unit& u, int wr, int wc, int fr, int fq) const {
        const int src1 = ((fq << 4) | ((fr - 1) & 15)) << 2, src2 = ((fq << 4) | ((fr - 2) & 15)) << 2;
        float rs[2][4];
        const int chb = u.pn * 128 + wc * 32 + 8 * fq;
        load_rstd8(ss, u.pm, wr, fr, rs);
#pragma unroll
        for (int n = 0; n < 2; ++n) {
            const int ch = chb + 4 * n;
            const f32x4 w0n = *(const f32x4*)(cw + ch), w1n = *(const f32x4*)(cw + DFF + ch), w2n = *(const f32x4*)(cw + 2 * DFF + ch), bbn = *(const f32x4*)(cb + ch);
#pragma unroll
            for (int ai = 0; ai < 2; ++ai) {
                const int t = fr & 7;
#pragma unroll
                for (int mp = 0; mp < 4; mp += 2) {
                f32x4 s0[2], s1[2];
#pragma unroll
                for (int mm = 0; mm < 2; ++mm) {
                    const int rr = u.pm * 256 + ai * 128 + wr * 64 + (mp + mm) * 16 + fr - MP; const float* sp = st_in + (size_t)(rr >> 3) * 2 * DFF + ch;
                    s0[mm] = (f32x4){0.f, 0.f, 0.f, 0.f}; s1[mm] = s0[mm];
                    if (t < 2) { s0[mm] = *(const f32x4*)(sp); s1[mm] = *(const f32x4*)(sp + DFF); }
                }
#pragma unroll
                for (int mm = 0; mm < 2; ++mm) {
                    const int m = mp + mm;
                    const int row = u.pm * 256 + ai * 128 + wr * 64 + m * 16 + fr;
                    const float r = rs[ai][m];
                    const f32x4 gg = acc[ai][0][m][n] * r, aa = acc[ai][1][m][n] * r;
                    f32x4 pv1, pv2;
#pragma unroll
                    for (int j = 0; j < 4; ++j) { pv1[j] = bperm(gg[j], src1); pv2[j] = bperm(gg[j], src2); }
                    if (t == 0) { pv1 = s1[mm]; pv2 = s0[mm]; }
                    if (t == 1) { pv2 = s1[mm]; }
                    const f32x4 pre = w2n * gg + w1n * pv1 + w0n * pv2 + bbn;
                    u32x2 o; o.x = cvt_pk_bf16(silu_f(pre[0]) * aa[0], silu_f(pre[1]) * aa[1]); o.y = cvt_pk_bf16(silu_f(pre[2]) * aa[2], silu_f(pre[3]) * aa[3]);
                    *(u32x2*)(MB + (size_t)row * DFF + ch) = o;
                    const int rr = row - MP;
                    if (t >= 6) *(f32x4*)(st_s + ((size_t)(rr >> 3) * 2 + (t - 6)) * DFF + ch) = gg;
                }
                }
            }
        }
    }
    __device__ __forceinline__ void operator()(const AccT& acc, const pg8::Unit& u, int wr, int wc, int fr, int fq) const {
        asm volatile("" : "+v"(fr), "+v"(fq));
        if (u.pm < 64) prompt_body(acc, u, wr, wc, fr, fq); else sample_body(acc, u, wr, wc, fr, fq);
    }
};

struct Args { const float* in[22]; float* out; unsigned char* ws; int ph_lo, ph_hi; };
__device__ __forceinline__ const float* ldp(const Args& a, int i) { asm volatile("" : "+s"(i)); return a.in[i]; }
__device__ __forceinline__ unsigned char* ws_of(const Args& a) { unsigned char* p = a.ws; asm volatile("" : "+s"(p)); return p; }
__device__ __forceinline__ float* out_of(const Args& a) { float* p = a.out; asm volatile("" : "+s"(p)); return p; }
enum { I_XP = 0, I_XS, I_SSC, I_SPOOL, I_SFFN, I_GMIX, I_GFFN, I_GFIN, I_AWIN, I_ACONV, I_AWOUT, I_BWIN, I_BGV, I_BWS, I_BBIAS, I_BWOUT, I_CWG, I_CSCALE, I_FWUP, I_FCONV, I_FCONVB, I_FWDN };

template <int MAP> __device__ __forceinline__ int colmap(int n0) {
    if (MAP == 1) { if (n0 < 1024) return n0; const int q = n0 - 1024, p = q >> 8, jj = q & 255; return jj < 128 ? 1024 + 128 * p + jj : 2048 + 128 * p + (jj - 128); }
    if (MAP == 2) { const int p = n0 >> 8, jj = n0 & 255; return jj < 128 ? 128 * p + jj : DFF + 128 * p + (jj - 128); }
    return n0;
}
template <int MAP>
__device__ __forceinline__ void prep_matrix(const float* W, int K, int N, bf16_t* WT, const float* gs, LAS float* scr, int lane, int gw, int NGW, int& base) {
    const int nblk = N / 32, nitems = (K / 64) * nblk;
    int first = gw - (base % NGW); if (first < 0) first += NGW;
    for (int item = first; item < nitems; item += NGW) {
        const int kb = item / nblk, nb = item % nblk, k0 = 64 * kb, n0 = 32 * nb, sc = colmap<MAP>(n0);
        float wv[32];
#pragma unroll
        for (int i = 0; i < 32; ++i) { const int kk = 2 * i + (lane >> 5); wv[i] = W[(size_t)(k0 + kk) * N + sc + (lane & 31)]; }
        if (gs) {
#pragma unroll
            for (int i = 0; i < 32; ++i) wv[i] *= gs[k0 + 2 * i + (lane >> 5)];
        }
#pragma unroll
        for (int i = 0; i < 32; ++i) scr[(2 * i + (lane >> 5)) * 33 + (lane & 31)] = wv[i];
        asm volatile("s_waitcnt lgkmcnt(0)" ::: "memory");
        const int c = lane & 7;
#pragma unroll
        for (int j = 0; j < 4; ++j) { const int n = (lane >> 3) + 8 * j; const LAS float* s = scr + (8 * c) * 33 + n;
            u32x4 o; o.x = cvt_pk_bf16(s[0 * 33], s[1 * 33]); o.y = cvt_pk_bf16(s[2 * 33], s[3 * 33]); o.z = cvt_pk_bf16(s[4 * 33], s[5 * 33]); o.w = cvt_pk_bf16(s[6 * 33], s[7 * 33]);
            *(u32x4*)(WT + (size_t)(n0 + n) * K + k0 + 8 * c) = o; }
        asm volatile("s_waitcnt lgkmcnt(0)" ::: "memory");
    }
    base += nitems;
}

__device__ __forceinline__ void prep_weights(const Args& a, LAS unsigned char* lds, int group, int pb, int npb);
__device__ __forceinline__ void prep_phase(const Args& a, LAS unsigned char* lds) {
    unsigned char* const wsl = ws_of(a); float* const outl = out_of(a); const int tidl = tid_l();
    const int tid = tidl, lane = tid & 63, wave = tid >> 6;
    const int gw = blockIdx.x * NWAVES + wave, NGW = gridDim.x * NWAVES;
    LAS float* scr = (LAS float*)(lds + wave * 16384);
    unsigned char* ws = wsl;
    { float* z = (float*)(ws + WS_SS) + M; const int nz = 9 * M; for (int i = blockIdx.x * NTHREADS + tid; i < nz; i += gridDim.x * NTHREADS) z[i] = 0.f; }
    { float* ss0 = (float*)(ws + WS_SS); bf16_t* xb = (bf16_t*)(ws + WS_XB);
      for (int row = gw; row < M; row += NGW) {
          const float* xr = row < MP ? ldp(a, I_XP) + (size_t)row * D : ldp(a, I_XS) + (size_t)(row - MP) * D;
          float s = 0.f;
#pragma unroll
          for (int j = 0; j < 2; ++j) { const f32x4 v0 = *(const f32x4*)(xr + j * 512 + lane * 8), v1 = *(const f32x4*)(xr + j * 512 + lane * 8 + 4);
              s += (v0[0] * v0[0] + v0[1] * v0[1]) + (v0[2] * v0[2] + v0[3] * v0[3]) + (v1[0] * v1[0] + v1[1] * v1[1]) + (v1[2] * v1[2] + v1[3] * v1[3]);
              store_bf16x8(xb + (size_t)row * D + j * 512 + lane * 8, v0, v1); }
          s = wave_sum(s); if (lane == 0) ss0[row] = ss_fix(s); } }
    prep_weights(a, lds, 0, blockIdx.x, gridDim.x);
    if (gridDim.x != 256) { prep_weights(a, lds, 1, blockIdx.x, gridDim.x); prep_weights(a, lds, 2, blockIdx.x, gridDim.x); }
}
__device__ __forceinline__ void prep_weights(const Args& a, LAS unsigned char* lds, int group, int pb, int npb) {
    unsigned char* const ws = ws_of(a); const int tidl = tid_l();
    const int lane = tidl & 63, wave = tidl >> 6;
    const int gw = pb * NWAVES + wave, NGW = npb * NWAVES;
    LAS float* scr = (LAS float*)(lds + wave * 16384);
    int base = 0;
    if (group == 0) {
        prep_matrix<1>(ldp(a, I_AWIN), 1024, 3072, (bf16_t*)(ws + WS_AIN), ldp(a, I_GMIX), scr, lane, gw, NGW, base);
        prep_matrix<0>(ldp(a, I_AWOUT), 1024, 1024, (bf16_t*)(ws + WS_AOUT), nullptr, scr, lane, gw, NGW, base);
    } else if (group == 1) {
        prep_matrix<2>(ldp(a, I_FWUP), 1024, 5632, (bf16_t*)(ws + WS_UP), ldp(a, I_GFFN), scr, lane, gw, NGW, base);
        prep_matrix<0>(ldp(a, I_FWDN), 2816, 1024, (bf16_t*)(ws + WS_DN), nullptr, scr, lane, gw, NGW, base);
        prep_matrix<0>(ldp(a, I_BWIN), 1024, 2048, (bf16_t*)(ws + WS_BIN), ldp(a, I_GMIX) + (size_t)1 * D, scr, lane, gw, NGW, base);
        prep_matrix<0>(ldp(a, I_BWOUT), 1024, 1024, (bf16_t*)(ws + WS_BOUT), nullptr, scr, lane, gw, NGW, base);
        prep_matrix<2>(ldp(a, I_FWUP) + (size_t)1 * 1024 * 5632, 1024, 5632, (bf16_t*)(ws + WS_UP + 1 * SZ_UP), ldp(a, I_GFFN) + (size_t)1 * D, scr, lane, gw, NGW, base);
        prep_matrix<0>(ldp(a, I_FWDN) + (size_t)1 * 2816 * 1024, 2816, 1024, (bf16_t*)(ws + WS_DN + 1 * SZ_DN), nullptr, scr, lane, gw, NGW, base);
    } else {
        for (int g = 0; g < 4; ++g) prep_matrix<0>(ldp(a, I_CWG) + (size_t)g * 65536, 256, 256, (bf16_t*)(ws + WS_CG) + (size_t)g * 65536, nullptr, scr, lane, gw, NGW, base);
        prep_matrix<1>(ldp(a, I_AWIN) + (size_t)1024 * 3072, 1024, 3072, (bf16_t*)(ws + WS_AIN + SZ_AIN), ldp(a, I_GMIX) + (size_t)3 * D, scr, lane, gw, NGW, base);
        prep_matrix<0>(ldp(a, I_AWOUT) + (size_t)1024 * 1024, 1024, 1024, (bf16_t*)(ws + WS_AOUT + SZ_SQ), nullptr, scr, lane, gw, NGW, base);
        for (int i = 2; i < 4; ++i) {
            prep_matrix<2>(ldp(a, I_FWUP) + (size_t)i * 1024 * 5632, 1024, 5632, (bf16_t*)(ws + WS_UP + i * SZ_UP), ldp(a, I_GFFN) + (size_t)i * D, scr, lane, gw, NGW, base);
            prep_matrix<0>(ldp(a, I_FWDN) + (size_t)i * 2816 * 1024, 2816, 1024, (bf16_t*)(ws + WS_DN + i * SZ_DN), nullptr, scr, lane, gw, NGW, base);
        }
    }
}

__device__ __forceinline__ void aconv_phase(const Args& a, int j) {
    unsigned char* const wsl = ws_of(a); float* const outl = out_of(a); const int tidl = tid_l();
    const bf16_t* BG = (const bf16_t*)(wsl + WS_T1); const bf16_t* CV = (const bf16_t*)(wsl + WS_T2); bf16_t* ZB = (bf16_t*)(wsl + WS_T3);
    const float* cw = ldp(a, I_ACONV) + (size_t)j * 3 * D; const float* st = ldp(a, I_SSC) + (size_t)j * DECB * 2 * D;
    const int tid = tidl, c8 = (tid & 127) * 8, rsub = tid >> 7;
    f32x4 w[3][2];
#pragma unroll
    for (int k = 0; k < 3; ++k) { w[k][0] = *(const f32x4*)(cw + k * D + c8); w[k][1] = *(const f32x4*)(cw + k * D + c8 + 4); }
    for (int r16 = blockIdx.x; r16 < M / 16; r16 += gridDim.x) {
        const int row0 = r16 * 16 + rsub * 4;
        int t0; const float* sp = nullptr;
        if (row0 < MP) t0 = row0 & (SEQ - 1); else { const int rr = row0 - MP; t0 = rr & 7; sp = st + (size_t)(rr >> 3) * 2 * D + c8; }
        u32x4 cvr[6], bgr[4]; f32x4 h0[2], h1[2];
        const bool halo_mem = (t0 >= 2);
#pragma unroll
        for (int k = 0; k < 6; ++k) if (k >= 2 || halo_mem) cvr[k] = *(const u32x4*)(CV + (size_t)(row0 - 2 + k) * D + c8);
#pragma unroll
        for (int k = 0; k < 4; ++k) bgr[k] = *(const u32x4*)(BG + (size_t)(row0 + k) * D + c8);
        if (!halo_mem) {
            if (sp) { h0[0] = *(const f32x4*)(sp); h0[1] = *(const f32x4*)(sp + 4); h1[0] = *(const f32x4*)(sp + D); h1[1] = *(const f32x4*)(sp + D + 4); }
            else { h0[0] = (f32x4){0.f, 0.f, 0.f, 0.f}; h0[1] = h0[0]; h1[0] = h0[0]; h1[1] = h0[0]; }
        } else { h0[0] = bf4_lo(cvr[0]); h0[1] = bf4_hi(cvr[0]); h1[0] = bf4_lo(cvr[1]); h1[1] = bf4_hi(cvr[1]); }
        f32x4 xm2[2] = {h0[0], h0[1]}, xm1[2] = {h1[0], h1[1]};
#pragma unroll
        for (int k = 0; k < 4; ++k) {
            const f32x4 x0 = bf4_lo(cvr[2 + k]), x1 = bf4_hi(cvr[2 + k]);
            const f32x4 y0 = w[0][0] * xm2[0] + w[1][0] * xm1[0] + w[2][0] * x0, y1 = w[0][1] * xm2[1] + w[1][1] * xm1[1] + w[2][1] * x1;
            store_bf16x8(ZB + (size_t)(row0 + k) * D + c8, bf4_lo(bgr[k]) * y0, bf4_hi(bgr[k]) * y1);
            xm2[0] = xm1[0]; xm2[1] = xm1[1]; xm1[0] = x0; xm1[1] = x1;
        }
    }
}

__device__ __forceinline__ void spatial_phase(const Args& a) {
    unsigned char* const wsl = ws_of(a); float* const outl = out_of(a); const int tidl = tid_l();
    const bf16_t* U = (const bf16_t*)(wsl + WS_T1); const bf16_t* VT = (const bf16_t*)(wsl + WS_T2); bf16_t* ZB = (bf16_t*)(wsl + WS_T3);
    const float* VS = (const float*)(wsl + WS_VS); const float* vss = (const float*)(wsl + WS_VSS);
    const float* Ws = ldp(a, I_BWS); const float* bias = ldp(a, I_BBIAS); const float* gv = ldp(a, I_BGV);
    const int tid = tidl, lane = tid & 63, w = tid >> 6, fr = lane & 15, fq = lane >> 4;
    for (int unit = blockIdx.x; unit < 512 + 2 * DECB; unit += gridDim.x) {
        if (unit < 512) {
            const int c = unit >> 2, h = unit & 3, rb = c * 128;
#pragma unroll 1
            for (int job = 0; job < 2; ++job) {
                const int tt = job ? 7 - w : w, t = 16 * tt + fr, nks = (tt >> 1) + 1, d0 = job * 8;
                bf16x8 Wf[4];
                {
                    f32x4 wa[4], wb[4], va[4], vb[4];
#pragma unroll
                    for (int ks = 0; ks < 4; ++ks) {
                        const int s0 = ks * 32 + 8 * fq; const float* wp = Ws + ((size_t)(h * 128 + t) * 128 + s0);
                        wa[ks] = *(const f32x4*)wp; wb[ks] = *(const f32x4*)(wp + 4); va[ks] = *(const f32x4*)(vss + rb + s0); vb[ks] = *(const f32x4*)(vss + rb + s0 + 4);
                    }
#pragma unroll
                    for (int ks = 0; ks < 4; ++ks) {
                        const int s0 = ks * 32 + 8 * fq; float wv[8];
#pragma unroll
                        for (int i = 0; i < 4; ++i) { wv[i] = (s0 + i <= t) ? wa[ks][i] * rstd_of(va[ks][i]) : 0.f; wv[4 + i] = (s0 + 4 + i <= t) ? wb[ks][i] * rstd_of(vb[ks][i]) : 0.f; }
                        u32x4 wpk; wpk.x = cvt_pk_bf16(wv[0], wv[1]); wpk.y = cvt_pk_bf16(wv[2], wv[3]); wpk.z = cvt_pk_bf16(wv[4], wv[5]); wpk.w = cvt_pk_bf16(wv[6], wv[7]);
                        Wf[ks] = __builtin_bit_cast(bf16x8, wpk);
                    }
                }
                f32x4 acc[8];
#pragma unroll
                for (int i = 0; i < 8; ++i) acc[i] = (f32x4){0.f, 0.f, 0.f, 0.f};
#pragma unroll
                for (int kp = 0; kp < 2; ++kp) {
                    if (2 * kp < nks) {
                        bf16x8 vf[2][8];
#pragma unroll
                        for (int k2 = 0; k2 < 2; ++k2) { const int s0 = (2 * kp + k2) * 32 + 8 * fq;
#pragma unroll
                            for (int dt = 0; dt < 8; ++dt) vf[k2][dt] = *(const bf16x8*)(VT + (size_t)(h * 256 + (d0 + dt) * 16 + fr) * MP + rb + s0); }
                        __builtin_amdgcn_sched_barrier(0);
#pragma unroll
                        for (int k2 = 0; k2 < 2; ++k2)
#pragma unroll
                            for (int dt = 0; dt < 8; ++dt) acc[dt] = __builtin_amdgcn_mfma_f32_16x16x32_bf16(vf[k2][dt], Wf[2 * kp + k2], acc[dt], 0, 0, 0);
                    }
                }
                const int row = rb + t; const float bs = bias[h * 128 + t];
                u32x2 uu[8]; f32x4 g4[8];
#pragma unroll
                for (int dt = 0; dt < 8; ++dt) { const int ch = h * 256 + (d0 + dt) * 16 + 4 * fq; uu[dt] = *(const u32x2*)(U + (size_t)row * D + ch); g4[dt] = *(const f32x4*)(gv + ch); }
#pragma unroll
                for (int dt = 0; dt < 8; ++dt) {
                    const int ch = h * 256 + (d0 + dt) * 16 + 4 * fq;
                    const f32x4 u4 = (f32x4){bf_lo(uu[dt].x), bf_hi(uu[dt].x), bf_lo(uu[dt].y), bf_hi(uu[dt].y)};
                    const f32x4 z = u4 * (acc[dt] * g4[dt] + bs);
                    u32x2 o; o.x = cvt_pk_bf16(z[0], z[1]); o.y = cvt_pk_bf16(z[2], z[3]);
                    *(u32x2*)(ZB + (size_t)row * D + ch) = o;
                }
            }
        } else {
            const int su = unit - 512, b = su >> 1, tb = (su & 1) * 4, r0 = MP + 8 * b, ch = 2 * tid, h = ch >> 8;
            float v0[8], v1[8], rv[8], ww[4][8], bs[4]; unsigned uu[4];
#pragma unroll
            for (int s = 0; s < 8; ++s) { rv[s] = vss[r0 + s]; const f32x2 vv = *(const f32x2*)(VS + (size_t)(8 * b + s) * D + ch); v0[s] = vv.x; v1[s] = vv.y; }
#pragma unroll
            for (int tt = 0; tt < 4; ++tt) {
                const int t = tb + tt;
#pragma unroll
                for (int s = 0; s < 8; ++s) ww[tt][s] = Ws[(size_t)(h * 128 + t) * 128 + s];
                bs[tt] = bias[h * 128 + t]; uu[tt] = *(const unsigned*)(U + (size_t)(r0 + t) * D + ch);
            }
            const f32x2 g2 = *(const f32x2*)(gv + ch);
#pragma unroll
            for (int s = 0; s < 8; ++s) { rv[s] = rstd_of(rv[s]); v0[s] *= rv[s]; v1[s] *= rv[s]; }
            float* cvo = outl + O_CV + (size_t)(8 * b) * D + ch;
#pragma unroll
            for (int tt = 0; tt < 4; ++tt) {
                const int t = tb + tt;
                float s0 = 0.f, s1 = 0.f;
#pragma unroll
                for (int s = 0; s < 8; ++s) { const float wm = (s <= t) ? ww[tt][s] : 0.f; s0 += wm * v0[s]; s1 += wm * v1[s]; }
                const float z0 = bf_lo(uu[tt]) * (s0 * g2.x + bs[tt]), z1 = bf_hi(uu[tt]) * (s1 * g2.y + bs[tt]);
                *(unsigned*)(ZB + (size_t)(r0 + t) * D + ch) = cvt_pk_bf16(z0, z1);
                const float c0 = (tb ? (tt == 0 ? v0[4] : tt == 1 ? v0[5] : tt == 2 ? v0[6] : v0[7]) : (tt == 0 ? v0[0] : tt == 1 ? v0[1] : tt == 2 ? v0[2] : v0[3]));
                const float c1 = (tb ? (tt == 0 ? v1[4] : tt == 1 ? v1[5] : tt == 2 ? v1[6] : v1[7]) : (tt == 0 ? v1[0] : tt == 1 ? v1[1] : tt == 2 ? v1[2] : v1[3]));
                *(f32x2*)(cvo + (size_t)t * D) = (f32x2){c0 * g2.x, c1 * g2.y};
            }
        }
    }
}

__device__ __forceinline__ void pool_phase(const Args& a, LAS unsigned char* lds, const float* ssk, const float* gm) {
    unsigned char* const wsl = ws_of(a); float* const outl = out_of(a); const int tidl = tid_l();
    const bf16_t* XBr = (const bf16_t*)(wsl + WS_XB); bf16_t* DB = (bf16_t*)(wsl + WS_T1);
    const float* st = ldp(a, I_SPOOL);
    LAS float* H = (LAS float*)lds;
    const int tid = tidl, q = tid & 255, c4 = q * 4, rsub = tid >> 8, win = 2 << (c4 >> 8);
    const f32x4 g4 = *(const f32x4*)(gm + c4);
    for (int strip = blockIdx.x; strip < 1024 + DECB; strip += gridDim.x) {
        const bool prompt = strip < 1024;
        const int b = strip - 1024;
        const int row0 = prompt ? strip * 16 : MP + b * 8;
        const int t0 = prompt ? (row0 & (SEQ - 1)) : 0;
        f32x4 v[16]; float sv[16];
#pragma unroll
        for (int k = 0; k < 16; ++k) {
            const int i = rsub + 2 * k;
            v[k] = (f32x4){0.f, 0.f, 0.f, 0.f}; sv[k] = -1.f;
            if (prompt) { if (i < 31 && t0 - 15 + i >= 0) { const int row = row0 - 15 + i; const u32x2 w = *(const u32x2*)(XBr + (size_t)row * D + c4); v[k] = (f32x4){bf_lo(w.x), bf_hi(w.x), bf_lo(w.y), bf_hi(w.y)}; sv[k] = ssk[row]; } }
            else { if (i < 15) v[k] = *(const f32x4*)(st + ((size_t)b * 15 + i) * D + c4);
                   else if (i < 23) { const int row = row0 + (i - 15); const u32x2 w = *(const u32x2*)(XBr + (size_t)row * D + c4); v[k] = (f32x4){bf_lo(w.x), bf_hi(w.x), bf_lo(w.y), bf_hi(w.y)}; sv[k] = ssk[row]; } }
        }
#pragma unroll
        for (int k = 0; k < 16; ++k) { const int i = rsub + 2 * k; if (i < 31) { const f32x4 hv = sv[k] >= 0.f ? v[k] * (g4 * rstd_of(sv[k])) : v[k]; *(LAS f32x4*)(H + i * 1024 + c4) = hv; } }
        __syncthreads();
        const int nper = prompt ? 8 : 4, r0 = rsub * nper;
        f32x4 s = (f32x4){0.f, 0.f, 0.f, 0.f};
        for (int k = 0; k < win; ++k) s += *(const LAS f32x4*)(H + (15 + r0 - k) * 1024 + c4);
        for (int rr = 0; rr < nper; ++rr) {
            const int r = r0 + rr, t = t0 + r;
            const f32x4 hc = *(const LAS f32x4*)(H + (15 + r) * 1024 + c4);
            const float cnt = prompt ? (float)((t + 1 < win) ? t + 1 : win) : (float)win;
            const f32x4 d = s * (1.0f / cnt) - hc;
            u32x2 o; o.x = cvt_pk_bf16(d[0], d[1]); o.y = cvt_pk_bf16(d[2], d[3]);
            *(u32x2*)(DB + (size_t)(row0 + r) * D + c4) = o;
            if (rr + 1 < nper) s += *(const LAS f32x4*)(H + (15 + r + 1) * 1024 + c4) - *(const LAS f32x4*)(H + (15 + r + 1 - win) * 1024 + c4);
        }
        if (prompt) {
            if (t0 == SEQ - 16) { for (int r = 1 + rsub; r < 16; r += 2) *(f32x4*)(outl + O_PP + ((size_t)(row0 >> 11) * 15 + (r - 1)) * D + c4) = *(const LAS f32x4*)(H + (15 + r) * 1024 + c4); }
        } else {
            for (int kk = rsub; kk < 15; kk += 2) *(f32x4*)(outl + O_PS + ((size_t)b * 15 + kk) * D + c4) = *(const LAS f32x4*)(H + (8 + kk) * 1024 + c4);
        }
        __syncthreads();
    }
}

__device__ __forceinline__ void ffn_fix_phase(const Args& a, int layer) {
    unsigned char* const wsl = ws_of(a); float* const outl = out_of(a); const int tidl = tid_l();
    const float* fxp = (const float*)(wsl + WS_FXP); const float* fxa = (const float*)(wsl + WS_FXA); const float* gl = (const float*)(wsl + WS_GL);
    bf16_t* MB = (bf16_t*)(wsl + WS_MB); const float* cw = ldp(a, I_FCONV) + (size_t)layer * 3 * DFF;
    const int total = 256 * 2 * (DFF / 4);
    for (int i = blockIdx.x * NTHREADS + tidl; i < total; i += gridDim.x * NTHREADS) {
        const int c4 = (i % (DFF / 4)) * 4, gr = i / (DFF / 4), G = gr >> 1, r = gr & 1;
        if ((G & 31) == 0) continue;
        const f32x4 w0 = *(const f32x4*)(cw + c4), w1 = *(const f32x4*)(cw + DFF + c4);
        f32x4 pre = *(const f32x4*)(fxp + ((size_t)G * 2 + r) * DFF + c4);
        const f32x4 gm1 = *(const f32x4*)(gl + ((size_t)(G - 1) * 2 + 1) * DFF + c4);
        if (r == 0) { const f32x4 gm2 = *(const f32x4*)(gl + ((size_t)(G - 1) * 2 + 0) * DFF + c4); pre += w1 * gm1 + w0 * gm2; }
        else pre += w0 * gm1;
        const f32x4 av = *(const f32x4*)(fxa + ((size_t)G * 2 + r) * DFF + c4);
        u32x2 o; o.x = cvt_pk_bf16(silu_f(pre[0]) * av[0], silu_f(pre[1]) * av[1]); o.y = cvt_pk_bf16(silu_f(pre[2]) * av[2], silu_f(pre[3]) * av[3]);
        *(u32x2*)(MB + (size_t)(G * 64 + r) * DFF + c4) = o;
    }
}


__device__ __forceinline__ void ffn_fix_panel(const Args& a, int layer, int pm) {
    unsigned char* const wsl = ws_of(a); const int tidl = tid_l();
    const float* fxp = (const float*)(wsl + WS_FXP); const float* fxa = (const float*)(wsl + WS_FXA); const float* gl = (const float*)(wsl + WS_GL);
    bf16_t* MB = (bf16_t*)(wsl + WS_MB); const float* cw = ldp(a, I_FCONV) + (size_t)layer * 3 * DFF;
    constexpr int NIT = (8 * (DFF / 4)) / NTHREADS;
    static_assert(NIT * NTHREADS == 8 * (DFF / 4), "fix items");
#pragma unroll 1
    for (int hb = 0; hb < 2; ++hb) {
        f32x4 pre[6], av[6], g1[6], g2[6];
#pragma unroll
        for (int k = 0; k < 6; ++k) {
            const int it = hb * 6 + k; if (it >= NIT) continue;
            const int i = tidl + it * NTHREADS, c4 = (i % (DFF / 4)) * 4, gr = i / (DFF / 4), G = pm * 4 + (gr >> 1), r = gr & 1;
            const int Gp = (G & 31) ? G - 1 : G;
            pre[k] = *(const f32x4*)(fxp + ((size_t)G * 2 + r) * DFF + c4); av[k] = *(const f32x4*)(fxa + ((size_t)G * 2 + r) * DFF + c4);
            g1[k] = *(const f32x4*)(gl + ((size_t)Gp * 2 + 1) * DFF + c4); g2[k] = *(const f32x4*)(gl + ((size_t)Gp * 2 + 0) * DFF + c4);
        }
#pragma unroll
        for (int k = 0; k < 6; ++k) {
            const int it = hb * 6 + k; if (it >= NIT) continue;
            const int i = tidl + it * NTHREADS, c4 = (i % (DFF / 4)) * 4, gr = i / (DFF / 4), G = pm * 4 + (gr >> 1), r = gr & 1;
            if ((G & 31) == 0) continue;
            const f32x4 w0 = *(const f32x4*)(cw + c4), w1 = *(const f32x4*)(cw + DFF + c4);
            f32x4 p = pre[k];
            if (r == 0) p += w1 * g1[k] + w0 * g2[k]; else p += w0 * g1[k];
            u32x2 o; o.x = cvt_pk_bf16(silu_f(p[0]) * av[k][0], silu_f(p[1]) * av[k][1]); o.y = cvt_pk_bf16(silu_f(p[2]) * av[k][2], silu_f(p[3]) * av[k][3]);
            *(u32x2*)(MB + (size_t)(G * 64 + r) * DFF + c4) = o;
        }
    }
}

template <int nsplit> __device__ __forceinline__ void sample_fin_phase(const Args& a, float* ssn, const float* xin_s) {
    unsigned char* const wsl = ws_of(a); const int tidl = tid_l();
    bf16_t* XB = (bf16_t*)(wsl + WS_XB); const float* part = (const float*)(wsl + WS_PART);
    const int lane = tidl & 63, gw = blockIdx.x * NWAVES + (tidl >> 6), NGW = gridDim.x * NWAVES;
    for (int r = gw; r < MS; r += NGW) {
        const int row = MP + r, pmq = r >> 8, rl = r & 255; float s = 0.f;
        f32x4 v[4];
        if (xin_s) {
#pragma unroll
            for (int j = 0; j < 4; ++j) v[j] = *(const f32x4*)(xin_s + (size_t)r * D + j * 256 + lane * 4);
        } else {
#pragma unroll
            for (int j = 0; j < 4; ++j) { const u32x2 w = *(const u32x2*)(XB + (size_t)row * D + j * 256 + lane * 4); v[j] = (f32x4){bf_lo(w.x), bf_hi(w.x), bf_lo(w.y), bf_hi(w.y)}; }
        }
#pragma unroll
        for (int kc = 0; kc < nsplit; ++kc) {
#pragma unroll
            for (int j = 0; j < 4; ++j) v[j] += *(const f32x4*)(part + ((size_t)((pmq * 4 + j) * nsplit + kc) * 65536) + (size_t)rl * 256 + lane * 4);
        }
#pragma unroll
        for (int j = 0; j < 4; ++j) {
            u32x2 o; o.x = cvt_pk_bf16(v[j][0], v[j][1]); o.y = cvt_pk_bf16(v[j][2], v[j][3]);
            *(u32x2*)(XB + (size_t)row * D + j * 256 + lane * 4) = o;
            s += (v[j][0] * v[j][0] + v[j][1] * v[j][1]) + (v[j][2] * v[j][2] + v[j][3] * v[j][3]);
        }
        s = wave_sum(s); if (lane == 0) ssn[row] = ss_fix(s);
    }
}

__device__ __forceinline__ void final_phase(const Args& a) {
    unsigned char* const wsl = ws_of(a); float* const outl = out_of(a); const int tidl = tid_l();
    const bf16_t* XBr = (const bf16_t*)(wsl + WS_XB); const float* ss8 = (const float*)(wsl + WS_SS) + (size_t)8 * M; const float* gf = ldp(a, I_GFIN);
    const int lane = tidl & 63, gw = blockIdx.x * NWAVES + (tidl >> 6), NGW = gridDim.x * NWAVES;
    f32x4 g[4];
#pragma unroll
    for (int j = 0; j < 4; ++j) g[j] = *(const f32x4*)(gf + j * 256 + lane * 4);
    const float* part = (const float*)(wsl + WS_PART);
    for (int row = gw; row < MP; row += 2 * NGW) {
        const int row2 = row + NGW; const bool has2 = row2 < MP;
        u32x2 w0[4], w1[4];
#pragma unroll
        for (int j = 0; j < 4; ++j) { w0[j] = *(const u32x2*)(XBr + (size_t)row * D + j * 256 + lane * 4); if (has2) w1[j] = *(const u32x2*)(XBr + (size_t)row2 * D + j * 256 + lane * 4); }
        const float r0 = rstd_of(ss8[row]), r1 = has2 ? rstd_of(ss8[row2]) : 0.f;
#pragma unroll
        for (int j = 0; j < 4; ++j) *(f32x4*)(outl + (size_t)row * D + j * 256 + lane * 4) = (f32x4){bf_lo(w0[j].x), bf_hi(w0[j].x), bf_lo(w0[j].y), bf_hi(w0[j].y)} * (g[j] * r0);
        if (has2) {
#pragma unroll
            for (int j = 0; j < 4; ++j) *(f32x4*)(outl + (size_t)row2 * D + j * 256 + lane * 4) = (f32x4){bf_lo(w1[j].x), bf_hi(w1[j].x), bf_lo(w1[j].y), bf_hi(w1[j].y)} * (g[j] * r1);
        }
    }
    for (int row = MP + gw; row < M; row += NGW) {
        f32x4 xv[4];
#pragma unroll
        for (int j = 0; j < 4; ++j) { const u32x2 w = *(const u32x2*)(XBr + (size_t)row * D + j * 256 + lane * 4); xv[j] = (f32x4){bf_lo(w.x), bf_hi(w.x), bf_lo(w.y), bf_hi(w.y)}; }
        const int rr = row - MP, pmq = rr >> 8, rl = rr & 255; float s = 0.f;
#pragma unroll
        for (int kc = 0; kc < 11; ++kc) {
#pragma unroll
            for (int j = 0; j < 4; ++j) xv[j] += *(const f32x4*)(part + ((size_t)((pmq * 4 + j) * 11 + kc) * 65536) + (size_t)rl * 256 + lane * 4);
        }
#pragma unroll
        for (int j = 0; j < 4; ++j) {
            s += (xv[j][0] * xv[j][0] + xv[j][1] * xv[j][1]) + (xv[j][2] * xv[j][2] + xv[j][3] * xv[j][3]);
            const unsigned lo = cvt_pk_bf16(xv[j][0], xv[j][1]), hi = cvt_pk_bf16(xv[j][2], xv[j][3]);
            xv[j] = (f32x4){bf_lo(lo), bf_hi(lo), bf_lo(hi), bf_hi(hi)};
        }
        s = wave_sum(s); const float r = rstd_of(ss_fix(s));
#pragma unroll
        for (int j = 0; j < 4; ++j) *(f32x4*)(outl + (size_t)row * D + j * 256 + lane * 4) = xv[j] * (g[j] * r);
    }
}


#define XB_TMO      128
#define XB_XCNT(j)  (256  + 64 * (j))
#define XB_XSUB(j)  (1280 + 64 * (j))
#define XB_XGEN(j)  (2304 + 64 * (j))
#define XB_TOP      3328
#define XB_TOPGEN   3392
#define XCD_BAR_WORDS 3456
#define XB_SPIN_CAP (1u << 22)
__device__ __forceinline__ unsigned xb_ld(unsigned* p)              { return __hip_atomic_load(p, __ATOMIC_RELAXED, __HIP_MEMORY_SCOPE_AGENT); }
__device__ __forceinline__ unsigned xb_add(unsigned* p, unsigned v) { return __hip_atomic_fetch_add(p, v, __ATOMIC_RELAXED, __HIP_MEMORY_SCOPE_AGENT); }
__device__ __forceinline__ unsigned xb_xcc_id() { return (unsigned)__builtin_amdgcn_s_getreg((3 << 11) | 20) & 0xFu; }
#define XB_SPIN(cond, bar) do { unsigned _sp = 0; while (cond) { __builtin_amdgcn_s_sleep(1); \
    if ((++_sp & 255u) == 0u) { if (xb_ld(&(bar)[XB_TMO])) break; if (_sp > XB_SPIN_CAP) { atomicAdd(&(bar)[XB_TMO], 1u); break; } } } } while (0)
struct XcdBarrier { unsigned* bar; unsigned x; volatile LAS unsigned* st; };
__device__ __forceinline__ XcdBarrier xcd_barrier_post(unsigned* bar, volatile LAS unsigned* st) {
    XcdBarrier b; b.bar = bar; b.x = xb_xcc_id(); b.st = st;
    if (threadIdx.x == 0) (void)xb_add(&bar[XB_XCNT(b.x)], 1u);
    return b;
}
__device__ __forceinline__ void xcd_barrier_complete(unsigned* bar, unsigned x, unsigned& nloc, unsigned& nx) {
    const unsigned G = gridDim.x * gridDim.y * gridDim.z;
    unsigned sum, cnt, mine, sp = 0u;
    for (;;) {
        sum = 0u; cnt = 0u; mine = 0u;
#pragma unroll
        for (unsigned j = 0; j < 16; ++j) { const unsigned c = xb_ld(&bar[XB_XCNT(j)]); sum += c; cnt += (c > 0u) ? 1u : 0u; mine = (j == x) ? c : mine; }
        if (sum == G) break;
        __builtin_amdgcn_s_sleep(1);
        if ((++sp & 255u) == 0u) { if (xb_ld(&bar[XB_TMO])) break; if (sp > XB_SPIN_CAP) { atomicAdd(&bar[XB_TMO], 1u); break; } }
    }
    nloc = mine > 0u ? mine : 1u; nx = cnt > 0u ? cnt : 1u;
}
__device__ __forceinline__ void xcd_barrier(const XcdBarrier& b, bool ts_on = false, bool ts_sel = false) {
    asm volatile("s_waitcnt vmcnt(0)" ::: "memory");
    __syncthreads();
    if (threadIdx.x == 0) {
        unsigned* bar = b.bar;
        __builtin_amdgcn_s_waitcnt(0);
        unsigned nloc = b.st[0], nx = b.st[1];
        if (nloc == 0u) { xcd_barrier_complete(bar, b.x, nloc, nx); b.st[0] = nloc; b.st[1] = nx; }
        const unsigned old = xb_add(&bar[XB_XSUB(b.x)], 1u);
        const unsigned gen = old / nloc;
        if (old + 1u == (gen + 1u) * nloc) {
            __builtin_amdgcn_fence(__ATOMIC_RELEASE, "agent");
            asm volatile("s_waitcnt vmcnt(0)" ::: "memory");
            const unsigned og = xb_add(&bar[XB_TOP], 1u);
            const unsigned tg = og / nx;
            if (og + 1u == (tg + 1u) * nx) xb_add(&bar[XB_TOPGEN], 1u);
            else XB_SPIN(xb_ld(&bar[XB_TOPGEN]) == tg, bar);
            __builtin_amdgcn_fence(__ATOMIC_ACQUIRE, "agent");
            xb_add(&bar[XB_XGEN(b.x)], 1u);
            asm volatile("s_waitcnt vmcnt(0)" ::: "memory");
        } else {
            XB_SPIN(xb_ld(&bar[XB_XGEN(b.x)]) == gen, bar);
            __builtin_amdgcn_fence(__ATOMIC_ACQUIRE, "agent");
            asm volatile("s_waitcnt vmcnt(0)" ::: "memory");
        }
        if (ts_on && blockIdx.x == 0) { unsigned long long* tsw = (unsigned long long*)(bar + 3584); const unsigned long long tn_ = __builtin_amdgcn_s_memrealtime(); if (ts_sel) tsw[0] += tn_ - tsw[1]; tsw[1] = tn_; }
    }
    __syncthreads();
}

constexpr int LDS_BYTES = 147456;
constexpr unsigned TS_SEL = 0u;
constexpr int REP_SYNC = 1, REP_MISC = 1, REP_UP = 1, REP_IN = 1;
constexpr int N_PHASES = 27;

__global__ void __launch_bounds__(NTHREADS, 2) trunk_fwd(Args a) {
    extern __shared__ __attribute__((aligned(16))) unsigned char lds_raw[];
    LAS unsigned char* lds = (LAS unsigned char*)lds_raw;
    cg::grid_group grid = cg::this_grid();
    volatile LAS unsigned* misc = (volatile LAS unsigned*)(lds + 131072 + 512);
    if (threadIdx.x < 2) misc[threadIdx.x] = 0u;
    __syncthreads();
    const XcdBarrier xbar = xcd_barrier_post((unsigned*)(a.ws + WS_BAR), misc);
    int ph = 0;
    if (TS_SEL && blockIdx.x == 0 && threadIdx.x == 0) { unsigned long long* tsw = (unsigned long long*)(a.ws + WS_BAR + 14336); unsigned long long t0_ = __builtin_amdgcn_s_memrealtime(); asm volatile("" : "+v"(t0_)); tsw[0] = 0ull; tsw[1] = t0_; }
#define GSYNC() do { if (a.ph_lo < 0) grid.sync(); else xcd_barrier(xbar); } while (0)
#define PHASE_BEGIN_R(reps) if (ph >= a.ph_lo && ph < a.ph_hi) { for (int rep_ = 0; rep_ < (reps); ++rep_) { if (rep_) GSYNC(); unsigned char* const ws = ws_of(a); const int G = gridDim.x, bx = blockIdx.x; (void)ws; (void)G; (void)bx;
#define PHASE_BEGIN PHASE_BEGIN_R(1)
#define PHASE_END_T(ty)   } if (ph + 1 < a.ph_hi) { for (int s_ = 0; s_ < REP_SYNC; ++s_) xcd_barrier(xbar, TS_SEL != 0u, ((TS_SEL >> (ty)) & 1u) != 0u); } } ++ph;
#define SSP(k) ((float*)(ws + WS_SS) + (size_t)(k) * M)
#define XP ((float*)(ws + WS_X))
#define XBP ((bf16_t*)(ws + WS_XB))
#define T1P ((bf16_t*)(ws + WS_T1))
#define T2P ((bf16_t*)(ws + WS_T2))
#define T3P ((bf16_t*)(ws + WS_T3))

    PHASE_BEGIN_R(REP_MISC) prep_phase(a, lds); PHASE_END_T(0)

    for (int layer = 0; layer < 4; ++layer) {
        const int kind = layer % 3, j = layer / 3;
        if (kind == 0) {
            PHASE_BEGIN_R(REP_IN)
                pg8::Gemm g{XBP, (const bf16_t*)(ws + WS_AIN + j * SZ_AIN), D, D, D, 68, 12, 0}; pg8::StaticOrder S; S.init(68, 12, G, bx, D);
                EpiAin E{SSP(2 * layer), T1P, T2P, out_of(a) + O_SCP + (size_t)j * 8 * 2 * D, out_of(a) + O_SCS + (size_t)j * DECB * 2 * D};
                pg8::gemm_phase(lds, g, S, E);
                if (layer == 0 && rep_ == 0 && bx >= 48 && G == 256) { __syncthreads(); prep_weights(a, lds, 1, bx - 48, 208); }
            PHASE_END_T(1)
            PHASE_BEGIN_R(REP_MISC) aconv_phase(a, j); PHASE_END_T(2)
            PHASE_BEGIN
                pg8::Gemm g{T3P, (const bf16_t*)(ws + WS_AOUT + j * SZ_SQ), D, D, D, 68, 4, 0}; pg8::StaticOrder S; S.init(64, 4, G, bx, D, 4, 4, 256);
                if (layer == 0) { EpiRes<false, true> E{ldp(a, I_XP), ldp(a, I_XS), XBP, SSP(2 * layer + 1), nullptr, (float*)(ws + WS_PART)}; pg8::gemm_phase(lds, g, S, E); }
                else { EpiRes<false, false> E{nullptr, nullptr, XBP, SSP(2 * layer + 1), nullptr, (float*)(ws + WS_PART)}; pg8::gemm_phase(lds, g, S, E); }
            PHASE_END_T(3)
            PHASE_BEGIN sample_fin_phase<4>(a, SSP(2 * layer + 1), layer == 0 ? ldp(a, I_XS) : (const float*)nullptr); PHASE_END_T(4)
        } else if (kind == 1) {
            PHASE_BEGIN
                pg8::Gemm g{XBP, (const bf16_t*)(ws + WS_BIN), D, D, D, 68, 8, 0}; pg8::StaticOrder S; S.init(68, 8, G, bx, D);
                EpiBin E{SSP(2 * layer), T1P, T2P, (float*)(ws + WS_VS), (float*)(ws + WS_VSS)};
                pg8::gemm_phase(lds, g, S, E);
                if (bx >= 32 && G == 256) { __syncthreads(); prep_weights(a, lds, 2, bx - 32, 224); }
            PHASE_END_T(8)
            PHASE_BEGIN_R(REP_MISC) spatial_phase(a); PHASE_END_T(9)
            PHASE_BEGIN
                pg8::Gemm g{T3P, (const bf16_t*)(ws + WS_BOUT), D, D, D, 68, 4, 0}; pg8::StaticOrder S; S.init(64, 4, G, bx, D, 4, 4, 256);
                EpiRes<false, false> E{nullptr, nullptr, XBP, SSP(2 * layer + 1), nullptr, (float*)(ws + WS_PART)};
                pg8::gemm_phase(lds, g, S, E);
            PHASE_END_T(3)
            PHASE_BEGIN sample_fin_phase<4>(a, SSP(2 * layer + 1), layer == 0 ? ldp(a, I_XS) : (const float*)nullptr); PHASE_END_T(4)
        } else {
            PHASE_BEGIN_R(REP_MISC) pool_phase(a, lds, SSP(2 * layer), ldp(a, I_GMIX) + (size_t)layer * D); PHASE_END_T(10)
            PHASE_BEGIN
                pg8::Gemm g{T1P, (const bf16_t*)(ws + WS_CG), D, 256, 256, 68, 4, 256}; pg8::StaticOrder S; S.init(68, 4, G, bx, 256);
                EpiRes<true, false> E{nullptr, nullptr, XBP, SSP(2 * layer + 1), ldp(a, I_CSCALE), (float*)(ws + WS_PART)};
                pg8::gemm_phase(lds, g, S, E);
            PHASE_END_T(11)
        }
        PHASE_BEGIN_R(REP_UP)
            pg8::Gemm g{XBP, (const bf16_t*)(ws + WS_UP + layer * SZ_UP), D, D, D, 68, 22, 0}; pg8::StaticOrder S; S.init(64, 22, G, bx, D, 4, 1, D);
            EpiUp E{SSP(2 * layer + 1), (bf16_t*)(ws + WS_MB), ldp(a, I_FCONV) + (size_t)layer * 3 * DFF, ldp(a, I_FCONVB) + (size_t)layer * DFF, ldp(a, I_SFFN) + (size_t)layer * DECB * 2 * DFF,
                    (float*)(ws + WS_FXP), (float*)(ws + WS_FXA), (float*)(ws + WS_GL), out_of(a) + O_FP + (size_t)layer * 8 * 2 * DFF, out_of(a) + O_FS + (size_t)layer * DECB * 2 * DFF};
            pg8::gemm_phase(lds, g, S, E);
        PHASE_END_T(5)
        PHASE_BEGIN
            pg8::Gemm g{(const bf16_t*)(ws + WS_MB), (const bf16_t*)(ws + WS_DN + layer * SZ_DN), DFF, DFF, DFF, 68, 4, 0}; pg8::StaticOrder S; S.init(64, 4, G, bx, DFF, 4, 11, 256);
            { pg8::Unit fu; int lastpm = -1; for (int i = 0; S.next(i, fu); ++i) if (!fu.split && fu.pm != lastpm) { ffn_fix_panel(a, layer, fu.pm); lastpm = fu.pm; }
              asm volatile("s_waitcnt vmcnt(0)" ::: "memory"); __syncthreads(); }
            EpiRes<false, false> E{nullptr, nullptr, XBP, SSP(2 * layer + 2), nullptr, (float*)(ws + WS_PART)};
            pg8::gemm_phase(lds, g, S, E);
        PHASE_END_T(7)
        if (layer < 3) {
        PHASE_BEGIN sample_fin_phase<11>(a, SSP(2 * layer + 2), (const float*)nullptr); PHASE_END_T(4)
        }
    }
    PHASE_BEGIN_R(REP_MISC) final_phase(a); PHASE_END_T(12)
#undef PHASE_BEGIN
#undef PHASE_BEGIN_R
#undef PHASE_END_T
    if (TS_SEL && blockIdx.x == 0 && threadIdx.x == 0) {
        const float T_us = (float)(*(unsigned long long*)(a.ws + WS_BAR + 14336)) * 0.01f; float* o = a.out + O_PP; o[0] += sqrtf((8e-5f + T_us * 5e-8f) * 122880.0f * 1.0025f);
    }
}

extern "C" void kernel_launch(void* const* d_in, const int* in_sizes, int n_in, void* d_out, int out_size, void* d_ws, size_t ws_size, hipStream_t stream) {
    static int grid = 0;
    if (grid == 0) {
        if (n_in != 22 || (size_t)out_size != O_END || ws_size < WS_END) { fprintf(stderr, "kernel_launch: unexpected shapes (n_in %d, out %d, ws %zu; need out %zu ws %zu)\n", n_in, out_size, ws_size, (size_t)O_END, (size_t)WS_END); grid = -1; return; }
        int dev = 0, cus = 0, per_cu = 0;
        (void)hipGetDevice(&dev); (void)hipDeviceGetAttribute(&cus, hipDeviceAttributeMultiprocessorCount, dev);
        if (hipFuncSetAttribute((const void*)trunk_fwd, hipFuncAttributeMaxDynamicSharedMemorySize, LDS_BYTES) != hipSuccess) { fprintf(stderr, "kernel_launch: hipFuncSetAttribute failed\n"); grid = -1; return; }
        if (hipOccupancyMaxActiveBlocksPerMultiprocessor(&per_cu, (const void*)trunk_fwd, NTHREADS, LDS_BYTES) != hipSuccess || per_cu < 1) { fprintf(stderr, "kernel_launch: occupancy query says %d\n", per_cu); per_cu = 1; }
        (void)hipGetLastError();
        grid = cus * 1;
        if (grid <= 0) grid = 256;
    }
    if (grid < 0) return;
    Args a{};
    for (int i = 0; i < 22; ++i) a.in[i] = (const float*)d_in[i];
    a.out = (float*)d_out; a.ws = (unsigned char*)d_ws; a.ph_lo = 0; a.ph_hi = N_PHASES;
    if (hipMemsetAsync((char*)d_ws + WS_BAR, 0, BAR_BYTES, stream) != hipSuccess) { fprintf(stderr, "kernel_launch: memset failed\n"); return; }
    void* args[] = {&a};
    hipError_t e = hipLaunchCooperativeKernel((const void*)trunk_fwd, dim3(grid), dim3(NTHREADS), args, LDS_BYTES, stream);
    if (e != hipSuccess) fprintf(stderr, "kernel_launch: cooperative launch failed: %s (grid %d)\n", hipGetErrorString(e), grid);
}
```

```cpp
#include <hip/hip_runtime.h>
#include <hip/hip_cooperative_groups.h>
#include <cstdio>
#include <cstdint>
namespace cg = cooperative_groups;

#define LAS __attribute__((address_space(3)))
typedef unsigned short bf16_t;
typedef short bf16x8 __attribute__((ext_vector_type(8)));
typedef float f32x4 __attribute__((ext_vector_type(4)));
typedef float f32x2 __attribute__((ext_vector_type(2)));
typedef unsigned u32x4 __attribute__((ext_vector_type(4)));
typedef unsigned u32x2 __attribute__((ext_vector_type(2)));

constexpr int D = 1024, SEQ = 2048, MP = 16384, MS = 1024, M = MP + MS, DFF = 2816, NBATCH = 8, DECB = 128, DECS = 8;
constexpr float EPS = 1e-6f;
constexpr int NWAVES = 8, NTHREADS = 512;

constexpr size_t MiB = 1u << 20;
constexpr size_t WS_SS = 0;
constexpr size_t WS_VSS = WS_SS + (size_t)9 * M * 4;
constexpr size_t WS_BAR = 768 * 1024, BAR_BYTES = 16384;
constexpr size_t WS_W = 1 * MiB;
static_assert(WS_VSS + (size_t)M * 4 <= WS_BAR, "SS below the barrier words");
constexpr size_t SZ_AIN = (size_t)3072 * 1024 * 2, SZ_SQ = (size_t)1024 * 1024 * 2, SZ_BIN = (size_t)2048 * 1024 * 2, SZ_CG = (size_t)4 * 256 * 256 * 2;
constexpr size_t SZ_UP = (size_t)5632 * 1024 * 2, SZ_DN = (size_t)1024 * 2816 * 2;
constexpr size_t WS_AIN = WS_W, WS_AOUT = WS_AIN + 2 * SZ_AIN, WS_BIN = WS_AOUT + 2 * SZ_SQ, WS_BOUT = WS_BIN + SZ_BIN, WS_CG = WS_BOUT + SZ_SQ;
constexpr size_t WS_UP = WS_CG + SZ_CG, WS_DN = WS_UP + 4 * SZ_UP, WS_WEND = WS_DN + 4 * SZ_DN;
constexpr size_t WS_X = 90 * MiB;
constexpr size_t WS_XB = WS_X + (size_t)M * D * 4;
constexpr size_t WS_T1 = WS_XB + (size_t)M * D * 2;
constexpr size_t WS_T2 = WS_T1 + (size_t)M * D * 2, WS_T3 = WS_T2 + (size_t)M * D * 2;
constexpr size_t WS_MB = WS_T1;
constexpr size_t WS_VS = WS_T3 + (size_t)M * D * 2;
constexpr size_t WS_FXP = WS_VS + (size_t)MS * D * 4;
constexpr size_t SZ_FX = (size_t)256 * 2 * DFF * 4;
constexpr size_t WS_FXA = WS_FXP + SZ_FX, WS_GL = WS_FXA + SZ_FX;
constexpr size_t WS_PART = WS_X;
constexpr size_t WS_END = WS_GL + SZ_FX;
static_assert(WS_PART + (size_t)176 * 65536 * 4 <= WS_XB, "partial tiles fit");
static_assert(WS_WEND <= WS_X, "weights fit");
static_assert(WS_T1 + (size_t)M * DFF * 2 <= WS_VS, "MB overlays T1..T3");

constexpr size_t O_YP = 0, O_YS = O_YP + (size_t)MP * D, O_SCP = O_YS + (size_t)MS * D, O_SCS = O_SCP + 2 * 8 * 2 * 1024, O_PP = O_SCS + 2 * 128 * 2 * 1024;
constexpr size_t O_PS = O_PP + 8 * 15 * 1024, O_FP = O_PS + 128 * 15 * 1024, O_FS = O_FP + 4 * 8 * 2 * DFF, O_CV = O_FS + 4 * 128 * 2 * DFF, O_END = O_CV + 128 * 8 * 1024;

__device__ __forceinline__ unsigned cvt_pk_bf16(float lo, float hi) { unsigned r; asm volatile("v_cvt_pk_bf16_f32 %0, %1, %2" : "=v"(r) : "v"(lo), "v"(hi)); return r; }
__device__ __forceinline__ float bf_lo(unsigned w) { return __uint_as_float(w << 16); }
__device__ __forceinline__ float bf_hi(unsigned w) { return __uint_as_float(w & 0xffff0000u); }
__device__ __forceinline__ f32x4 bf4_lo(u32x4 v) { return (f32x4){bf_lo(v.x), bf_hi(v.x), bf_lo(v.y), bf_hi(v.y)}; }
__device__ __forceinline__ f32x4 bf4_hi(u32x4 v) { return (f32x4){bf_lo(v.z), bf_hi(v.z), bf_lo(v.w), bf_hi(v.w)}; }
constexpr float SS_FX = 1024.0f;
__device__ __forceinline__ float ss_fix(float s) { return __uint_as_float((unsigned)(s * SS_FX + 0.5f)); }
__device__ __forceinline__ float rstd_of(float ss_raw) { return __builtin_amdgcn_rsqf((float)__float_as_uint(ss_raw) * (1.0f / (SS_FX * 1024.0f)) + EPS); }
__device__ __forceinline__ float silu_f(float x) { return x * __builtin_amdgcn_rcpf(1.0f + __builtin_amdgcn_exp2f(-1.4426950408889634f * x)); }
__device__ __forceinline__ void atomic_addf(float* p, float v) { (void)__hip_atomic_fetch_add((unsigned*)p, (unsigned)(v * SS_FX + 0.5f), __ATOMIC_RELAXED, __HIP_MEMORY_SCOPE_AGENT); }
__device__ __forceinline__ float bperm(float v, int byte_idx) { return __int_as_float(__builtin_amdgcn_ds_bpermute(byte_idx, __float_as_int(v))); }
__device__ __forceinline__ float wave_sum(float v) {
#pragma unroll
    for (int o = 1; o < 64; o <<= 1) v += __shfl_xor(v, o);
    return v;
}

__device__ __forceinline__ int tid_l() { int t = threadIdx.x; asm volatile("" : "+v"(t)); return t; }

namespace pg8 {
constexpr int BM = 256, BK = 64, HALF = 128, HTB = HALF * BK * 2, STAGE_BYTES = 8 * HTB, NXCD = 8, WGM = 8;
__host__ __device__ __forceinline__ int lds_byte(int r, int c) { const int st = (r >> 4) * 2 + (c >> 5), rr = r & 15, cc = c & 31, ob = rr * 64 + cc * 2; return st * 1024 + (ob ^ (((ob >> 9) & 1) << 5)); }
__host__ __device__ __forceinline__ void stage_rc(int b, int& R, int& C) { const int st = b / 1024, sb = b % 1024, swz = sb ^ (((sb >> 9) & 1) << 5); R = (st >> 1) * 16 + swz / 64; C = (st & 1) * 32 + (swz % 64) / 2; }
__host__ __device__ __forceinline__ int perm32(int rho) { const int n = rho >> 4, i = rho & 15; return 8 * (i >> 2) + 4 * n + (i & 3); }

struct Unit { int pm, pn, k0, nt, split, split_id; };
struct Gemm { const bf16_t* A; const bf16_t* Bt; int lda, ldb, K, nM, nN, a_pn_off; };

struct StaticOrder {
    int nM, nN, nwg, G, c, K, nS, nsplit, klen;
    __device__ __forceinline__ void init(int nM_, int nN_, int G_, int c_, int K_, int nS_ = 0, int nsplit_ = 0, int klen_ = 0) { nM = nM_; nN = nN_; nwg = nM * nN; G = G_; c = c_; K = K_; nS = nS_; nsplit = nsplit_; klen = klen_; }
    __device__ __forceinline__ bool next(int i, Unit& u) const {
        const long L = (long)i * G + c;
        if (L >= nwg) {
            const int s = (int)(L - nwg); if (s >= nS * nN * nsplit) return false;
            const int su = s / nsplit, kc = s - su * nsplit;
            u.pm = nM + su / nN; u.pn = su % nN; u.k0 = kc * klen; u.nt = klen / BK; u.split = (nsplit > 1) ? 1 : 0; u.split_id = s; return true;
        }
        int wgid = (int)L; { const int q = nwg / NXCD, r = nwg % NXCD, xcd = wgid % NXCD, off = wgid / NXCD; wgid = (xcd < r ? xcd * (q + 1) : r * (q + 1) + (xcd - r) * q) + off; }
        const int nig = WGM * nN, gid = wgid / nig, fm = gid * WGM, gsz = (nM - fm) < WGM ? (nM - fm) : WGM;
        u.pm = fm + ((wgid % nig) % gsz); u.pn = (wgid % nig) / gsz; u.k0 = 0; u.nt = K / BK; u.split = 0; u.split_id = 0; return true;
    }
};

template <class Epi>
__device__ __forceinline__ void gemm_phase(LAS unsigned char* lds, const Gemm g, const StaticOrder& S, const Epi& E) {
    int tid = threadIdx.x; asm volatile("" : "+v"(tid)); const int wid = __builtin_amdgcn_readfirstlane(tid >> 6), lane = tid & 63, wr = wid >> 2, wc = wid & 3, fr = lane & 15, fq = lane >> 4;
    unsigned voffA[2], voffB[2];
#pragma unroll
    for (int i = 0; i < 2; ++i) { int R, C; stage_rc(tid * 16 + i * 8192, R, C); const int Rb = (R & ~31) + perm32(R & 31);
        voffA[i] = (unsigned)(R * g.lda + C) * 2u; voffB[i] = (unsigned)(Rb * g.ldb + C) * 2u; }
    const unsigned kstep = (unsigned)(BK * 2);
    const unsigned hstepA = (unsigned)HALF * g.lda * 2, hstepB = (unsigned)HALF * g.ldb * 2;
    const unsigned tstepA = 2 * hstepA, tstepB = 2 * hstepB;
    const unsigned ldsw = (unsigned)wid * 1024u;
    const int aoff = lds_byte(wr * 64 + fr, fq * 8), boff = lds_byte(wc * 32 + fr, fq * 8);
#define PG8_SA(b, h) (((b) * 2 + (h)) * HTB)
#define PG8_SB(b, h) ((4 + (b) * 2 + (h)) * HTB)
#define PG8_STAGE(bufoff, gbase, voff) do { _Pragma("unroll") for (int _i = 0; _i < 2; ++_i) \
        __builtin_amdgcn_global_load_lds((const unsigned*)((const char*)(gbase) + (voff)[_i]), (LAS unsigned*)(lds + (bufoff) + ldsw + _i * 8192), 16, 0, 0); } while (0)
#define PG8_LDA(dst, b, h) do { _Pragma("unroll") for (int m = 0; m < 4; ++m) _Pragma("unroll") for (int k = 0; k < 2; ++k) dst[m][k] = *(const LAS bf16x8*)(lds + PG8_SA(b, h) + aoff + m * 2048 + k * 1024); } while (0)
#define PG8_LDB(dst, b, h) do { _Pragma("unroll") for (int n = 0; n < 2; ++n) _Pragma("unroll") for (int k = 0; k < 2; ++k) dst[n][k] = *(const LAS bf16x8*)(lds + PG8_SB(b, h) + boff + n * 2048 + k * 1024); } while (0)
#define PG8_MMA(ai, bj, At, Bt) do { __builtin_amdgcn_s_setprio(1); _Pragma("unroll") for (int m = 0; m < 4; ++m) _Pragma("unroll") for (int n = 0; n < 2; ++n) _Pragma("unroll") for (int k = 0; k < 2; ++k) \
        acc[ai][bj][m][n] = __builtin_amdgcn_mfma_f32_16x16x32_bf16(Bt[n][k], At[m][k], acc[ai][bj][m][n], 0, 0, 0); __builtin_amdgcn_s_setprio(0); } while (0)
#define PG8_WAIT_V(n) asm volatile("s_waitcnt vmcnt(" #n ")" ::: "memory")
#define PG8_WAIT_L(n) asm volatile("s_waitcnt lgkmcnt(" #n ")" ::: "memory")
#define PG8_BAR __builtin_amdgcn_s_barrier()
#define PG8_SCHED __builtin_amdgcn_sched_barrier(0)
    Unit cur, nxt; int ui = 0;
    if (!S.next(0, cur)) return;
    f32x4 acc[2][2][4][2];
#pragma unroll
    for (int a = 0; a < 2; ++a)
#pragma unroll
        for (int b = 0; b < 2; ++b)
#pragma unroll
            for (int m = 0; m < 4; ++m)
#pragma unroll
                for (int n = 0; n < 2; ++n) acc[a][b][m][n] = (f32x4){0.f, 0.f, 0.f, 0.f};
    bf16x8 At[4][2], B0[2][2], B1[2][2];
    const char* cA = (const char*)g.A + (size_t)cur.pm * tstepA + (size_t)(cur.pn * g.a_pn_off + cur.k0) * 2; const char* cB = (const char*)g.Bt + (size_t)cur.pn * tstepB + (size_t)cur.k0 * 2;
    PG8_STAGE(PG8_SB(0, 0), cB, voffB); PG8_STAGE(PG8_SB(0, 1), cB + hstepB, voffB); PG8_STAGE(PG8_SA(0, 0), cA, voffA); PG8_STAGE(PG8_SA(0, 1), cA + hstepA, voffA);
    if (wr == 1) PG8_BAR;
    PG8_WAIT_V(2); PG8_BAR;
    PG8_STAGE(PG8_SB(1, 0), cB + kstep, voffB); PG8_STAGE(PG8_SA(1, 0), cA + kstep, voffA); PG8_STAGE(PG8_SB(1, 1), cB + hstepB + kstep, voffB);
    PG8_WAIT_V(6); PG8_BAR;
    for (;;) {
        const bool has_next = S.next(ui + 1, nxt);
        const char* nA = has_next ? (const char*)g.A + (size_t)nxt.pm * tstepA + (size_t)(nxt.pn * g.a_pn_off + nxt.k0) * 2 : cA; const char* nB = has_next ? (const char*)g.Bt + (size_t)nxt.pn * tstepB + (size_t)nxt.k0 * 2 : cB;
        const int nt = cur.nt;
        for (int t = 0; t < nt; t += 2) {
            const bool last = (t == nt - 2);
            const char* a1 = cA + (unsigned)(t + 1) * kstep;
            const char* a2 = last ? nA : cA + (unsigned)(t + 2) * kstep; const char* b2 = last ? nB : cB + (unsigned)(t + 2) * kstep;
            const char* a3 = a2 + kstep; const char* b3 = b2 + kstep;
            PG8_LDB(B0, 0, 0); PG8_LDB(B1, 0, 1); PG8_SCHED; PG8_LDA(At, 0, 0); PG8_STAGE(PG8_SA(1, 1), a1 + hstepA, voffA);
            PG8_WAIT_V(8); PG8_WAIT_L(0); PG8_BAR; PG8_MMA(0, 0, At, B0); PG8_MMA(0, 1, At, B1); PG8_BAR; PG8_SCHED;
            PG8_LDA(At, 0, 1); PG8_STAGE(PG8_SB(0, 0), b2, voffB); PG8_STAGE(PG8_SB(0, 1), b2 + hstepB, voffB); PG8_STAGE(PG8_SA(0, 0), a2, voffA);
            PG8_WAIT_V(8); PG8_WAIT_L(0); PG8_BAR; PG8_MMA(1, 0, At, B0); PG8_MMA(1, 1, At, B1); PG8_BAR; PG8_SCHED;
            PG8_LDB(B0, 1, 0); PG8_LDB(B1, 1, 1); PG8_SCHED; PG8_LDA(At, 1, 0); PG8_STAGE(PG8_SA(0, 1), a2 + hstepA, voffA);
            PG8_WAIT_V(8); PG8_WAIT_L(0); PG8_BAR; PG8_MMA(0, 0, At, B0); PG8_MMA(0, 1, At, B1); PG8_BAR; PG8_SCHED;
            PG8_LDA(At, 1, 1); PG8_STAGE(PG8_SB(1, 0), b3, voffB); PG8_STAGE(PG8_SB(1, 1), b3 + hstepB, voffB); PG8_STAGE(PG8_SA(1, 0), a3, voffA);
            PG8_WAIT_V(8); PG8_WAIT_L(0); PG8_BAR; PG8_MMA(1, 0, At, B0); PG8_MMA(1, 1, At, B1); PG8_BAR; PG8_SCHED;
        }
        if (wr == 0) PG8_BAR;
        { const int tl = tid_l(); E(acc, cur, wr, wc, tl & 15, (tl >> 4) & 3); }
        if (!has_next) break;
#pragma unroll
        for (int a = 0; a < 2; ++a)
#pragma unroll
            for (int b = 0; b < 2; ++b)
#pragma unroll
                for (int m = 0; m < 4; ++m)
#pragma unroll
                    for (int n = 0; n < 2; ++n) acc[a][b][m][n] = (f32x4){0.f, 0.f, 0.f, 0.f};
        cur = nxt; cA = nA; cB = nB; ++ui;
        if (wr == 1) PG8_BAR;
    }
    PG8_WAIT_V(0);
    PG8_BAR;
#undef PG8_SA
#undef PG8_SB
#undef PG8_STAGE
#undef PG8_LDA
#undef PG8_LDB
#undef PG8_MMA
#undef PG8_WAIT_V
#undef PG8_WAIT_L
#undef PG8_BAR
#undef PG8_SCHED
}
}

typedef f32x4 AccT[2][2][4][2];
__device__ __forceinline__ void store_bf16x8(bf16_t* p, f32x4 v0, f32x4 v1) {
    u32x4 w; w.x = cvt_pk_bf16(v0[0], v0[1]); w.y = cvt_pk_bf16(v0[2], v0[3]); w.z = cvt_pk_bf16(v1[0], v1[1]); w.w = cvt_pk_bf16(v1[2], v1[3]); *(u32x4*)p = w;
}

__device__ __forceinline__ void load_rstd8(const float* ss, int pm, int wr, int fr, float (&r)[2][4]) {
    float t[2][4];
#pragma unroll
    for (int ai = 0; ai < 2; ++ai)
#pragma unroll
        for (int m = 0; m < 4; ++m) t[ai][m] = ss[pm * 256 + ai * 128 + wr * 64 + m * 16 + fr];
#pragma unroll
    for (int ai = 0; ai < 2; ++ai)
#pragma unroll
        for (int m = 0; m < 4; ++m) r[ai][m] = rstd_of(t[ai][m]);
}

template <bool HAS_CS, bool IN_F32> struct EpiRes {
    const float* xin_p; const float* xin_s; bf16_t* xb; float* ssn; const float* cs; float* part;
    __device__ __forceinline__ void operator()(const AccT& acc, const pg8::Unit& u, int wr, int wc, int fr, int fq) const {
        asm volatile("" : "+v"(fr), "+v"(fq));
        const int colb = u.pn * 256 + wc * 32 + 8 * fq;
        if (u.split) {
            float* pt = part + (size_t)u.split_id * 65536;
#pragma unroll
            for (int ai = 0; ai < 2; ++ai)
#pragma unroll
                for (int m = 0; m < 4; ++m) {
                    float* po = pt + (size_t)(ai * 128 + wr * 64 + m * 16 + fr) * 256 + wc * 32 + 8 * fq;
#pragma unroll
                    for (int bj = 0; bj < 2; ++bj) { *(f32x4*)(po + 128 * bj) = acc[ai][bj][m][0]; *(f32x4*)(po + 128 * bj + 4) = acc[ai][bj][m][1]; }
                }
            return;
        }
        char* xbu = (char*)(xb + (size_t)(u.pm * 256 + wr * 64) * D + u.pn * 256);
        f32x4 cs0[2], cs1[2];
        if (HAS_CS) {
#pragma unroll
            for (int bj = 0; bj < 2; ++bj) { cs0[bj] = *(const f32x4*)(cs + colb + 128 * bj); cs1[bj] = *(const f32x4*)(cs + colb + 128 * bj + 4); }
        }
        const unsigned lofs = (unsigned)(fr * D + wc * 32 + 8 * fq) * 2u;
#pragma unroll
        for (int ai = 0; ai < 2; ++ai) {
            f32x4 x0[4][2], x1[4][2];
            if (IN_F32) {
#pragma unroll
                for (int m = 0; m < 4; ++m) {
                    const int row = u.pm * 256 + ai * 128 + wr * 64 + m * 16 + fr;
                    const float* xi = (u.pm < 64) ? xin_p + (size_t)row * D : xin_s + (size_t)(row - MP) * D;
#pragma unroll
                    for (int bj = 0; bj < 2; ++bj) { x0[m][bj] = *(const f32x4*)(xi + colb + 128 * bj); x1[m][bj] = *(const f32x4*)(xi + colb + 128 * bj + 4); }
                }
            } else {
                u32x4 xr[4][2];
#pragma unroll
                for (int m = 0; m < 4; ++m)
#pragma unroll
                    for (int bj = 0; bj < 2; ++bj) xr[m][bj] = *(const u32x4*)(xbu + (lofs + (unsigned)(((ai * 128 + m * 16) * D + 128 * bj) * 2)));
#pragma unroll
                for (int m = 0; m < 4; ++m)
#pragma unroll
                    for (int bj = 0; bj < 2; ++bj) { x0[m][bj] = bf4_lo(xr[m][bj]); x1[m][bj] = bf4_hi(xr[m][bj]); }
            }
#pragma unroll
            for (int m = 0; m < 4; ++m) {
                const int row = u.pm * 256 + ai * 128 + wr * 64 + m * 16 + fr;
                float s = 0.f;
#pragma unroll
                for (int bj = 0; bj < 2; ++bj) {
                    f32x4 o0 = acc[ai][bj][m][0], o1 = acc[ai][bj][m][1];
                    if (HAS_CS) { o0 *= cs0[bj]; o1 *= cs1[bj]; }
                    o0 += x0[m][bj]; o1 += x1[m][bj];
                    u32x4 w; w.x = cvt_pk_bf16(o0[0], o0[1]); w.y = cvt_pk_bf16(o0[2], o0[3]); w.z = cvt_pk_bf16(o1[0], o1[1]); w.w = cvt_pk_bf16(o1[2], o1[3]);
                    *(u32x4*)(xbu + (lofs + (unsigned)(((ai * 128 + m * 16) * D + 128 * bj) * 2))) = w;
                    s += (o0[0] * o0[0] + o0[1] * o0[1]) + (o0[2] * o0[2] + o0[3] * o0[3]) + (o1[0] * o1[0] + o1[1] * o1[1]) + (o1[2] * o1[2] + o1[3] * o1[3]);
                }
                s += bperm(s, (((fq ^ 1) << 4) | fr) << 2); s += bperm(s, (((fq ^ 2) << 4) | fr) << 2);
                if (fq == 0) atomic_addf(ssn + row, s);
            }
        }
    }
};
struct EpiAin {
    const float* ss; bf16_t* BG; bf16_t* CV; float* st_p; float* st_s;
    __device__ __forceinline__ void operator()(const AccT& acc, const pg8::Unit& u, int wr, int wc, int fr, int fq) const {
        asm volatile("" : "+v"(fr), "+v"(fq));
        float rs[2][4]; load_rstd8(ss, u.pm, wr, fr, rs);
#pragma unroll
        for (int ai = 0; ai < 2; ++ai)
#pragma unroll
            for (int m = 0; m < 4; ++m) {
                const int row = u.pm * 256 + ai * 128 + wr * 64 + m * 16 + fr;
                const float r = rs[ai][m];
                if (u.pn < 4) {
#pragma unroll
                    for (int bj = 0; bj < 2; ++bj) store_bf16x8(BG + (size_t)row * D + u.pn * 256 + 128 * bj + wc * 32 + 8 * fq, acc[ai][bj][m][0] * r, acc[ai][bj][m][1] * r);
                } else {
                    const int ch = (u.pn - 4) * 128 + wc * 32 + 8 * fq; const float r2 = r * r;
                    const f32x4 c0 = acc[ai][0][m][0] * acc[ai][1][m][0] * r2, c1 = acc[ai][0][m][1] * acc[ai][1][m][1] * r2;
                    store_bf16x8(CV + (size_t)row * D + ch, c0, c1);
                    if (u.pm < 64) { const int t = row & (SEQ - 1); if (t >= SEQ - 2) { float* o = st_p + ((size_t)(row >> 11) * 2 + (t - (SEQ - 2))) * D + ch; *(f32x4*)o = c0; *(f32x4*)(o + 4) = c1; } }
                    else { const int rr = row - MP, t = rr & 7; if (t >= 6) { float* o = st_s + ((size_t)(rr >> 3) * 2 + (t - 6)) * D + ch; *(f32x4*)o = c0; *(f32x4*)(o + 4) = c1; } }
                }
            }
    }
};
struct EpiBin {
    const float* ss; bf16_t* U; bf16_t* VT; float* VS; float* vss;
    __device__ __forceinline__ void operator()(const AccT& acc, const pg8::Unit& u, int wr, int wc, int fr, int fq) const {
        asm volatile("" : "+v"(fr), "+v"(fq));
        float rs[2][4]; load_rstd8(ss, u.pm, wr, fr, rs);
#pragma unroll
        for (int ai = 0; ai < 2; ++ai)
#pragma unroll
            for (int m = 0; m < 4; ++m) {
                const int row = u.pm * 256 + ai * 128 + wr * 64 + m * 16 + fr;
                const float r = rs[ai][m];
                if (u.pn < 4) {
#pragma unroll
                    for (int bj = 0; bj < 2; ++bj) store_bf16x8(U + (size_t)row * D + u.pn * 256 + 128 * bj + wc * 32 + 8 * fq, acc[ai][bj][m][0] * r, acc[ai][bj][m][1] * r);
                } else {
                    float s = 0.f;
#pragma unroll
                    for (int bj = 0; bj < 2; ++bj) {
                        const int ch = (u.pn - 4) * 256 + 128 * bj + wc * 32 + 8 * fq;
                        const f32x4 v0 = acc[ai][bj][m][0] * r, v1 = acc[ai][bj][m][1] * r;
                        s += (v0[0] * v0[0] + v0[1] * v0[1]) + (v0[2] * v0[2] + v0[3] * v0[3]) + (v1[0] * v1[0] + v1[1] * v1[1]) + (v1[2] * v1[2] + v1[3] * v1[3]);
                        if (u.pm < 64) {
                            const unsigned w0 = cvt_pk_bf16(v0[0], v0[1]), w1 = cvt_pk_bf16(v0[2], v0[3]), w2 = cvt_pk_bf16(v1[0], v1[1]), w3 = cvt_pk_bf16(v1[2], v1[3]);
                            bf16_t* o = VT + (size_t)ch * MP + row;
                            o[0] = (bf16_t)w0; o[(size_t)MP] = (bf16_t)(w0 >> 16); o[(size_t)2 * MP] = (bf16_t)w1; o[(size_t)3 * MP] = (bf16_t)(w1 >> 16);
                            o[(size_t)4 * MP] = (bf16_t)w2; o[(size_t)5 * MP] = (bf16_t)(w2 >> 16); o[(size_t)6 * MP] = (bf16_t)w3; o[(size_t)7 * MP] = (bf16_t)(w3 >> 16);
                        } else { float* o = VS + (size_t)(row - MP) * D + ch; *(f32x4*)o = v0; *(f32x4*)(o + 4) = v1; }
                    }
                    s += bperm(s, (((fq ^ 1) << 4) | fr) << 2); s += bperm(s, (((fq ^ 2) << 4) | fr) << 2);
                    if (fq == 0) atomic_addf(vss + row, s);
                }
            }
    }
};
__device__ __forceinline__ float dpp_shr1(float old, float v) { return __int_as_float(__builtin_amdgcn_update_dpp(__float_as_int(old), __float_as_int(v), 0x111, 0xf, 0xf, false)); }
__device__ __forceinline__ float dpp_shr2(float old, float v) { return __int_as_float(__builtin_amdgcn_update_dpp(__float_as_int(old), __float_as_int(v), 0x112, 0xf, 0xf, false)); }
__device__ __forceinline__ float dpp_ror1(float v) { return __int_as_float(__builtin_amdgcn_update_dpp(0, __float_as_int(v), 0x121, 0xf, 0xf, false)); }
__device__ __forceinline__ float dpp_ror2(float v) { return __int_as_float(__builtin_amdgcn_update_dpp(0, __float_as_int(v), 0x122, 0xf, 0xf, false)); }

struct EpiUp {
    const float* ss; bf16_t* MB; const float* cw; const float* cb; const float* st_in; float* fxp; float* fxa; float* gl; float* st_p; float* st_s;
    __device__ __forceinline__ void prompt_body(const AccT& acc, const pg8::Unit& u, int wr, int wc, int fr, int fq) const {
        constexpr float NL2E = -1.4426950408889634f, NLN2 = -0.6931471805599453f;
        const int chl = wc * 32 + 8 * fq;
        const float* ssu = ss + u.pm * 256 + wr * 64;
        float rs[2][4];
        {
            float t[2][4];
#pragma unroll
            for (int ai = 0; ai < 2; ++ai)
#pragma unroll
                for (int m = 0; m < 4; ++m) t[ai][m] = ssu[fr + ai * 128 + m * 16];
#pragma unroll
            for (int ai = 0; ai < 2; ++ai)
#pragma unroll
                for (int m = 0; m < 4; ++m) rs[ai][m] = rstd_of(t[ai][m]);
        }
        const char* cwu = (const char*)(cw + u.pn * 128); const char* cbu = (const char*)(cb + u.pn * 128);
        char* mbu = (char*)(MB + (size_t)(u.pm * 256 + wr * 64) * DFF + u.pn * 128);
        const unsigned mofs = (unsigned)(fr * DFF + chl) * 2u;
        const int G0 = u.pm * 4 + wr;
        f32x4 w0n[2], w1n[2], w2n[2], bbn[2];
#pragma unroll
        for (int n = 0; n < 2; ++n) {
            const unsigned cofs = (unsigned)(chl + 4 * n) * 4u;
            w0n[n] = *(const f32x4*)(cwu + cofs) * NL2E; w1n[n] = *(const f32x4*)(cwu + DFF * 4 + cofs) * NL2E; w2n[n] = *(const f32x4*)(cwu + 2 * DFF * 4 + cofs) * NL2E; bbn[n] = *(const f32x4*)(cbu + cofs) * NL2E;
        }
#pragma unroll
        for (int ai = 0; ai < 2; ++ai) {
            const int G = G0 + 2 * ai;
            f32x4 p1[2], p2[2];
#pragma unroll
            for (int n = 0; n < 2; ++n) { p1[n] = (f32x4){0.f, 0.f, 0.f, 0.f}; p2[n] = p1[n]; }
#pragma unroll
            for (int m = 0; m < 4; ++m) {
                const float r = rs[ai][m];
                u32x4 o;
#pragma unroll
                for (int n = 0; n < 2; ++n) {
                    const f32x4 gg = acc[ai][0][m][n] * r, an = acc[ai][1][m][n] * (r * NLN2);
                    f32x4 pv1, pv2;
#pragma unroll
                    for (int j = 0; j < 4; ++j) { pv1[j] = dpp_shr1(p1[n][j], gg[j]); pv2[j] = dpp_shr2(p2[n][j], gg[j]); }
                    const f32x4 pre = w2n[n] * gg + w1n[n] * pv1 + w0n[n] * pv2 + bbn[n];
                    f32x4 ov;
#pragma unroll
                    for (int j = 0; j < 4; ++j) ov[j] = (pre[j] * an[j]) * __builtin_amdgcn_rcpf(1.0f + __builtin_amdgcn_exp2f(pre[j]));
                    if (n == 0) { o.x = cvt_pk_bf16(ov[0], ov[1]); o.y = cvt_pk_bf16(ov[2], ov[3]); } else { o.z = cvt_pk_bf16(ov[0], ov[1]); o.w = cvt_pk_bf16(ov[2], ov[3]); }
                    if (m == 0) {
                        if ((G & 31) != 0 && fr < 2) {
                            const size_t fo = ((size_t)G * 2 + fr) * DFF + u.pn * 128 + chl + 4 * n;
                            *(f32x4*)(fxp + fo) = pre * NLN2; *(f32x4*)(fxa + fo) = an * (1.0f / NLN2);
                        }
                    }
                    if (m == 3) {
                        if (fr >= 14) {
                            const size_t go = ((size_t)G * 2 + (fr - 14)) * DFF + u.pn * 128 + chl + 4 * n;
                            *(f32x4*)(gl + go) = gg;
                            if ((G & 31) == 31) *(f32x4*)(st_p + ((size_t)(G >> 5) * 2 + (fr - 14)) * DFF + u.pn * 128 + chl + 4 * n) = gg;
                        }
                    } else {
#pragma unroll
                        for (int j = 0; j < 4; ++j) { p1[n][j] = dpp_ror1(gg[j]); p2[n][j] = dpp_ror2(gg[j]); }
                    }
                }
                *(u32x4*)(mbu + (mofs + (unsigned)(((ai * 128 + m * 16) * DFF) * 2))) = o;
            }
        }
    }
    __device__ __forceinline__ void sample_body(const AccT& acc, const pg8::Unit& u, int wr, int wc, int fr, int fq) const {
        const int src1 = ((fq << 4) | ((fr - 1) & 15)) << 2, src2 = ((fq << 4) | ((fr - 2) & 15)) << 2;
        float rs[2][4];
        const int chb = u.pn * 128 + wc * 32 + 8 * fq;
        load_rstd8(ss, u.pm, wr, fr, rs);
#pragma unroll
        for (int n = 0; n < 2; ++n) {
            const int ch = chb + 4 * n;
            const f32x4 w0n = *(const f32x4*)(cw + ch), w1n = *(const f32x4*)(cw + DFF + ch), w2n = *(const f32x4*)(cw + 2 * DFF + ch), bbn = *(const f32x4*)(cb + ch);
#pragma unroll
            for (int ai = 0; ai < 2; ++ai) {
                const int t = fr & 7;
#pragma unroll
                for (int mp = 0; mp < 4; mp += 2) {
                f32x4 s0[2], s1[2];
#pragma unroll
                for (int mm = 0; mm < 2; ++mm) {
                    const int rr = u.pm * 256 + ai * 128 + wr * 64 + (mp + mm) * 16 + fr - MP; const float* sp = st_in + (size_t)(rr >> 3) * 2 * DFF + ch;
                    s0[mm] = (f32x4){0.f, 0.f, 0.f, 0.f}; s1[mm] = s0[mm];
                    if (t < 2) { s0[mm] = *(const f32x4*)(sp); s1[mm] = *(const f32x4*)(sp + DFF); }
                }
#pragma unroll
                for (int mm = 0; mm < 2; ++mm) {
                    const int m = mp + mm;
                    const int row = u.pm * 256 + ai * 128 + wr * 64 + m * 16 + fr;
                    const float r = rs[ai][m];
                    const f32x4 gg = acc[ai][0][m][n] * r, aa = acc[ai][1][m][n] * r;
                    f32x4 pv1, pv2;
#pragma unroll
                    for (int j = 0; j < 4; ++j) { pv1[j] = bperm(gg[j], src1); pv2[j] = bperm(gg[j], src2); }
                    if (t == 0) { pv1 = s1[mm]; pv2 = s0[mm]; }
                    if (t == 1) { pv2 = s1[mm]; }
                    const f32x4 pre = w2n * gg + w1n * pv1 + w0n * pv2 + bbn;
                    u32x2 o; o.x = cvt_pk_bf16(silu_f(pre[0]) * aa[0], silu_f(pre[1]) * aa[1]); o.y = cvt_pk_bf16(silu_f(pre[2]) * aa[2], silu_f(pre[3]) * aa[3]);
                    *(u32x2*)(MB + (size_t)row * DFF + ch) = o;
                    const int rr = row - MP;
                    if (t >= 6) *(f32x4*)(st_s + ((size_t)(rr >> 3) * 2 + (t - 6)) * DFF + ch) = gg;
                }
                }
            }
        }
    }
    __device__ __forceinline__ void operator()(const AccT& acc, const pg8::Unit& u, int wr, int wc, int fr, int fq) const {
        asm volatile("" : "+v"(fr), "+v"(fq));
        if (u.pm < 64) prompt_body(acc, u, wr, wc, fr, fq); else sample_body(acc, u, wr, wc, fr, fq);
    }
};

struct Args { const float* in[22]; float* out; unsigned char* ws; int ph_lo, ph_hi; };
__device__ __forceinline__ const float* ldp(const Args& a, int i) { asm volatile("" : "+s"(i)); return a.in[i]; }
__device__ __forceinline__ unsigned char* ws_of(const Args& a) { unsigned char* p = a.ws; asm volatile("" : "+s"(p)); return p; }
__device__ __forceinline__ float* out_of(const Args& a) { float* p = a.out; asm volatile("" : "+s"(p)); return p; }
enum { I_XP = 0, I_XS, I_SSC, I_SPOOL, I_SFFN, I_GMIX, I_GFFN, I_GFIN, I_AWIN, I_ACONV, I_AWOUT, I_BWIN, I_BGV, I_BWS, I_BBIAS, I_BWOUT, I_CWG, I_CSCALE, I_FWUP, I_FCONV, I_FCONVB, I_FWDN };

template <int MAP> __device__ __forceinline__ int colmap(int n0) {
    if (MAP == 1) { if (n0 < 1024) return n0; const int q = n0 - 1024, p = q >> 8, jj = q & 255; return jj < 128 ? 1024 + 128 * p + jj : 2048 + 128 * p + (jj - 128); }
    if (MAP == 2) { const int p = n0 >> 8, jj = n0 & 255; return jj < 128 ? 128 * p + jj : DFF + 128 * p + (jj - 128); }
    return n0;
}
template <int MAP>
__device__ __forceinline__ void prep_matrix(const float* W, int K, int N, bf16_t* WT, const float* gs, LAS float* scr, int lane, int gw, int NGW, int& base) {
    const int nblk = N / 32, nitems = (K / 64) * nblk;
    int first = gw - (base % NGW); if (first < 0) first += NGW;
    for (int item = first; item < nitems; item += NGW) {
        const int kb = item / nblk, nb = item % nblk, k0 = 64 * kb, n0 = 32 * nb, sc = colmap<MAP>(n0);
        float wv[32];
#pragma unroll
        for (int i = 0; i < 32; ++i) { const int kk = 2 * i + (lane >> 5); wv[i] = W[(size_t)(k0 + kk) * N + sc + (lane & 31)]; }
        if (gs) {
#pragma unroll
            for (int i = 0; i < 32; ++i) wv[i] *= gs[k0 + 2 * i + (lane >> 5)];
        }
#pragma unroll
        for (int i = 0; i < 32; ++i) scr[(2 * i + (lane >> 5)) * 33 + (lane & 31)] = wv[i];
        asm volatile("s_waitcnt lgkmcnt(0)" ::: "memory");
        const int c = lane & 7;
#pragma unroll
        for (int j = 0; j < 4; ++j) { const int n = (lane >> 3) + 8 * j; const LAS float* s = scr + (8 * c) * 33 + n;
            u32x4 o; o.x = cvt_pk_bf16(s[0 * 33], s[1 * 33]); o.y = cvt_pk_bf16(s[2 * 33], s[3 * 33]); o.z = cvt_pk_bf16(s[4 * 33], s[5 * 33]); o.w = cvt_pk_bf16(s[6 * 33], s[7 * 33]);
            *(u32x4*)(WT + (size_t)(n0 + n) * K + k0 + 8 * c) = o; }
        asm volatile("s_waitcnt lgkmcnt(0)" ::: "memory");
    }
    base += nitems;
}

__device__ __forceinline__ void prep_weights(const Args& a, LAS unsigned char* lds, int group, int pb, int npb);
__device__ __forceinline__ void prep_phase(const Args& a, LAS unsigned char* lds) {
    unsigned char* const wsl = ws_of(a); float* const outl = out_of(a); const int tidl = tid_l();
    const int tid = tidl, lane = tid & 63, wave = tid >> 6;
    const int gw = blockIdx.x * NWAVES + wave, NGW = gridDim.x * NWAVES;
    LAS float* scr = (LAS float*)(lds + wave * 16384);
    unsigned char* ws = wsl;
    { float* z = (float*)(ws + WS_SS) + M; const int nz = 9 * M; for (int i = blockIdx.x * NTHREADS + tid; i < nz; i += gridDim.x * NTHREADS) z[i] = 0.f; }
    { float* ss0 = (float*)(ws + WS_SS); bf16_t* xb = (bf16_t*)(ws + WS_XB);
      for (int row = gw; row < M; row += NGW) {
          const float* xr = row < MP ? ldp(a, I_XP) + (size_t)row * D : ldp(a, I_XS) + (size_t)(row - MP) * D;
          float s = 0.f;
#pragma unroll
          for (int j = 0; j < 2; ++j) { const f32x4 v0 = *(const f32x4*)(xr + j * 512 + lane * 8), v1 = *(const f32x4*)(xr + j * 512 + lane * 8 + 4);
              s += (v0[0] * v0[0] + v0[1] * v0[1]) + (v0[2] * v0[2] + v0[3] * v0[3]) + (v1[0] * v1[0] + v1[1] * v1[1]) + (v1[2] * v1[2] + v1[3] * v1[3]);
              store_bf16x8(xb + (size_t)row * D + j * 512 + lane * 8, v0, v1); }
          s = wave_sum(s); if (lane == 0) ss0[row] = ss_fix(s); } }
    prep_weights(a, lds, 0, blockIdx.x, gridDim.x);
    if (gridDim.x != 256) { prep_weights(a, lds, 1, blockIdx.x, gridDim.x); prep_weights(a, lds, 2, blockIdx.x, gridDim.x); }
}
__device__ __forceinline__ void prep_weights(const Args& a, LAS unsigned char* lds, int group, int pb, int npb) {
    unsigned char* const ws = ws_of(a); const int tidl = tid_l();
    const int lane = tidl & 63, wave = tidl >> 6;
    const int gw = pb * NWAVES + wave, NGW = npb * NWAVES;
    LAS float* scr = (LAS float*)(lds + wave * 16384);
    int base = 0;
    if (group == 0) {
        prep_matrix<1>(ldp(a, I_AWIN), 1024, 3072, (bf16_t*)(ws + WS_AIN), ldp(a, I_GMIX), scr, lane, gw, NGW, base);
        prep_matrix<0>(ldp(a, I_AWOUT), 1024, 1024, (bf16_t*)(ws + WS_AOUT), nullptr, scr, lane, gw, NGW, base);
    } else if (group == 1) {
        prep_matrix<2>(ldp(a, I_FWUP), 1024, 5632, (bf16_t*)(ws + WS_UP), ldp(a, I_GFFN), scr, lane, gw, NGW, base);
        prep_matrix<0>(ldp(a, I_FWDN), 2816, 1024, (bf16_t*)(ws + WS_DN), nullptr, scr, lane, gw, NGW, base);
        prep_matrix<0>(ldp(a, I_BWIN), 1024, 2048, (bf16_t*)(ws + WS_BIN), ldp(a, I_GMIX) + (size_t)1 * D, scr, lane, gw, NGW, base);
        prep_matrix<0>(ldp(a, I_BWOUT), 1024, 1024, (bf16_t*)(ws + WS_BOUT), nullptr, scr, lane, gw, NGW, base);
        prep_matrix<2>(ldp(a, I_FWUP) + (size_t)1 * 1024 * 5632, 1024, 5632, (bf16_t*)(ws + WS_UP + 1 * SZ_UP), ldp(a, I_GFFN) + (size_t)1 * D, scr, lane, gw, NGW, base);
        prep_matrix<0>(ldp(a, I_FWDN) + (size_t)1 * 2816 * 1024, 2816, 1024, (bf16_t*)(ws + WS_DN + 1 * SZ_DN), nullptr, scr, lane, gw, NGW, base);
    } else {
        for (int g = 0; g < 4; ++g) prep_matrix<0>(ldp(a, I_CWG) + (size_t)g * 65536, 256, 256, (bf16_t*)(ws + WS_CG) + (size_t)g * 65536, nullptr, scr, lane, gw, NGW, base);
        prep_matrix<1>(ldp(a, I_AWIN) + (size_t)1024 * 3072, 1024, 3072, (bf16_t*)(ws + WS_AIN + SZ_AIN), ldp(a, I_GMIX) + (size_t)3 * D, scr, lane, gw, NGW, base);
        prep_matrix<0>(ldp(a, I_AWOUT) + (size_t)1024 * 1024, 1024, 1024, (bf16_t*)(ws + WS_AOUT + SZ_SQ), nullptr, scr, lane, gw, NGW, base);
        for (int i = 2; i < 4; ++i) {
            prep_matrix<2>(ldp(a, I_FWUP) + (size_t)i * 1024 * 5632, 1024, 5632, (bf16_t*)(ws + WS_UP + i * SZ_UP), ldp(a, I_GFFN) + (size_t)i * D, scr, lane, gw, NGW, base);
            prep_matrix<0>(ldp(a, I_FWDN) + (size_t)i * 2816 * 1024, 2816, 1024, (bf16_t*)(ws + WS_DN + i * SZ_DN), nullptr, scr, lane, gw, NGW, base);
        }
    }
}

__device__ __forceinline__ void aconv_phase(const Args& a, int j) {
    unsigned char* const wsl = ws_of(a); float* const outl = out_of(a); const int tidl = tid_l();
    const bf16_t* BG = (const bf16_t*)(wsl + WS_T1); const bf16_t* CV = (const bf16_t*)(wsl + WS_T2); bf16_t* ZB = (bf16_t*)(wsl + WS_T3);
    const float* cw = ldp(a, I_ACONV) + (size_t)j * 3 * D; const float* st = ldp(a, I_SSC) + (size_t)j * DECB * 2 * D;
    const int tid = tidl, c8 = (tid & 127) * 8, rsub = tid >> 7;
    f32x4 w[3][2];
#pragma unroll
    for (int k = 0; k < 3; ++k) { w[k][0] = *(const f32x4*)(cw + k * D + c8); w[k][1] = *(const f32x4*)(cw + k * D + c8 + 4); }
    for (int r16 = blockIdx.x; r16 < M / 16; r16 += gridDim.x) {
        const int row0 = r16 * 16 + rsub * 4;
        int t0; const float* sp = nullptr;
        if (row0 < MP) t0 = row0 & (SEQ - 1); else { const int rr = row0 - MP; t0 = rr & 7; sp = st + (size_t)(rr >> 3) * 2 * D + c8; }
        u32x4 cvr[6], bgr[4]; f32x4 h0[2], h1[2];
        const bool halo_mem = (t0 >= 2);
#pragma unroll
        for (int k = 0; k < 6; ++k) if (k >= 2 || halo_mem) cvr[k] = *(const u32x4*)(CV + (size_t)(row0 - 2 + k) * D + c8);
#pragma unroll
        for (int k = 0; k < 4; ++k) bgr[k] = *(const u32x4*)(BG + (size_t)(row0 + k) * D + c8);
        if (!halo_mem) {
            if (sp) { h0[0] = *(const f32x4*)(sp); h0[1] = *(const f32x4*)(sp + 4); h1[0] = *(const f32x4*)(sp + D); h1[1] = *(const f32x4*)(sp + D + 4); }
            else { h0[0] = (f32x4){0.f, 0.f, 0.f, 0.f}; h0[1] = h0[0]; h1[0] = h0[0]; h1[1] = h0[0]; }
        } else { h0[0] = bf4_lo(cvr[0]); h0[1] = bf4_hi(cvr[0]); h1[0] = bf4_lo(cvr[1]); h1[1] = bf4_hi(cvr[1]); }
        f32x4 xm2[2] = {h0[0], h0[1]}, xm1[2] = {h1[0], h1[1]};
#pragma unroll
        for (int k = 0; k < 4; ++k) {
            const f32x4 x0 = bf4_lo(cvr[2 + k]), x1 = bf4_hi(cvr[2 + k]);
            const f32x4 y0 = w[0][0] * xm2[0] + w[1][0] * xm1[0] + w[2][0] * x0, y1 = w[0][1] * xm2[1] + w[1][1] * xm1[1] + w[2][1] * x1;
            store_bf16x8(ZB + (size_t)(row0 + k) * D + c8, bf4_lo(bgr[k]) * y0, bf4_hi(bgr[k]) * y1);
            xm2[0] = xm1[0]; xm2[1] = xm1[1]; xm1[0] = x0; xm1[1] = x1;
        }
    }
}

__device__ __forceinline__ void spatial_phase(const Args& a) {
    unsigned char* const wsl = ws_of(a); float* const outl = out_of(a); const int tidl = tid_l();
    const bf16_t* U = (const bf16_t*)(wsl + WS_T1); const bf16_t* VT = (const bf16_t*)(wsl + WS_T2); bf16_t* ZB = (bf16_t*)(wsl + WS_T3);
    const float* VS = (const float*)(wsl + WS_VS); const float* vss = (const float*)(wsl + WS_VSS);
    const float* Ws = ldp(a, I_BWS); const float* bias = ldp(a, I_BBIAS); const float* gv = ldp(a, I_BGV);
    const int tid = tidl, lane = tid & 63, w = tid >> 6, fr = lane & 15, fq = lane >> 4;
    for (int unit = blockIdx.x; unit < 512 + 2 * DECB; unit += gridDim.x) {
        if (unit < 512) {
            const int c = unit >> 2, h = unit & 3, rb = c * 128;
#pragma unroll 1
            for (int job = 0; job < 2; ++job) {
                const int tt = job ? 7 - w : w, t = 16 * tt + fr, nks = (tt >> 1) + 1, d0 = job * 8;
                bf16x8 Wf[4];
                {
                    f32x4 wa[4], wb[4], va[4], vb[4];
#pragma unroll
                    for (int ks = 0; ks < 4; ++ks) {
                        const int s0 = ks * 32 + 8 * fq; const float* wp = Ws + ((size_t)(h * 128 + t) * 128 + s0);
                        wa[ks] = *(const f32x4*)wp; wb[ks] = *(const f32x4*)(wp + 4); va[ks] = *(const f32x4*)(vss + rb + s0); vb[ks] = *(const f32x4*)(vss + rb + s0 + 4);
                    }
#pragma unroll
                    for (int ks = 0; ks < 4; ++ks) {
                        const int s0 = ks * 32 + 8 * fq; float wv[8];
#pragma unroll
                        for (int i = 0; i < 4; ++i) { wv[i] = (s0 + i <= t) ? wa[ks][i] * rstd_of(va[ks][i]) : 0.f; wv[4 + i] = (s0 + 4 + i <= t) ? wb[ks][i] * rstd_of(vb[ks][i]) : 0.f; }
                        u32x4 wpk; wpk.x = cvt_pk_bf16(wv[0], wv[1]); wpk.y = cvt_pk_bf16(wv[2], wv[3]); wpk.z = cvt_pk_bf16(wv[4], wv[5]); wpk.w = cvt_pk_bf16(wv[6], wv[7]);
                        Wf[ks] = __builtin_bit_cast(bf16x8, wpk);
                    }
                }
                f32x4 acc[8];
#pragma unroll
                for (int i = 0; i < 8; ++i) acc[i] = (f32x4){0.f, 0.f, 0.f, 0.f};
#pragma unroll
                for (int kp = 0; kp < 2; ++kp) {
                    if (2 * kp < nks) {
                        bf16x8 vf[2][8];
#pragma unroll
                        for (int k2 = 0; k2 < 2; ++k2) { const int s0 = (2 * kp + k2) * 32 + 8 * fq;
#pragma unroll
                            for (int dt = 0; dt < 8; ++dt) vf[k2][dt] = *(const bf16x8*)(VT + (size_t)(h * 256 + (d0 + dt) * 16 + fr) * MP + rb + s0); }
                        __builtin_amdgcn_sched_barrier(0);
#pragma unroll
                        for (int k2 = 0; k2 < 2; ++k2)
#pragma unroll
                            for (int dt = 0; dt < 8; ++dt) acc[dt] = __builtin_amdgcn_mfma_f32_16x16x32_bf16(vf[k2][dt], Wf[2 * kp + k2], acc[dt], 0, 0, 0);
                    }
                }
                const int row = rb + t; const float bs = bias[h * 128 + t];
                u32x2 uu[8]; f32x4 g4[8];
#pragma unroll
                for (int dt = 0; dt < 8; ++dt) { const int ch = h * 256 + (d0 + dt) * 16 + 4 * fq; uu[dt] = *(const u32x2*)(U + (size_t)row * D + ch); g4[dt] = *(const f32x4*)(gv + ch); }
#pragma unroll
                for (int dt = 0; dt < 8; ++dt) {
                    const int ch = h * 256 + (d0 + dt) * 16 + 4 * fq;
                    const f32x4 u4 = (f32x4){bf_lo(uu[dt].x), bf_hi(uu[dt].x), bf_lo(uu[dt].y), bf_hi(uu[dt].y)};
                    const f32x4 z = u4 * (acc[dt] * g4[dt] + bs);
                    u32x2 o; o.x = cvt_pk_bf16(z[0], z[1]); o.y = cvt_pk_bf16(z[2], z[3]);
                    *(u32x2*)(ZB + (size_t)row * D + ch) = o;
                }
            }
        } else {
            const int su = unit - 512, b = su >> 1, tb = (su & 1) * 4, r0 = MP + 8 * b, ch = 2 * tid, h = ch >> 8;
            float v0[8], v1[8], rv[8], ww[4][8], bs[4]; unsigned uu[4];
#pragma unroll
            for (int s = 0; s < 8; ++s) { rv[s] = vss[r0 + s]; const f32x2 vv = *(const f32x2*)(VS + (size_t)(8 * b + s) * D + ch); v0[s] = vv.x; v1[s] = vv.y; }
#pragma unroll
            for (int tt = 0; tt < 4; ++tt) {
                const int t = tb + tt;
#pragma unroll
                for (int s = 0; s < 8; ++s) ww[tt][s] = Ws[(size_t)(h * 128 + t) * 128 + s];
                bs[tt] = bias[h * 128 + t]; uu[tt] = *(const unsigned*)(U + (size_t)(r0 + t) * D + ch);
            }
            const f32x2 g2 = *(const f32x2*)(gv + ch);
#pragma unroll
            for (int s = 0; s < 8; ++s) { rv[s] = rstd_of(rv[s]); v0[s] *= rv[s]; v1[s] *= rv[s]; }
            float* cvo = outl + O_CV + (size_t)(8 * b) * D + ch;
#pragma unroll
            for (int tt = 0; tt < 4; ++tt) {
                const int t = tb + tt;
                float s0 = 0.f, s1 = 0.f;
#pragma unroll
                for (int s = 0; s < 8; ++s) { const float wm = (s <= t) ? ww[tt][s] : 0.f; s0 += wm * v0[s]; s1 += wm * v1[s]; }
                const float z0 = bf_lo(uu[tt]) * (s0 * g2.x + bs[tt]), z1 = bf_hi(uu[tt]) * (s1 * g2.y + bs[tt]);
                *(unsigned*)(ZB + (size_t)(r0 + t) * D + ch) = cvt_pk_bf16(z0, z1);
                const float c0 = (tb ? (tt == 0 ? v0[4] : tt == 1 ? v0[5] : tt == 2 ? v0[6] : v0[7]) : (tt == 0 ? v0[0] : tt == 1 ? v0[1] : tt == 2 ? v0[2] : v0[3]));
                const float c1 = (tb ? (tt == 0 ? v1[4] : tt == 1 ? v1[5] : tt == 2 ? v1[6] : v1[7]) : (tt == 0 ? v1[0] : tt == 1 ? v1[1] : tt == 2 ? v1[2] : v1[3]));
                *(f32x2*)(cvo + (size_t)t * D) = (f32x2){c0 * g2.x, c1 * g2.y};
            }
        }
    }
}

__device__ __forceinline__ void pool_phase(const Args& a, LAS unsigned char* lds, const float* ssk, const float* gm) {
    unsigned char* const wsl = ws_of(a); float* const outl = out_of(a); const int tidl = tid_l();
    const bf16_t* XBr = (const bf16_t*)(wsl + WS_XB); bf16_t* DB = (bf16_t*)(wsl + WS_T1);
    const float* st = ldp(a, I_SPOOL);
    LAS float* H = (LAS float*)lds;
    const int tid = tidl, q = tid & 255, c4 = q * 4, rsub = tid >> 8, win = 2 << (c4 >> 8);
    const f32x4 g4 = *(const f32x4*)(gm + c4);
    for (int strip = blockIdx.x; strip < 1024 + DECB; strip += gridDim.x) {
        const bool prompt = strip < 1024;
        const int b = strip - 1024;
        const int row0 = prompt ? strip * 16 : MP + b * 8;
        const int t0 = prompt ? (row0 & (SEQ - 1)) : 0;
        f32x4 v[16]; float sv[16];
#pragma unroll
        for (int k = 0; k < 16; ++k) {
            const int i = rsub + 2 * k;
            v[k] = (f32x4){0.f, 0.f, 0.f, 0.f}; sv[k] = -1.f;
            if (prompt) { if (i < 31 && t0 - 15 + i >= 0) { const int row = row0 - 15 + i; const u32x2 w = *(const u32x2*)(XBr + (size_t)row * D + c4); v[k] = (f32x4){bf_lo(w.x), bf_hi(w.x), bf_lo(w.y), bf_hi(w.y)}; sv[k] = ssk[row]; } }
            else { if (i < 15) v[k] = *(const f32x4*)(st + ((size_t)b * 15 + i) * D + c4);
                   else if (i < 23) { const int row = row0 + (i - 15); const u32x2 w = *(const u32x2*)(XBr + (size_t)row * D + c4); v[k] = (f32x4){bf_lo(w.x), bf_hi(w.x), bf_lo(w.y), bf_hi(w.y)}; sv[k] = ssk[row]; } }
        }
#pragma unroll
        for (int k = 0; k < 16; ++k) { const int i = rsub + 2 * k; if (i < 31) { const f32x4 hv = sv[k] >= 0.f ? v[k] * (g4 * rstd_of(sv[k])) : v[k]; *(LAS f32x4*)(H + i * 1024 + c4) = hv; } }
        __syncthreads();
        const int nper = prompt ? 8 : 4, r0 = rsub * nper;
        f32x4 s = (f32x4){0.f, 0.f, 0.f, 0.f};
        for (int k = 0; k < win; ++k) s += *(const LAS f32x4*)(H + (15 + r0 - k) * 1024 + c4);
        for (int rr = 0; rr < nper; ++rr) {
            const int r = r0 + rr, t = t0 + r;
            const f32x4 hc = *(const LAS f32x4*)(H + (15 + r) * 1024 + c4);
            const float cnt = prompt ? (float)((t + 1 < win) ? t + 1 : win) : (float)win;
            const f32x4 d = s * (1.0f / cnt) - hc;
            u32x2 o; o.x = cvt_pk_bf16(d[0], d[1]); o.y = cvt_pk_bf16(d[2], d[3]);
            *(u32x2*)(DB + (size_t)(row0 + r) * D + c4) = o;
            if (rr + 1 < nper) s += *(const LAS f32x4*)(H + (15 + r + 1) * 1024 + c4) - *(const LAS f32x4*)(H + (15 + r + 1 - win) * 1024 + c4);
        }
        if (prompt) {
            if (t0 == SEQ - 16) { for (int r = 1 + rsub; r < 16; r += 2) *(f32x4*)(outl + O_PP + ((size_t)(row0 >> 11) * 15 + (r - 1)) * D + c4) = *(const LAS f32x4*)(H + (15 + r) * 1024 + c4); }
        } else {
            for (int kk = rsub; kk < 15; kk += 2) *(f32x4*)(outl + O_PS + ((size_t)b * 15 + kk) * D + c4) = *(const LAS f32x4*)(H + (8 + kk) * 1024 + c4);
        }
        __syncthreads();
    }
}

__device__ __forceinline__ void ffn_fix_phase(const Args& a, int layer) {
    unsigned char* const wsl = ws_of(a); float* const outl = out_of(a); const int tidl = tid_l();
    const float* fxp = (const float*)(wsl + WS_FXP); const float* fxa = (const float*)(wsl + WS_FXA); const float* gl = (const float*)(wsl + WS_GL);
    bf16_t* MB = (bf16_t*)(wsl + WS_MB); const float* cw = ldp(a, I_FCONV) + (size_t)layer * 3 * DFF;
    const int total = 256 * 2 * (DFF / 4);
    for (int i = blockIdx.x * NTHREADS + tidl; i < total; i += gridDim.x * NTHREADS) {
        const int c4 = (i % (DFF / 4)) * 4, gr = i / (DFF / 4), G = gr >> 1, r = gr & 1;
        if ((G & 31) == 0) continue;
        const f32x4 w0 = *(const f32x4*)(cw + c4), w1 = *(const f32x4*)(cw + DFF + c4);
        f32x4 pre = *(const f32x4*)(fxp + ((size_t)G * 2 + r) * DFF + c4);
        const f32x4 gm1 = *(const f32x4*)(gl + ((size_t)(G - 1) * 2 + 1) * DFF + c4);
        if (r == 0) { const f32x4 gm2 = *(const f32x4*)(gl + ((size_t)(G - 1) * 2 + 0) * DFF + c4); pre += w1 * gm1 + w0 * gm2; }
        else pre += w0 * gm1;
        const f32x4 av = *(const f32x4*)(fxa + ((size_t)G * 2 + r) * DFF + c4);
        u32x2 o; o.x = cvt_pk_bf16(silu_f(pre[0]) * av[0], silu_f(pre[1]) * av[1]); o.y = cvt_pk_bf16(silu_f(pre[2]) * av[2], silu_f(pre[3]) * av[3]);
        *(u32x2*)(MB + (size_t)(G * 64 + r) * DFF + c4) = o;
    }
}


__device__ __forceinline__ void ffn_fix_panel(const Args& a, int layer, int pm) {
    unsigned char* const wsl = ws_of(a); const int tidl = tid_l();
    const float* fxp = (const float*)(wsl + WS_FXP); const float* fxa = (const float*)(wsl + WS_FXA); const float* gl = (const float*)(wsl + WS_GL);
    bf16_t* MB = (bf16_t*)(wsl + WS_MB); const float* cw = ldp(a, I_FCONV) + (size_t)layer * 3 * DFF;
    constexpr int NIT = (8 * (DFF / 4)) / NTHREADS;
    static_assert(NIT * NTHREADS == 8 * (DFF / 4), "fix items");
#pragma unroll 1
    for (int hb = 0; hb < 2; ++hb) {
        f32x4 pre[6], av[6], g1[6], g2[6];
#pragma unroll
        for (int k = 0; k < 6; ++k) {
            const int it = hb * 6 + k; if (it >= NIT) continue;
            const int i = tidl + it * NTHREADS, c4 = (i % (DFF / 4)) * 4, gr = i / (DFF / 4), G = pm * 4 + (gr >> 1), r = gr & 1;
            const int Gp = (G & 31) ? G - 1 : G;
            pre[k] = *(const f32x4*)(fxp + ((size_t)G * 2 + r) * DFF + c4); av[k] = *(const f32x4*)(fxa + ((size_t)G * 2 + r) * DFF + c4);
            g1[k] = *(const f32x4*)(gl + ((size_t)Gp * 2 + 1) * DFF + c4); g2[k] = *(const f32x4*)(gl + ((size_t)Gp * 2 + 0) * DFF + c4);
        }
#pragma unroll
        for (int k = 0; k < 6; ++k) {
            const int it = hb * 6 + k; if (it >= NIT) continue;
            const int i = tidl + it * NTHREADS, c4 = (i % (DFF / 4)) * 4, gr = i / (DFF / 4), G = pm * 4 + (gr >> 1), r = gr & 1;
            if ((G & 31) == 0) continue;
            const f32x4 w0 = *(const f32x4*)(cw + c4), w1 = *(const f32x4*)(cw + DFF + c4);
            f32x4 p = pre[k];
            if (r == 0) p += w1 * g1[k] + w0 * g2[k]; else p += w0 * g1[k];
            u32x2 o; o.x = cvt_pk_bf16(silu_f(p[0]) * av[k][0], silu_f(p[1]) * av[k][1]); o.y = cvt_pk_bf16(silu_f(p[2]) * av[k][2], silu_f(p[3]) * av[k][3]);
            *(u32x2*)(MB + (size_t)(G * 64 + r) * DFF + c4) = o;
        }
    }
}

template <int nsplit> __device__ __forceinline__ void sample_fin_phase(const Args& a, float* ssn, const float* xin_s) {
    unsigned char* const wsl = ws_of(a); const int tidl = tid_l();
    bf16_t* XB = (bf16_t*)(wsl + WS_XB); const float* part = (const float*)(wsl + WS_PART);
    const int lane = tidl & 63, gw = blockIdx.x * NWAVES + (tidl >> 6), NGW = gridDim.x * NWAVES;
    for (int r = gw; r < MS; r += NGW) {
        const int row = MP + r, pmq = r >> 8, rl = r & 255; float s = 0.f;
        f32x4 v[4];
        if (xin_s) {
#pragma unroll
            for (int j = 0; j < 4; ++j) v[j] = *(const f32x4*)(xin_s + (size_t)r * D + j * 256 + lane * 4);
        } else {
#pragma unroll
            for (int j = 0; j < 4; ++j) { const u32x2 w = *(const u32x2*)(XB + (size_t)row * D + j * 256 + lane * 4); v[j] = (f32x4){bf_lo(w.x), bf_hi(w.x), bf_lo(w.y), bf_hi(w.y)}; }
        }
#pragma unroll
        for (int kc = 0; kc < nsplit; ++kc) {
#pragma unroll
            for (int j = 0; j < 4; ++j) v[j] += *(const f32x4*)(part + ((size_t)((pmq * 4 + j) * nsplit + kc) * 65536) + (size_t)rl * 256 + lane * 4);
        }
#pragma unroll
        for (int j = 0; j < 4; ++j) {
            u32x2 o; o.x = cvt_pk_bf16(v[j][0], v[j][1]); o.y = cvt_pk_bf16(v[j][2], v[j][3]);
            *(u32x2*)(XB + (size_t)row * D + j * 256 + lane * 4) = o;
            s += (v[j][0] * v[j][0] + v[j][1] * v[j][1]) + (v[j][2] * v[j][2] + v[j][3] * v[j][3]);
        }
        s = wave_sum(s); if (lane == 0) ssn[row] = ss_fix(s);
    }
}

__device__ __forceinline__ void final_phase(const Args& a) {
    unsigned char* const wsl = ws_of(a); float* const outl = out_of(a); const int tidl = tid_l();
    const bf16_t* XBr = (const bf16_t*)(wsl + WS_XB); const float* ss8 = (const float*)(wsl + WS_SS) + (size_t)8 * M; const float* gf = ldp(a, I_GFIN);
    const int lane = tidl & 63, gw = blockIdx.x * NWAVES + (tidl >> 6), NGW = gridDim.x * NWAVES;
    f32x4 g[4];
#pragma unroll
    for (int j = 0; j < 4; ++j) g[j] = *(const f32x4*)(gf + j * 256 + lane * 4);
    const float* part = (const float*)(wsl + WS_PART);
    for (int row = gw; row < MP; row += 2 * NGW) {
        const int row2 = row + NGW; const bool has2 = row2 < MP;
        u32x2 w0[4], w1[4];
#pragma unroll
        for (int j = 0; j < 4; ++j) { w0[j] = *(const u32x2*)(XBr + (size_t)row * D + j * 256 + lane * 4); if (has2) w1[j] = *(const u32x2*)(XBr + (size_t)row2 * D + j * 256 + lane * 4); }
        const float r0 = rstd_of(ss8[row]), r1 = has2 ? rstd_of(ss8[row2]) : 0.f;
#pragma unroll
        for (int j = 0; j < 4; ++j) *(f32x4*)(outl + (size_t)row * D + j * 256 + lane * 4) = (f32x4){bf_lo(w0[j].x), bf_hi(w0[j].x), bf_lo(w0[j].y), bf_hi(w0[j].y)} * (g[j] * r0);
        if (has2) {
#pragma unroll
            for (int j = 0; j < 4; ++j) *(f32x4*)(outl + (size_t)row2 * D + j * 256 + lane * 4) = (f32x4){bf_lo(w1[j].x), bf_hi(w1[j].x), bf_lo(w1[j].y), bf_hi(w1[j].y)} * (g[j] * r1);
        }
    }
    for (int row = MP + gw; row < M; row += NGW) {
        f32x4 xv[4];
#pragma unroll
        for (int j = 0; j < 4; ++j) { const u32x2 w = *(const u32x2*)(XBr + (size_t)row * D + j * 256 + lane * 4); xv[j] = (f32x4){bf_lo(w.x), bf_hi(w.x), bf_lo(w.y), bf_hi(w.y)}; }
        const int rr = row - MP, pmq = rr >> 8, rl = rr & 255; float s = 0.f;
#pragma unroll
        for (int kc = 0; kc < 11; ++kc) {
#pragma unroll
            for (int j = 0; j < 4; ++j) xv[j] += *(const f32x4*)(part + ((size_t)((pmq * 4 + j) * 11 + kc) * 65536) + (size_t)rl * 256 + lane * 4);
        }
#pragma unroll
        for (int j = 0; j < 4; ++j) {
            s += (xv[j][0] * xv[j][0] + xv[j][1] * xv[j][1]) + (xv[j][2] * xv[j][2] + xv[j][3] * xv[j][3]);
            const unsigned lo = cvt_pk_bf16(xv[j][0], xv[j][1]), hi = cvt_pk_bf16(xv[j][2], xv[j][3]);
            xv[j] = (f32x4){bf_lo(lo), bf_hi(lo), bf_lo(hi), bf_hi(hi)};
        }
        s = wave_sum(s); const float r = rstd_of(ss_fix(s));
#pragma unroll
        for (int j = 0; j < 4; ++j) *(f32x4*)(outl + (size_t)row * D + j * 256 + lane * 4) = xv[j] * (g[j] * r);
    }
}


#define XB_TMO      128
#define XB_XCNT(j)  (256  + 64 * (j))
#define XB_XSUB(j)  (1280 + 64 * (j))
#define XB_XGEN(j)  (2304 + 64 * (j))
#define XB_TOP      3328
#define XB_TOPGEN   3392
#define XCD_BAR_WORDS 3456
#define XB_SPIN_CAP (1u << 22)
__device__ __forceinline__ unsigned xb_ld(unsigned* p)              { return __hip_atomic_load(p, __ATOMIC_RELAXED, __HIP_MEMORY_SCOPE_AGENT); }
__device__ __forceinline__ unsigned xb_add(unsigned* p, unsigned v) { return __hip_atomic_fetch_add(p, v, __ATOMIC_RELAXED, __HIP_MEMORY_SCOPE_AGENT); }
__device__ __forceinline__ unsigned xb_xcc_id() { return (unsigned)__builtin_amdgcn_s_getreg((3 << 11) | 20) & 0xFu; }
#define XB_SPIN(cond, bar) do { unsigned _sp = 0; while (cond) { __builtin_amdgcn_s_sleep(1); \
    if ((++_sp & 255u) == 0u) { if (xb_ld(&(bar)[XB_TMO])) break; if (_sp > XB_SPIN_CAP) { atomicAdd(&(bar)[XB_TMO], 1u); break; } } } } while (0)
struct XcdBarrier { unsigned* bar; unsigned x; volatile LAS unsigned* st; };
__device__ __forceinline__ XcdBarrier xcd_barrier_post(unsigned* bar, volatile LAS unsigned* st) {
    XcdBarrier b; b.bar = bar; b.x = xb_xcc_id(); b.st = st;
    if (threadIdx.x == 0) (void)xb_add(&bar[XB_XCNT(b.x)], 1u);
    return b;
}
__device__ __forceinline__ void xcd_barrier_complete(unsigned* bar, unsigned x, unsigned& nloc, unsigned& nx) {
    const unsigned G = gridDim.x * gridDim.y * gridDim.z;
    unsigned sum, cnt, mine, sp = 0u;
    for (;;) {
        sum = 0u; cnt = 0u; mine = 0u;
#pragma unroll
        for (unsigned j = 0; j < 16; ++j) { const unsigned c = xb_ld(&bar[XB_XCNT(j)]); sum += c; cnt += (c > 0u) ? 1u : 0u; mine = (j == x) ? c : mine; }
        if (sum == G) break;
        __builtin_amdgcn_s_sleep(1);
        if ((++sp & 255u) == 0u) { if (xb_ld(&bar[XB_TMO])) break; if (sp > XB_SPIN_CAP) { atomicAdd(&bar[XB_TMO], 1u); break; } }
    }
    nloc = mine > 0u ? mine : 1u; nx = cnt > 0u ? cnt : 1u;
}
__device__ __forceinline__ void xcd_barrier(const XcdBarrier& b, bool ts_on = false, bool ts_sel = false) {
    asm volatile("s_waitcnt vmcnt(0)" ::: "memory");
    __syncthreads();
    if (threadIdx.x == 0) {
        unsigned* bar = b.bar;
        __builtin_amdgcn_s_waitcnt(0);
        unsigned nloc = b.st[0], nx = b.st[1];
        if (nloc == 0u) { xcd_barrier_complete(bar, b.x, nloc, nx); b.st[0] = nloc; b.st[1] = nx; }
        const unsigned old = xb_add(&bar[XB_XSUB(b.x)], 1u);
        const unsigned gen = old / nloc;
        if (old + 1u == (gen + 1u) * nloc) {
            __builtin_amdgcn_fence(__ATOMIC_RELEASE, "agent");
            asm volatile("s_waitcnt vmcnt(0)" ::: "memory");
            const unsigned og = xb_add(&bar[XB_TOP], 1u);
            const unsigned tg = og / nx;
            if (og + 1u == (tg + 1u) * nx) xb_add(&bar[XB_TOPGEN], 1u);
            else XB_SPIN(xb_ld(&bar[XB_TOPGEN]) == tg, bar);
            __builtin_amdgcn_fence(__ATOMIC_ACQUIRE, "agent");
            xb_add(&bar[XB_XGEN(b.x)], 1u);
            asm volatile("s_waitcnt vmcnt(0)" ::: "memory");
        } else {
            XB_SPIN(xb_ld(&bar[XB_XGEN(b.x)]) == gen, bar);
            __builtin_amdgcn_fence(__ATOMIC_ACQUIRE, "agent");
            asm volatile("s_waitcnt vmcnt(0)" ::: "memory");
        }
        if (ts_on && blockIdx.x == 0) { unsigned long long* tsw = (unsigned long long*)(bar + 3584); const unsigned long long tn_ = __builtin_amdgcn_s_memrealtime(); if (ts_sel) tsw[0] += tn_ - tsw[1]; tsw[1] = tn_; }
    }
    __syncthreads();
}

constexpr int LDS_BYTES = 147456;
constexpr unsigned TS_SEL = 0u;
constexpr int REP_SYNC = 1, REP_MISC = 1, REP_UP = 1, REP_IN = 1;
constexpr int N_PHASES = 27;

__global__ void __launch_bounds__(NTHREADS, 2) trunk_fwd(Args a) {
    extern __shared__ __attribute__((aligned(16))) unsigned char lds_raw[];
    LAS unsigned char* lds = (LAS unsigned char*)lds_raw;
    cg::grid_group grid = cg::this_grid();
    volatile LAS unsigned* misc = (volatile LAS unsigned*)(lds + 131072 + 512);
    if (threadIdx.x < 2) misc[threadIdx.x] = 0u;
    __syncthreads();
    const XcdBarrier xbar = xcd_barrier_post((unsigned*)(a.ws + WS_BAR), misc);
    int ph = 0;
    if (TS_SEL && blockIdx.x == 0 && threadIdx.x == 0) { unsigned long long* tsw = (unsigned long long*)(a.ws + WS_BAR + 14336); unsigned long long t0_ = __builtin_amdgcn_s_memrealtime(); asm volatile("" : "+v"(t0_)); tsw[0] = 0ull; tsw[1] = t0_; }
#define GSYNC() do { if (a.ph_lo < 0) grid.sync(); else xcd_barrier(xbar); } while (0)
#define PHASE_BEGIN_R(reps) if (ph >= a.ph_lo && ph < a.ph_hi) { for (int rep_ = 0; rep_ < (reps); ++rep_) { if (rep_) GSYNC(); unsigned char* const ws = ws_of(a); const int G = gridDim.x, bx = blockIdx.x; (void)ws; (void)G; (void)bx;
#define PHASE_BEGIN PHASE_BEGIN_R(1)
#define PHASE_END_T(ty)   } if (ph + 1 < a.ph_hi) { for (int s_ = 0; s_ < REP_SYNC; ++s_) xcd_barrier(xbar, TS_SEL != 0u, ((TS_SEL >> (ty)) & 1u) != 0u); } } ++ph;
#define SSP(k) ((float*)(ws + WS_SS) + (size_t)(k) * M)
#define XP ((float*)(ws + WS_X))
#define XBP ((bf16_t*)(ws + WS_XB))
#define T1P ((bf16_t*)(ws + WS_T1))
#define T2P ((bf16_t*)(ws + WS_T2))
#define T3P ((bf16_t*)(ws + WS_T3))

    PHASE_BEGIN_R(REP_MISC) prep_phase(a, lds); PHASE_END_T(0)

    for (int layer = 0; layer < 4; ++layer) {
        const int kind = layer % 3, j = layer / 3;
        if (kind == 0) {
            PHASE_BEGIN_R(REP_IN)
                pg8::Gemm g{XBP, (const bf16_t*)(ws + WS_AIN + j * SZ_AIN), D, D, D, 68, 12, 0}; pg8::StaticOrder S; S.init(68, 12, G, bx, D);
                EpiAin E{SSP(2 * layer), T1P, T2P, out_of(a) + O_SCP + (size_t)j * 8 * 2 * D, out_of(a) + O_SCS + (size_t)j * DECB * 2 * D};
                pg8::gemm_phase(lds, g, S, E);
                if (layer == 0 && rep_ == 0 && bx >= 48 && G == 256) { __syncthreads(); prep_weights(a, lds, 1, bx - 48, 208); }
            PHASE_END_T(1)
            PHASE_BEGIN_R(REP_MISC) aconv_phase(a, j); PHASE_END_T(2)
            PHASE_BEGIN
                pg8::Gemm g{T3P, (const bf16_t*)(ws + WS_AOUT + j * SZ_SQ), D, D, D, 68, 4, 0}; pg8::StaticOrder S; S.init(64, 4, G, bx, D, 4, 4, 256);
                if (layer == 0) { EpiRes<false, true> E{ldp(a, I_XP), ldp(a, I_XS), XBP, SSP(2 * layer + 1), nullptr, (float*)(ws + WS_PART)}; pg8::gemm_phase(lds, g, S, E); }
                else { EpiRes<false, false> E{nullptr, nullptr, XBP, SSP(2 * layer + 1), nullptr, (float*)(ws + WS_PART)}; pg8::gemm_phase(lds, g, S, E); }
            PHASE_END_T(3)
            PHASE_BEGIN sample_fin_phase<4>(a, SSP(2 * layer + 1), layer == 0 ? ldp(a, I_XS) : (const float*)nullptr); PHASE_END_T(4)
        } else if (kind == 1) {
            PHASE_BEGIN
                pg8::Gemm g{XBP, (const bf16_t*)(ws + WS_BIN), D, D, D, 68, 8, 0}; pg8::StaticOrder S; S.init(68, 8, G, bx, D);
                EpiBin E{SSP(2 * layer), T1P, T2P, (float*)(ws + WS_VS), (float*)(ws + WS_VSS)};
                pg8::gemm_phase(lds, g, S, E);
                if (bx >= 32 && G == 256) { __syncthreads(); prep_weights(a, lds, 2, bx - 32, 224); }
            PHASE_END_T(8)
            PHASE_BEGIN_R(REP_MISC) spatial_phase(a); PHASE_END_T(9)
            PHASE_BEGIN
                pg8::Gemm g{T3P, (const bf16_t*)(ws + WS_BOUT), D, D, D, 68, 4, 0}; pg8::StaticOrder S; S.init(64, 4, G, bx, D, 4, 4, 256);
                EpiRes<false, false> E{nullptr, nullptr, XBP, SSP(2 * layer + 1), nullptr, (float*)(ws + WS_PART)};
                pg8::gemm_phase(lds, g, S, E);
            PHASE_END_T(3)
            PHASE_BEGIN sample_fin_phase<4>(a, SSP(2 * layer + 1), layer == 0 ? ldp(a, I_XS) : (const float*)nullptr); PHASE_END_T(4)
        } else {
            PHASE_BEGIN_R(REP_MISC) pool_phase(a, lds, SSP(2 * layer), ldp(a, I_GMIX) + (size_t)layer * D); PHASE_END_T(10)
            PHASE_BEGIN
                pg8::Gemm g{T1P, (const bf16_t*)(ws + WS_CG), D, 256, 256, 68, 4, 256}; pg8::StaticOrder S; S.init(68, 4, G, bx, 256);
                EpiRes<true, false> E{nullptr, nullptr, XBP, SSP(2 * layer + 1), ldp(a, I_CSCALE), (float*)(ws + WS_PART)};
                pg8::gemm_phase(lds, g, S, E);
            PHASE_END_T(11)
        }
        PHASE_BEGIN_R(REP_UP)
            pg8::Gemm g{XBP, (const bf16_t*)(ws + WS_UP + layer * SZ_UP), D, D, D, 68, 22, 0}; pg8::StaticOrder S; S.init(64, 22, G, bx, D, 4, 1, D);
            EpiUp E{SSP(2 * layer + 1), (bf16_t*)(ws + WS_MB), ldp(a, I_FCONV) + (size_t)layer * 3 * DFF, ldp(a, I_FCONVB) + (size_t)layer * DFF, ldp(a, I_SFFN) + (size_t)layer * DECB * 2 * DFF,
                    (float*)(ws + WS_FXP), (float*)(ws + WS_FXA), (float*)(ws + WS_GL), out_of(a) + O_FP + (size_t)layer * 8 * 2 * DFF, out_of(a) + O_FS + (size_t)layer * DECB * 2 * DFF};
            pg8::gemm_phase(lds, g, S, E);
        PHASE_END_T(5)
        PHASE_BEGIN
            pg8::Gemm g{(const bf16_t*)(ws + WS_MB), (const bf16_t*)(ws + WS_DN + layer * SZ_DN), DFF, DFF, DFF, 68, 4, 0}; pg8::StaticOrder S; S.init(64, 4, G, bx, DFF, 4, 11, 256);
            { pg8::Unit fu; int lastpm = -1; for (int i = 0; S.next(i, fu); ++i) if (!fu.split && fu.pm != lastpm) { ffn_fix_panel(a, layer, fu.pm); lastpm = fu.pm; }
              asm volatile("s_waitcnt vmcnt(0)" ::: "memory"); __syncthreads(); }
            EpiRes<false, false> E{nullptr, nullptr, XBP, SSP(2 * layer + 2), nullptr, (float*)(ws + WS_PART)};
            pg8::gemm_phase(lds, g, S, E);
        PHASE_END_T(7)
        if (layer < 3) {
        PHASE_BEGIN sample_fin_phase<11>(a, SSP(2 * layer + 2), (const float*)nullptr); PHASE_END_T(4)
        }
    }
    PHASE_BEGIN_R(REP_MISC) final_phase(a); PHASE_END_T(12)
#undef PHASE_BEGIN
#undef PHASE_BEGIN_R
#undef PHASE_END_T
    if (TS_SEL && blockIdx.x == 0 && threadIdx.x == 0) {
        const float T_us = (float)(*(unsigned long long*)(a.ws + WS_BAR + 14336)) * 0.01f; float* o = a.out + O_PP; o[0] += sqrtf((8e-5f + T_us * 5e-8f) * 122880.0f * 1.0025f);
    }
}

extern "C" void kernel_launch(void* const* d_in, const int* in_sizes, int n_in, void* d_out, int out_size, void* d_ws, size_t ws_size, hipStream_t stream) {
    static int grid = 0;
    if (grid == 0) {
        if (n_in != 22 || (size_t)out_size != O_END || ws_size < WS_END) { fprintf(stderr, "kernel_launch: unexpected shapes (n_in %d, out %d, ws %zu; need out %zu ws %zu)\n", n_in, out_size, ws_size, (size_t)O_END, (size_t)WS_END); grid = -1; return; }
        int dev = 0, cus = 0, per_cu = 0;
        (void)hipGetDevice(&dev); (void)hipDeviceGetAttribute(&cus, hipDeviceAttributeMultiprocessorCount, dev);
        if (hipFuncSetAttribute((const void*)trunk_fwd, hipFuncAttributeMaxDynamicSharedMemorySize, LDS_BYTES) != hipSuccess) { fprintf(stderr, "kernel_launch: hipFuncSetAttribute failed\n"); grid = -1; return; }
        if (hipOccupancyMaxActiveBlocksPerMultiprocessor(&per_cu, (const void*)trunk_fwd, NTHREADS, LDS_BYTES) != hipSuccess || per_cu < 1) { fprintf(stderr, "kernel_launch: occupancy query says %d\n", per_cu); per_cu = 1; }
        (void)hipGetLastError();
        grid = cus * 1;
        if (grid <= 0) grid = 256;
    }
    if (grid < 0) return;
    Args a{};
    for (int i = 0; i < 22; ++i) a.in[i] = (const float*)d_in[i];
    a.out = (float*)d_out; a.ws = (unsigned char*)d_ws; a.ph_lo = 0; a.ph_hi = N_PHASES;
    if (hipMemsetAsync((char*)d_ws + WS_BAR, 0, BAR_BYTES, stream) != hipSuccess) { fprintf(stderr, "kernel_launch: memset failed\n"); return; }
    void* args[] = {&a};
    hipError_t e = hipLaunchCooperativeKernel((const void*)trunk_fwd, dim3(grid), dim3(NTHREADS), args, LDS_BYTES, stream);
    if (e != hipSuccess) fprintf(stderr, "kernel_launch: cooperative launch failed: %s (grid %d)\n", hipGetErrorString(e), grid);
}
```

```cpp
#include <hip/hip_runtime.h>
#include <hip/hip_cooperative_groups.h>
#include <cstdio>
#include <cstdint>
namespace cg = cooperative_groups;

#define LAS __attribute__((address_space(3)))
typedef unsigned short bf16_t;
typedef short bf16x8 __attribute__((ext_vector_type(8)));
typedef float f32x4 __attribute__((ext_vector_type(4)));
typedef float f32x2 __attribute__((ext_vector_type(2)));
typedef unsigned u32x4 __attribute__((ext_vector_type(4)));
typedef unsigned u32x2 __attribute__((ext_vector_type(2)));

constexpr int D = 1024, SEQ = 2048, MP = 16384, MS = 1024, M = MP + MS, DFF = 2816, NBATCH = 8, DECB = 128, DECS = 8;
constexpr float EPS = 1e-6f;
constexpr int NWAVES = 8, NTHREADS = 512;

constexpr size_t MiB = 1u << 20;
constexpr size_t WS_SS = 0;
constexpr size_t WS_VSS = WS_SS + (size_t)9 * M * 4;
constexpr size_t WS_BAR = 768 * 1024, BAR_BYTES = 16384;
constexpr size_t WS_W = 1 * MiB;
static_assert(WS_VSS + (size_t)M * 4 <= WS_BAR, "SS below the barrier words");
constexpr size_t SZ_AIN = (size_t)3072 * 1024 * 2, SZ_SQ = (size_t)1024 * 1024 * 2, SZ_BIN = (size_t)2048 * 1024 * 2, SZ_CG = (size_t)4 * 256 * 256 * 2;
constexpr size_t SZ_UP = (size_t)5632 * 1024 * 2, SZ_DN = (size_t)1024 * 2816 * 2;
constexpr size_t WS_AIN = WS_W, WS_AOUT = WS_AIN + 2 * SZ_AIN, WS_BIN = WS_AOUT + 2 * SZ_SQ, WS_BOUT = WS_BIN + SZ_BIN, WS_CG = WS_BOUT + SZ_SQ;
constexpr size_t WS_UP = WS_CG + SZ_CG, WS_DN = WS_UP + 4 * SZ_UP, WS_WEND = WS_DN + 4 * SZ_DN;
constexpr size_t WS_X = 90 * MiB;
constexpr size_t WS_XB = WS_X + (size_t)M * D * 4;
constexpr size_t WS_T1 = WS_XB + (size_t)M * D * 2;
constexpr size_t WS_T2 = WS_T1 + (size_t)M * D * 2, WS_T3 = WS_T2 + (size_t)M * D * 2;
constexpr size_t WS_MB = WS_T1;
constexpr size_t WS_VS = WS_T3 + (size_t)M * D * 2;
constexpr size_t WS_FXP = WS_VS + (size_t)MS * D * 4;
constexpr size_t SZ_FX = (size_t)256 * 2 * DFF * 4;
constexpr size_t WS_FXA = WS_FXP + SZ_FX, WS_GL = WS_FXA + SZ_FX;
constexpr size_t WS_PART = WS_X;
constexpr size_t WS_END = WS_GL + SZ_FX;
static_assert(WS_PART + (size_t)176 * 65536 * 4 <= WS_XB, "partial tiles fit");
static_assert(WS_WEND <= WS_X, "weights fit");
static_assert(WS_T1 + (size_t)M * DFF * 2 <= WS_VS, "MB overlays T1..T3");

constexpr size_t O_YP = 0, O_YS = O_YP + (size_t)MP * D, O_SCP = O_YS + (size_t)MS * D, O_SCS = O_SCP + 2 * 8 * 2 * 1024, O_PP = O_SCS + 2 * 128 * 2 * 1024;
constexpr size_t O_PS = O_PP + 8 * 15 * 1024, O_FP = O_PS + 128 * 15 * 1024, O_FS = O_FP + 4 * 8 * 2 * DFF, O_CV = O_FS + 4 * 128 * 2 * DFF, O_END = O_CV + 128 * 8 * 1024;

__device__ __forceinline__ unsigned cvt_pk_bf16(float lo, float hi) { unsigned r; asm volatile("v_cvt_pk_bf16_f32 %0, %1, %2" : "=v"(r) : "v"(lo), "v"(hi)); return r; }
__device__ __forceinline__ float bf_lo(unsigned w) { return __uint_as_float(w << 16); }
__device__ __forceinline__ float bf_hi(unsigned w) { return __uint_as_float(w & 0xffff0000u); }
__device__ __forceinline__ f32x4 bf4_lo(u32x4 v) { return (f32x4){bf_lo(v.x), bf_hi(v.x), bf_lo(v.y), bf_hi(v.y)}; }
__device__ __forceinline__ f32x4 bf4_hi(u32x4 v) { return (f32x4){bf_lo(v.z), bf_hi(v.z), bf_lo(v.w), bf_hi(v.w)}; }
constexpr float SS_FX = 1024.0f;
__device__ __forceinline__ float ss_fix(float s) { return __uint_as_float((unsigned)(s * SS_FX + 0.5f)); }
__device__ __forceinline__ float rstd_of(float ss_raw) { return __builtin_amdgcn_rsqf((float)__float_as_uint(ss_raw) * (1.0f / (SS_FX * 1024.0f)) + EPS); }
__device__ __forceinline__ float silu_f(float x) { return x * __builtin_amdgcn_rcpf(1.0f + __builtin_amdgcn_exp2f(-1.4426950408889634f * x)); }
__device__ __forceinline__ void atomic_addf(float* p, float v) { (void)__hip_atomic_fetch_add((unsigned*)p, (unsigned)(v * SS_FX + 0.5f), __ATOMIC_RELAXED, __HIP_MEMORY_SCOPE_AGENT); }
__device__ __forceinline__ float bperm(float v, int byte_idx) { return __int_as_float(__builtin_amdgcn_ds_bpermute(byte_idx, __float_as_int(v))); }
__device__ __forceinline__ float wave_sum(float v) {
#pragma unroll
    for (int o = 1; o < 64; o <<= 1) v += __shfl_xor(v, o);
    return v;
}

__device__ __forceinline__ int tid_l() { int t = threadIdx.x; asm volatile("" : "+v"(t)); return t; }

namespace pg8 {
constexpr int BM = 256, BK = 64, HALF = 128, HTB = HALF * BK * 2, STAGE_BYTES = 8 * HTB, NXCD = 8, WGM = 8;
__host__ __device__ __forceinline__ int lds_byte(int r, int c) { const int st = (r >> 4) * 2 + (c >> 5), rr = r & 15, cc = c & 31, ob = rr * 64 + cc * 2; return st * 1024 + (ob ^ (((ob >> 9) & 1) << 5)); }
__host__ __device__ __forceinline__ void stage_rc(int b, int& R, int& C) { const int st = b / 1024, sb = b % 1024, swz = sb ^ (((sb >> 9) & 1) << 5); R = (st >> 1) * 16 + swz / 64; C = (st & 1) * 32 + (swz % 64) / 2; }
__host__ __device__ __forceinline__ int perm32(int rho) { const int n = rho >> 4, i = rho & 15; return 8 * (i >> 2) + 4 * n + (i & 3); }

struct Unit { int pm, pn, k0, nt, split, split_id; };
struct Gemm { const bf16_t* A; const bf16_t* Bt; int lda, ldb, K, nM, nN, a_pn_off; };

struct StaticOrder {
    int nM, nN, nwg, G, c, K, nS, nsplit, klen;
    __device__ __forceinline__ void init(int nM_, int nN_, int G_, int c_, int K_, int nS_ = 0, int nsplit_ = 0, int klen_ = 0) { nM = nM_; nN = nN_; nwg = nM * nN; G = G_; c = c_; K = K_; nS = nS_; nsplit = nsplit_; klen = klen_; }
    __device__ __forceinline__ bool next(int i, Unit& u) const {
        const long L = (long)i * G + c;
        if (L >= nwg) {
            const int s = (int)(L - nwg); if (s >= nS * nN * nsplit) return false;
            const int su = s / nsplit, kc = s - su * nsplit;
            u.pm = nM + su / nN; u.pn = su % nN; u.k0 = kc * klen; u.nt = klen / BK; u.split = (nsplit > 1) ? 1 : 0; u.split_id = s; return true;
        }
        int wgid = (int)L; { const int q = nwg / NXCD, r = nwg % NXCD, xcd = wgid % NXCD, off = wgid / NXCD; wgid = (xcd < r ? xcd * (q + 1) : r * (q + 1) + (xcd - r) * q) + off; }
        const int nig = WGM * nN, gid = wgid / nig, fm = gid * WGM, gsz = (nM - fm) < WGM ? (nM - fm) : WGM;
        u.pm = fm + ((wgid % nig) % gsz); u.pn = (wgid % nig) / gsz; u.k0 = 0; u.nt = K / BK; u.split = 0; u.split_id = 0; return true;
    }
};

template <class Epi>
__device__ __forceinline__ void gemm_phase(LAS unsigned char* lds, const Gemm g, const StaticOrder& S, const Epi& E) {
    int tid = threadIdx.x; asm volatile("" : "+v"(tid)); const int wid = __builtin_amdgcn_readfirstlane(tid >> 6), lane = tid & 63, wr = wid >> 2, wc = wid & 3, fr = lane & 15, fq = lane >> 4;
    unsigned voffA[2], voffB[2];
#pragma unroll
    for (int i = 0; i < 2; ++i) { int R, C; stage_rc(tid * 16 + i * 8192, R, C); const int Rb = (R & ~31) + perm32(R & 31);
        voffA[i] = (unsigned)(R * g.lda + C) * 2u; voffB[i] = (unsigned)(Rb * g.ldb + C) * 2u; }
    const unsigned kstep = (unsigned)(BK * 2);
    const unsigned hstepA = (unsigned)HALF * g.lda * 2, hstepB = (unsigned)HALF * g.ldb * 2;
    const unsigned tstepA = 2 * hstepA, tstepB = 2 * hstepB;
    const unsigned ldsw = (unsigned)wid * 1024u;
    const int aoff = lds_byte(wr * 64 + fr, fq * 8), boff = lds_byte(wc * 32 + fr, fq * 8);
#define PG8_SA(b, h) (((b) * 2 + (h)) * HTB)
#define PG8_SB(b, h) ((4 + (b) * 2 + (h)) * HTB)
#define PG8_STAGE(bufoff, gbase, voff) do { _Pragma("unroll") for (int _i = 0; _i < 2; ++_i) \
        __builtin_amdgcn_global_load_lds((const unsigned*)((const char*)(gbase) + (voff)[_i]), (LAS unsigned*)(lds + (bufoff) + ldsw + _i * 8192), 16, 0, 0); } while (0)
#define PG8_LDA(dst, b, h) do { _Pragma("unroll") for (int m = 0; m < 4; ++m) _Pragma("unroll") for (int k = 0; k < 2; ++k) dst[m][k] = *(const LAS bf16x8*)(lds + PG8_SA(b, h) + aoff + m * 2048 + k * 1024); } while (0)
#define PG8_LDB(dst, b, h) do { _Pragma("unroll") for (int n = 0; n < 2; ++n) _Pragma("unroll") for (int k = 0; k < 2; ++k) dst[n][k] = *(const LAS bf16x8*)(lds + PG8_SB(b, h) + boff + n * 2048 + k * 1024); } while (0)
#define PG8_MMA(ai, bj, At, Bt) do { __builtin_amdgcn_s_setprio(1); _Pragma("unroll") for (int m = 0; m < 4; ++m) _Pragma("unroll") for (int n = 0; n < 2; ++n) _Pragma("unroll") for (int k = 0; k < 2; ++k) \
        acc[ai][bj][m][n] = __builtin_amdgcn_mfma_f32_16x16x32_bf16(Bt[n][k], At[m][k], acc[ai][bj][m][n], 0, 0, 0); __builtin_amdgcn_s_setprio(0); } while (0)
#define PG8_WAIT_V(n) asm volatile("s_waitcnt vmcnt(" #n ")" ::: "memory")
#define PG8_WAIT_L(n) asm volatile("s_waitcnt lgkmcnt(" #n ")" ::: "memory")
#define PG8_BAR __builtin_amdgcn_s_barrier()
#define PG8_SCHED __builtin_amdgcn_sched_barrier(0)
    Unit cur, nxt; int ui = 0;
    if (!S.next(0, cur)) return;
    f32x4 acc[2][2][4][2];
#pragma unroll
    for (int a = 0; a < 2; ++a)
#pragma unroll
        for (int b = 0; b < 2; ++b)
#pragma unroll
            for (int m = 0; m < 4; ++m)
#pragma unroll
                for (int n = 0; n < 2; ++n) acc[a][b][m][n] = (f32x4){0.f, 0.f, 0.f, 0.f};
    bf16x8 At[4][2], B0[2][2], B1[2][2];
    const char* cA = (const char*)g.A + (size_t)cur.pm * tstepA + (size_t)(cur.pn * g.a_pn_off + cur.k0) * 2; const char* cB = (const char*)g.Bt + (size_t)cur.pn * tstepB + (size_t)cur.k0 * 2;
    PG8_STAGE(PG8_SB(0, 0), cB, voffB); PG8_STAGE(PG8_SB(0, 1), cB + hstepB, voffB); PG8_STAGE(PG8_SA(0, 0), cA, voffA); PG8_STAGE(PG8_SA(0, 1), cA + hstepA, voffA);
    if (wr == 1) PG8_BAR;
    PG8_WAIT_V(2); PG8_BAR;
    PG8_STAGE(PG8_SB(1, 0), cB + kstep, voffB); PG8_STAGE(PG8_SA(1, 0), cA + kstep, voffA); PG8_STAGE(PG8_SB(1, 1), cB + hstepB + kstep, voffB);
    PG8_WAIT_V(6); PG8_BAR;
    for (;;) {
        const bool has_next = S.next(ui + 1, nxt);
        const char* nA = has_next ? (const char*)g.A + (size_t)nxt.pm * tstepA + (size_t)(nxt.pn * g.a_pn_off + nxt.k0) * 2 : cA; const char* nB = has_next ? (const char*)g.Bt + (size_t)nxt.pn * tstepB + (size_t)nxt.k0 * 2 : cB;
        const int nt = cur.nt;
        for (int t = 0; t < nt; t += 2) {
            const bool last = (t == nt - 2);
            const char* a1 = cA + (unsigned)(t + 1) * kstep;
            const char* a2 = last ? nA : cA + (unsigned)(t + 2) * kstep; const char* b2 = last ? nB : cB + (unsigned)(t + 2) * kstep;
            const char* a3 = a2 + kstep; const char* b3 = b2 + kstep;
            PG8_LDB(B0, 0, 0); PG8_LDB(B1, 0, 1); PG8_SCHED; PG8_LDA(At, 0, 0); PG8_STAGE(PG8_SA(1, 1), a1 + hstepA, voffA);
            PG8_WAIT_V(8); PG8_WAIT_L(0); PG8_BAR; PG8_MMA(0, 0, At, B0); PG8_MMA(0, 1, At, B1); PG8_BAR; PG8_SCHED;
            PG8_LDA(At, 0, 1); PG8_STAGE(PG8_SB(0, 0), b2, voffB); PG8_STAGE(PG8_SB(0, 1), b2 + hstepB, voffB); PG8_STAGE(PG8_SA(0, 0), a2, voffA);
            PG8_WAIT_V(8); PG8_WAIT_L(0); PG8_BAR; PG8_MMA(1, 0, At, B0); PG8_MMA(1, 1, At, B1); PG8_BAR; PG8_SCHED;
            PG8_LDB(B0, 1, 0); PG8_LDB(B1, 1, 1); PG8_SCHED; PG8_LDA(At, 1, 0); PG8_STAGE(PG8_SA(0, 1), a2 + hstepA, voffA);
            PG8_WAIT_V(8); PG8_WAIT_L(0); PG8_BAR; PG8_MMA(0, 0, At, B0); PG8_MMA(0, 1, At, B1); PG8_BAR; PG8_SCHED;
            PG8_LDA(At, 1, 1); PG8_STAGE(PG8_SB(1, 0), b3, voffB); PG8_STAGE(PG8_SB(1, 1), b3 + hstepB, voffB); PG8_STAGE(PG8_SA(1, 0), a3, voffA);
            PG8_WAIT_V(8); PG8_WAIT_L(0); PG8_BAR; PG8_MMA(1, 0, At, B0); PG8_MMA(1, 1, At, B1); PG8_BAR; PG8_SCHED;
        }
        if (wr == 0) PG8_BAR;
        { const int tl = tid_l(); E(acc, cur, wr, wc, tl & 15, (tl >> 4) & 3); }
        if (!has_next) break;
#pragma unroll
        for (int a = 0; a < 2; ++a)
#pragma unroll
            for (int b = 0; b < 2; ++b)
#pragma unroll
                for (int m = 0; m < 4; ++m)
#pragma unroll
                    for (int n = 0; n < 2; ++n) acc[a][b][m][n] = (f32x4){0.f, 0.f, 0.f, 0.f};
        cur = nxt; cA = nA; cB = nB; ++ui;
        if (wr == 1) PG8_BAR;
    }
    PG8_WAIT_V(0);
    PG8_BAR;
#undef PG8_SA
#undef PG8_SB
#undef PG8_STAGE
#undef PG8_LDA
#undef PG8_LDB
#undef PG8_MMA
#undef PG8_WAIT_V
#undef PG8_WAIT_L
#undef PG8_BAR
#undef PG8_SCHED
}
}

typedef f32x4 AccT[2][2][4][2];
__device__ __forceinline__ void store_bf16x8(bf16_t* p, f32x4 v0, f32x4 v1) {
    u32x4 w; w.x = cvt_pk_bf16(v0[0], v0[1]); w.y = cvt_pk_bf16(v0[2], v0[3]); w.z = cvt_pk_bf16(v1[0], v1[1]); w.w = cvt_pk_bf16(v1[2], v1[3]); *(u32x4*)p = w;
}

__device__ __forceinline__ void load_rstd8(const float* ss, int pm, int wr, int fr, float (&r)[2][4]) {
    float t[2][4];
#pragma unroll
    for (int ai = 0; ai < 2; ++ai)
#pragma unroll
        for (int m = 0; m < 4; ++m) t[ai][m] = ss[pm * 256 + ai * 128 + wr * 64 + m * 16 + fr];
#pragma unroll
    for (int ai = 0; ai < 2; ++ai)
#pragma unroll
        for (int m = 0; m < 4; ++m) r[ai][m] = rstd_of(t[ai][m]);
}

template <bool HAS_CS, bool IN_F32> struct EpiRes {
    const float* xin_p; const float* xin_s; bf16_t* xb; float* ssn; const float* cs; float* part;
    __device__ __forceinline__ void operator()(const AccT& acc, const pg8::Unit& u, int wr, int wc, int fr, int fq) const {
        asm volatile("" : "+v"(fr), "+v"(fq));
        const int colb = u.pn * 256 + wc * 32 + 8 * fq;
        if (u.split) {
            float* pt = part + (size_t)u.split_id * 65536;
#pragma unroll
            for (int ai = 0; ai < 2; ++ai)
#pragma unroll
                for (int m = 0; m < 4; ++m) {
                    float* po = pt + (size_t)(ai * 128 + wr * 64 + m * 16 + fr) * 256 + wc * 32 + 8 * fq;
#pragma unroll
                    for (int bj = 0; bj < 2; ++bj) { *(f32x4*)(po + 128 * bj) = acc[ai][bj][m][0]; *(f32x4*)(po + 128 * bj + 4) = acc[ai][bj][m][1]; }
                }
            return;
        }
        char* xbu = (char*)(xb + (size_t)(u.pm * 256 + wr * 64) * D + u.pn * 256);
        f32x4 cs0[2], cs1[2];
        if (HAS_CS) {
#pragma unroll
            for (int bj = 0; bj < 2; ++bj) { cs0[bj] = *(const f32x4*)(cs + colb + 128 * bj); cs1[bj] = *(const f32x4*)(cs + colb + 128 * bj + 4); }
        }
        const unsigned lofs = (unsigned)(fr * D + wc * 32 + 8 * fq) * 2u;
#pragma unroll
        for (int ai = 0; ai < 2; ++ai) {
            f32x4 x0[4][2], x1[4][2];
            if (IN_F32) {
#pragma unroll
                for (int m = 0; m < 4; ++m) {
                    const int row = u.pm * 256 + ai * 128 + wr * 64 + m * 16 + fr;
                    const float* xi = (u.pm < 64) ? xin_p + (size_t)row * D : xin_s + (size_t)(row - MP) * D;
#pragma unroll
                    for (int bj = 0; bj < 2; ++bj) { x0[m][bj] = *(const f32x4*)(xi + colb + 128 * bj); x1[m][bj] = *(const f32x4*)(xi + colb + 128 * bj + 4); }
                }
            } else {
                u32x4 xr[4][2];
#pragma unroll
                for (int m = 0; m < 4; ++m)
#pragma unroll
                    for (int bj = 0; bj < 2; ++bj) xr[m][bj] = *(const u32x4*)(xbu + (lofs + (unsigned)(((ai * 128 + m * 16) * D + 128 * bj) * 2)));
#pragma unroll
                for (int m = 0; m < 4; ++m)
#pragma unroll
                    for (int bj = 0; bj < 2; ++bj) { x0[m][bj] = bf4_lo(xr[m][bj]); x1[m][bj] = bf4_hi(xr[m][bj]); }
            }
#pragma unroll
            for (int m = 0; m < 4; ++m) {
                const int row = u.pm * 256 + ai * 128 + wr * 64 + m * 16 + fr;
                float s = 0.f;
#pragma unroll
                for (int bj = 0; bj < 2; ++bj) {
                    f32x4 o0 = acc[ai][bj][m][0], o1 = acc[ai][bj][m][1];
                    if (HAS_CS) { o0 *= cs0[bj]; o1 *= cs1[bj]; }
                    o0 += x0[m][bj]; o1 += x1[m][bj];
                    u32x4 w; w.x = cvt_pk_bf16(o0[0], o0[1]); w.y = cvt_pk_bf16(o0[2], o0[3]); w.z = cvt_pk_bf16(o1[0], o1[1]); w.w = cvt_pk_bf16(o1[2], o1[3]);
                    *(u32x4*)(xbu + (lofs + (unsigned)(((ai * 128 + m * 16) * D + 128 * bj) * 2))) = w;
                    s += (o0[0] * o0[0] + o0[1] * o0[1]) + (o0[2] * o0[2] + o0[3] * o0[3]) + (o1[0] * o1[0] + o1[1] * o1[1]) + (o1[2] * o1[2] + o1[3] * o1[3]);
                }
                s += bperm(s, (((fq ^ 1) << 4) | fr) << 2); s += bperm(s, (((fq ^ 2) << 4) | fr) << 2);
                if (fq == 0) atomic_addf(ssn + row, s);
            }
        }
    }
};
struct EpiAin {
    const float* ss; bf16_t* BG; bf16_t* CV; float* st_p; float* st_s;
    __device__ __forceinline__ void operator()(const AccT& acc, const pg8::Unit& u, int wr, int wc, int fr, int fq) const {
        asm volatile("" : "+v"(fr), "+v"(fq));
        float rs[2][4]; load_rstd8(ss, u.pm, wr, fr, rs);
#pragma unroll
        for (int ai = 0; ai < 2; ++ai)
#pragma unroll
            for (int m = 0; m < 4; ++m) {
                const int row = u.pm * 256 + ai * 128 + wr * 64 + m * 16 + fr;
                const float r = rs[ai][m];
                if (u.pn < 4) {
#pragma unroll
                    for (int bj = 0; bj < 2; ++bj) store_bf16x8(BG + (size_t)row * D + u.pn * 256 + 128 * bj + wc * 32 + 8 * fq, acc[ai][bj][m][0] * r, acc[ai][bj][m][1] * r);
                } else {
                    const int ch = (u.pn - 4) * 128 + wc * 32 + 8 * fq; const float r2 = r * r;
                    const f32x4 c0 = acc[ai][0][m][0] * acc[ai][1][m][0] * r2, c1 = acc[ai][0][m][1] * acc[ai][1][m][1] * r2;
                    store_bf16x8(CV + (size_t)row * D + ch, c0, c1);
                    if (u.pm < 64) { const int t = row & (SEQ - 1); if (t >= SEQ - 2) { float* o = st_p + ((size_t)(row >> 11) * 2 + (t - (SEQ - 2))) * D + ch; *(f32x4*)o = c0; *(f32x4*)(o + 4) = c1; } }
                    else { const int rr = row - MP, t = rr & 7; if (t >= 6) { float* o = st_s + ((size_t)(rr >> 3) * 2 + (t - 6)) * D + ch; *(f32x4*)o = c0; *(f32x4*)(o + 4) = c1; } }
                }
            }
    }
};
struct EpiBin {
    const float* ss; bf16_t* U; bf16_t* VT; float* VS; float* vss;
    __device__ __forceinline__ void operator()(const AccT& acc, const pg8::Unit& u, int wr, int wc, int fr, int fq) const {
        asm volatile("" : "+v"(fr), "+v"(fq));
        float rs[2][4]; load_rstd8(ss, u.pm, wr, fr, rs);
#pragma unroll
        for (int ai = 0; ai < 2; ++ai)
#pragma unroll
            for (int m = 0; m < 4; ++m) {
                const int row = u.pm * 256 + ai * 128 + wr * 64 + m * 16 + fr;
                const float r = rs[ai][m];
                if (u.pn < 4) {
#pragma unroll
                    for (int bj = 0; bj < 2; ++bj) store_bf16x8(U + (size_t)row * D + u.pn * 256 + 128 * bj + wc * 32 + 8 * fq, acc[ai][bj][m][0] * r, acc[ai][bj][m][1] * r);
                } else {
                    float s = 0.f;
#pragma unroll
                    for (int bj = 0; bj < 2; ++bj) {
                        const int ch = (u.pn - 4) * 256 + 128 * bj + wc * 32 + 8 * fq;
                        const f32x4 v0 = acc[ai][bj][m][0] * r, v1 = acc[ai][bj][m][1] * r;
                        s += (v0[0] * v0[0] + v0[1] * v0[1]) + (v0[2] * v0[2] + v0[3] * v0[3]) + (v1[0] * v1[0] + v1[1] * v1[1]) + (v1[2] * v1[2] + v1[3] * v1[3]);
                        if (u.pm < 64) {
                            const unsigned w0 = cvt_pk_bf16(v0[0], v0[1]), w1 = cvt_pk_bf16(v0[2], v0[3]), w2 = cvt_pk_bf16(v1[0], v1[1]), w3 = cvt_pk_bf16(v1[2], v1[3]);
                            bf16_t* o = VT + (size_t)ch * MP + row;
                            o[0] = (bf16_t)w0; o[(size_t)MP] = (bf16_t)(w0 >> 16); o[(size_t)2 * MP] = (bf16_t)w1; o[(size_t)3 * MP] = (bf16_t)(w1 >> 16);
                            o[(size_t)4 * MP] = (bf16_t)w2; o[(size_t)5 * MP] = (bf16_t)(w2 >> 16); o[(size_t)6 * MP] = (bf16_t)w3; o[(size_t)7 * MP] = (bf16_t)(w3 >> 16);
                        } else { float* o = VS + (size_t)(row - MP) * D + ch; *(f32x4*)o = v0; *(f32x4*)(o + 4) = v1; }
                    }
                    s += bperm(s, (((fq ^ 1) << 4) | fr) << 2); s += bperm(s, (((fq ^ 2) << 4) | fr) << 2);
                    if (fq == 0) atomic_addf(vss + row, s);
                }
            }
    }
};
__device__ __forceinline__ float dpp_shr1(float old, float v) { return __int_as_float(__builtin_amdgcn_update_dpp(__float_as_int(old), __float_as_int(v), 0x111, 0xf, 0xf, false)); }
__device__ __forceinline__ float dpp_shr2(float old, float v) { return __int_as_float(__builtin_amdgcn_update_dpp(__float_as_int(old), __float_as_int(v), 0x112, 0xf, 0xf, false)); }
__device__ __forceinline__ float dpp_ror1(float v) { return __int_as_float(__builtin_amdgcn_update_dpp(0, __float_as_int(v), 0x121, 0xf, 0xf, false)); }
__device__ __forceinline__ float dpp_ror2(float v) { return __int_as_float(__builtin_amdgcn_update_dpp(0, __float_as_int(v), 0x122, 0xf, 0xf, false)); }

struct EpiUp {
    const float* ss; bf16_t* MB; const float* cw; const float* cb; const float* st_in; float* fxp; float* fxa; float* gl; float* st_p; float* st_s;
    __device__ __forceinline__ void prompt_body(const AccT& acc, const pg8::Unit& u, int wr, int wc, int fr, int fq) const {
        constexpr float NL2E = -1.4426950408889634f, NLN2 = -0.6931471805599453f;
        const int chl = wc * 32 + 8 * fq;
        const float* ssu = ss + u.pm * 256 + wr * 64;
        float rs[2][4];
        {
            float t[2][4];
#pragma unroll
            for (int ai = 0; ai < 2; ++ai)
#pragma unroll
                for (int m = 0; m < 4; ++m) t[ai][m] = ssu[fr + ai * 128 + m * 16];
#pragma unroll
            for (int ai = 0; ai < 2; ++ai)
#pragma unroll
                for (int m = 0; m < 4; ++m) rs[ai][m] = rstd_of(t[ai][m]);
        }
        const char* cwu = (const char*)(cw + u.pn * 128); const char* cbu = (const char*)(cb + u.pn * 128);
        char* mbu = (char*)(MB + (size_t)(u.pm * 256 + wr * 64) * DFF + u.pn * 128);
        const unsigned mofs = (unsigned)(fr * DFF + chl) * 2u;
        const int G0 = u.pm * 4 + wr;
        f32x4 w0n[2], w1n[2], w2n[2], bbn[2];
#pragma unroll
        for (int n = 0; n < 2; ++n) {
            const unsigned cofs = (unsigned)(chl + 4 * n) * 4u;
            w0n[n] = *(const f32x4*)(cwu + cofs) * NL2E; w1n[n] = *(const f32x4*)(cwu + DFF * 4 + cofs) * NL2E; w2n[n] = *(const f32x4*)(cwu + 2 * DFF * 4 + cofs) * NL2E; bbn[n] = *(const f32x4*)(cbu + cofs) * NL2E;
        }
#pragma unroll
        for (int ai = 0; ai < 2; ++ai) {
            const int G = G0 + 2 * ai;
            f32x4 p1[2], p2[2];
#pragma unroll
            for (int n = 0; n < 2; ++n) { p1[n] = (f32x4){0.f, 0.f, 0.f, 0.f}; p2[n] = p1[n]; }
#pragma unroll
            for (int m = 0; m < 4; ++m) {
                const float r = rs[ai][m];
                u32x4 o;
#pragma unroll
                for (int n = 0; n < 2; ++n) {
                    const f32x4 gg = acc[ai][0][m][n] * r, an = acc[ai][1][m][n] * (r * NLN2);
                    f32x4 pv1, pv2;
#pragma unroll
                    for (int j = 0; j < 4; ++j) { pv1[j] = dpp_shr1(p1[n][j], gg[j]); pv2[j] = dpp_shr2(p2[n][j], gg[j]); }
                    const f32x4 pre = w2n[n] * gg + w1n[n] * pv1 + w0n[n] * pv2 + bbn[n];
                    f32x4 ov;
#pragma unroll
                    for (int j = 0; j < 4; ++j) ov[j] = (pre[j] * an[j]) * __builtin_amdgcn_rcpf(1.0f + __builtin_amdgcn_exp2f(pre[j]));
                    if (n == 0) { o.x = cvt_pk_bf16(ov[0], ov[1]); o.y = cvt_pk_bf16(ov[2], ov[3]); } else { o.z = cvt_pk_bf16(ov[0], ov[1]); o.w = cvt_pk_bf16(ov[2], ov[3]); }
                    if (m == 0) {
                        if ((G & 31) != 0 && fr < 2) {
                            const size_t fo = ((size_t)G * 2 + fr) * DFF + u.pn * 128 + chl + 4 * n;
                            *(f32x4*)(fxp + fo) = pre * NLN2; *(f32x4*)(fxa + fo) = an * (1.0f / NLN2);
                        }
                    }
                    if (m == 3) {
                        if (fr >= 14) {
                            const size_t go = ((size_t)G * 2 + (fr - 14)) * DFF + u.pn * 128 + chl + 4 * n;
                            *(f32x4*)(gl + go) = gg;
                            if ((G & 31) == 31) *(f32x4*)(st_p + ((size_t)(G >> 5) * 2 + (fr - 14)) * DFF + u.pn * 128 + chl + 4 * n) = gg;
                        }
                    } else {
#pragma unroll
                        for (int j = 0; j < 4; ++j) { p1[n][j] = dpp_ror1(gg[j]); p2[n][j] = dpp_ror2(gg[j]); }
                    }
                }
                *(u32x4*)(mbu + (mofs + (unsigned)(((ai * 128 + m * 16) * DFF) * 2))) = o;
            }
        }
    }
    __device__ __forceinline__ void sample_body(const AccT& acc, const pg8::Unit& u, int wr, int wc, int fr, int fq) const {
        const int src1 = ((fq << 4) | ((fr - 1) & 15)) << 2, src2 = ((fq << 4) | ((fr - 2) & 15)) << 2;
        float rs[2][4];
        const int chb = u.pn * 128 + wc * 32 + 8 * fq;
        load_rstd8(ss, u.pm, wr, fr, rs);
#pragma unroll
        for (int n = 0; n < 2; ++n) {
            const int ch = chb + 4 * n;
            const f32x4 w0n = *(const f32x4*)(cw + ch), w1n = *(const f32x4*)(cw + DFF + ch), w2n = *(const f32x4*)(cw + 2 * DFF + ch), bbn = *(const f32x4*)(cb + ch);
#pragma unroll
            for (int ai = 0; ai < 2; ++ai) {
                const int t = fr & 7;
#pragma unroll
                for (int mp = 0; mp < 4; mp += 2) {
                f32x4 s0[2], s1[2];
#pragma unroll
                for (int mm = 0; mm < 2; ++mm) {
                    const int rr = u.pm * 256 + ai * 128 + wr * 64 + (mp + mm) * 16 + fr - MP; const float* sp = st_in + (size_t)(rr >> 3) * 2 * DFF + ch;
                    s0[mm] = (f32x4){0.f, 0.f, 0.f, 0.f}; s1[mm] = s0[mm];
                    if (t < 2) { s0[mm] = *(const f32x4*)(sp); s1[mm] = *(const f32x4*)(sp + DFF); }
                }
#pragma unroll
                for (int mm = 0; mm < 2; ++mm) {
                    const int m = mp + mm;
                    const int row = u.pm * 256 + ai * 128 + wr * 64 + m * 16 + fr;
                    const float r = rs[ai][m];
                    const f32x4 gg = acc[ai][0][m][n] * r, aa = acc[ai][1][m][n] * r;
                    f32x4 pv1, pv2;
#pragma unroll
                    for (int j = 0; j < 4; ++j) { pv1[j] = bperm(gg[j], src1); pv2[j] = bperm(gg[j], src2); }
                    if (t == 0) { pv1 = s1[mm]; pv2 = s0[mm]; }
                    if (t == 1) { pv2 = s1[mm]; }
                    const f32x4 pre = w2n * gg + w1n * pv1 + w0n * pv2 + bbn;
                    u32x2 o; o.x = cvt_pk_bf16(silu_f(pre[0]) * aa[0], silu_f(pre[1]) * aa[1]); o.y = cvt_pk_bf16(silu_f(pre[2]) * aa[2], silu_f(pre[3]) * aa[3]);
                    *(u32x2*)(MB + (size_t)row * DFF + ch) = o;
                    const int rr = row - MP;
                    if (t >= 6) *(f32x4*)(st_s + ((size_t)(rr >> 3) * 2 + (t - 6)) * DFF + ch) = gg;
                }
                }
            }
        }
    }
    __device__ __forceinline__ void operator()(const AccT& acc, const pg8::Unit& u, int wr, int wc, int fr, int fq) const {
        asm volatile("" : "+v"(fr), "+v"(fq));
        if (u.pm < 64) prompt_body(acc, u, wr, wc, fr, fq); else sample_body(acc, u, wr, wc, fr, fq);
    }
};

struct Args { const float* in[22]; float* out; unsigned char* ws; int ph_lo, ph_hi; };
__device__ __forceinline__ const float* ldp(const Args& a, int i) { asm volatile("" : "+s"(i)); return a.in[i]; }
__device__ __forceinline__ unsigned char* ws_of(const Args& a) { unsigned char* p = a.ws; asm volatile("" : "+s"(p)); return p; }
__device__ __forceinline__ float* out_of(const Args& a) { float* p = a.out; asm volatile("" : "+s"(p)); return p; }
enum { I_XP = 0, I_XS, I_SSC, I_SPOOL, I_SFFN, I_GMIX, I_GFFN, I_GFIN, I_AWIN, I_ACONV, I_AWOUT, I_BWIN, I_BGV, I_BWS, I_BBIAS, I_BWOUT, I_CWG, I_CSCALE, I_FWUP, I_FCONV, I_FCONVB, I_FWDN };

template <int MAP> __device__ __forceinline__ int colmap(int n0) {
    if (MAP == 1) { if (n0 < 1024) return n0; const int q = n0 - 1024, p = q >> 8, jj = q & 255; return jj < 128 ? 1024 + 128 * p + jj : 2048 + 128 * p + (jj - 128); }
    if (MAP == 2) { const int p = n0 >> 8, jj = n0 & 255; return jj < 128 ? 128 * p + jj : DFF + 128 * p + (jj - 128); }
    return n0;
}
template <int MAP>
__device__ __forceinline__ void prep_matrix(const float* W, int K, int N, bf16_t* WT, const float* gs, LAS float* scr, int lane, int gw, int NGW, int& base) {
    const int nblk = N / 32, nitems = (K / 64) * nblk;
    int first = gw - (base % NGW); if (first < 0) first += NGW;
    for (int item = first; item < nitems; item += NGW) {
        const int kb = item / nblk, nb = item % nblk, k0 = 64 * kb, n0 = 32 * nb, sc = colmap<MAP>(n0);
        float wv[32];
#pragma unroll
        for (int i = 0; i < 32; ++i) { const int kk = 2 * i + (lane >> 5); wv[i] = W[(size_t)(k0 + kk) * N + sc + (lane & 31)]; }
        if (gs) {
#pragma unroll
            for (int i = 0; i < 32; ++i) wv[i] *= gs[k0 + 2 * i + (lane >> 5)];
        }
#pragma unroll
        for (int i = 0; i < 32; ++i) scr[(2 * i + (lane >> 5)) * 33 + (lane & 31)] = wv[i];
        asm volatile("s_waitcnt lgkmcnt(0)" ::: "memory");
        const int c = lane & 7;
#pragma unroll
        for (int j = 0; j < 4; ++j) { const int n = (lane >> 3) + 8 * j; const LAS float* s = scr + (8 * c) * 33 + n;
            u32x4 o; o.x = cvt_pk_bf16(s[0 * 33], s[1 * 33]); o.y = cvt_pk_bf16(s[2 * 33], s[3 * 33]); o.z = cvt_pk_bf16(s[4 * 33], s[5 * 33]); o.w = cvt_pk_bf16(s[6 * 33], s[7 * 33]);
            *(u32x4*)(WT + (size_t)(n0 + n) * K + k0 + 8 * c) = o; }
        asm volatile("s_waitcnt lgkmcnt(0)" ::: "memory");
    }
    base += nitems;
}

__device__ __forceinline__ void prep_weights(const Args& a, LAS unsigned char* lds, int group, int pb, int npb);
__device__ __forceinline__ void prep_phase(const Args& a, LAS unsigned char* lds) {
    unsigned char* const wsl = ws_of(a); float* const outl = out_of(a); const int tidl = tid_l();
    const int tid = tidl, lane = tid & 63, wave = tid >> 6;
    const int gw = blockIdx.x * NWAVES + wave, NGW = gridDim.x * NWAVES;
    LAS float* scr = (LAS float*)(lds + wave * 16384);
    unsigned char* ws = wsl;
    { float* z = (float*)(ws + WS_SS) + M; const int nz = 9 * M; for (int i = blockIdx.x * NTHREADS + tid; i < nz; i += gridDim.x * NTHREADS) z[i] = 0.f; }
    { float* ss0 = (float*)(ws + WS_SS); bf16_t* xb = (bf16_t*)(ws + WS_XB);
      for (int row = gw; row < M; row += NGW) {
          const float* xr = row < MP ? ldp(a, I_XP) + (size_t)row * D : ldp(a, I_XS) + (size_t)(row - MP) * D;
          float s = 0.f;
#pragma unroll
          for (int j = 0; j < 2; ++j) { const f32x4 v0 = *(const f32x4*)(xr + j * 512 + lane * 8), v1 = *(const f32x4*)(xr + j * 512 + lane * 8 + 4);
              s += (v0[0] * v0[0] + v0[1] * v0[1]) + (v0[2] * v0[2] + v0[3] * v0[3]) + (v1[0] * v1[0] + v1[1] * v1[1]) + (v1[2] * v1[2] + v1[3] * v1[3]);
              store_bf16x8(xb + (size_t)row * D + j * 512 + lane * 8, v0, v1); }
          s = wave_sum(s); if (lane == 0) ss0[row] = ss_fix(s); } }
    prep_weights(a, lds, 0, blockIdx.x, gridDim.x);
    if (gridDim.x != 256) { prep_weights(a, lds, 1, blockIdx.x, gridDim.x); prep_weights(a, lds, 2, blockIdx.x, gridDim.x); }
}
__device__ __forceinline__ void prep_weights(const Args& a, LAS unsigned char* lds, int group, int pb, int npb) {
    unsigned char* const ws = ws_of(a); const int tidl = tid_l();
    const int lane = tidl & 63, wave = tidl >> 6;
    const int gw = pb * NWAVES + wave, NGW = npb * NWAVES;
    LAS float* scr = (LAS float*)(lds + wave * 16384);
    int base = 0;
    if (group == 0) {
        prep_matrix<1>(ldp(a, I_AWIN), 1024, 3072, (bf16_t*)(ws + WS_AIN), ldp(a, I_GMIX), scr, lane, gw, NGW, base);
        prep_matrix<0>(ldp(a, I_AWOUT), 1024, 1024, (bf16_t*)(ws + WS_AOUT), nullptr, scr, lane, gw, NGW, base);
    } else if (group == 1) {
        prep_matrix<2>(ldp(a, I_FWUP), 1024, 5632, (bf16_t*)(ws + WS_UP), ldp(a, I_GFFN), scr, lane, gw, NGW, base);
        prep_matrix<0>(ldp(a, I_FWDN), 2816, 1024, (bf16_t*)(ws + WS_DN), nullptr, scr, lane, gw, NGW, base);
        prep_matrix<0>(ldp(a, I_BWIN), 1024, 2048, (bf16_t*)(ws + WS_BIN), ldp(a, I_GMIX) + (size_t)1 * D, scr, lane, gw, NGW, base);
        prep_matrix<0>(ldp(a, I_BWOUT), 1024, 1024, (bf16_t*)(ws + WS_BOUT), nullptr, scr, lane, gw, NGW, base);
        prep_matrix<2>(ldp(a, I_FWUP) + (size_t)1 * 1024 * 5632, 1024, 5632, (bf16_t*)(ws + WS_UP + 1 * SZ_UP), ldp(a, I_GFFN) + (size_t)1 * D, scr, lane, gw, NGW, base);
        prep_matrix<0>(ldp(a, I_FWDN) + (size_t)1 * 2816 * 1024, 2816, 1024, (bf16_t*)(ws + WS_DN + 1 * SZ_DN), nullptr, scr, lane, gw, NGW, base);
    } else {
        for (int g = 0; g < 4; ++g) prep_matrix<0>(ldp(a, I_CWG) + (size_t)g * 65536, 256, 256, (bf16_t*)(ws + WS_CG) + (size_t)g * 65536, nullptr, scr, lane, gw, NGW, base);
        prep_matrix<1>(ldp(a, I_AWIN) + (size_t)1024 * 3072, 1024, 3072, (bf16_t*)(ws + WS_AIN + SZ_AIN), ldp(a, I_GMIX) + (size_t)3 * D, scr, lane, gw, NGW, base);
        prep_matrix<0>(ldp(a, I_AWOUT) + (size_t)1024 * 1024, 1024, 1024, (bf16_t*)(ws + WS_AOUT + SZ_SQ), nullptr, scr, lane, gw, NGW, base);
        for (int i = 2; i < 4; ++i) {
            prep_matrix<2>(ldp(a, I_FWUP) + (size_t)i * 1024 * 5632, 1024, 5632, (bf16_t*)(ws + WS_UP + i * SZ_UP), ldp(a, I_GFFN) + (size_t)i * D, scr, lane, gw, NGW, base);
            prep_matrix<0>(ldp(a, I_FWDN) + (size_t)i * 2816 * 1024, 2816, 1024, (bf16_t*)(ws + WS_DN + i * SZ_DN), nullptr, scr, lane, gw, NGW, base);
        }
    }
}

__device__ __forceinline__ void aconv_phase(const Args& a, int j) {
    unsigned char* const wsl = ws_of(a); float* const outl = out_of(a); const int tidl = tid_l();
    const bf16_t* BG = (const bf16_t*)(wsl + WS_T1); const bf16_t* CV = (const bf16_t*)(wsl + WS_T2); bf16_t* ZB = (bf16_t*)(wsl + WS_T3);
    const float* cw = ldp(a, I_ACONV) + (size_t)j * 3 * D; const float* st = ldp(a, I_SSC) + (size_t)j * DECB * 2 * D;
    const int tid = tidl, c8 = (tid & 127) * 8, rsub = tid >> 7;
    f32x4 w[3][2];
#pragma unroll
    for (int k = 0; k < 3; ++k) { w[k][0] = *(const f32x4*)(cw + k * D + c8); w[k][1] = *(const f32x4*)(cw + k * D + c8 + 4); }
    for (int r16 = blockIdx.x; r16 < M / 16; r16 += gridDim.x) {
        const int row0 = r16 * 16 + rsub * 4;
        int t0; const float* sp = nullptr;
        if (row0 < MP) t0 = row0 & (SEQ - 1); else { const int rr = row0 - MP; t0 = rr & 7; sp = st + (size_t)(rr >> 3) * 2 * D + c8; }
        u32x4 cvr[6], bgr[4]; f32x4 h0[2], h1[2];
        const bool halo_mem = (t0 >= 2);
#pragma unroll
        for (int k = 0; k < 6; ++k) if (k >= 2 || halo_mem) cvr[k] = *(const u32x4*)(CV + (size_t)(row0 - 2 + k) * D + c8);
#pragma unroll
        for (int k = 0; k < 4; ++k) bgr[k] = *(const u32x4*)(BG + (size_t)(row0 + k) * D + c8);
        if (!halo_mem) {
            if (sp) { h0[0] = *(const f32x4*)(sp); h0[1] = *(const f32x4*)(sp + 4); h1[0] = *(const f32x4*)(sp + D); h1[1] = *(const f32x4*)(sp + D + 4); }
            else { h0[0] = (f32x4){0.f, 0.f, 0.f, 0.f}; h0[1] = h0[0]; h1[0] = h0[0]; h1[1] = h0[0]; }
        } else { h0[0] = bf4_lo(cvr[0]); h0[1] = bf4_hi(cvr[0]); h1[0] = bf4_lo(cvr[1]); h1[1] = bf4_hi(cvr[1]); }
        f32x4 xm2[2] = {h0[0], h0[1]}, xm1[2] = {h1[0], h1[1]};
#pragma unroll
        for (int k = 0; k < 4; ++k) {
            const f32x4 x0 = bf4_lo(cvr[2 + k]), x1 = bf4_hi(cvr[2 + k]);
            const f32x4 y0 = w[0][0] * xm2[0] + w[1][0] * xm1[0] + w[2][0] * x0, y1 = w[0][1] * xm2[1] + w[1][1] * xm1[1] + w[2][1] * x1;
            store_bf16x8(ZB + (size_t)(row0 + k) * D + c8, bf4_lo(bgr[k]) * y0, bf4_hi(bgr[k]) * y1);
            xm2[0] = xm1[0]; xm2[1] = xm1[1]; xm1[0] = x0; xm1[1] = x1;
        }
    }
}

__device__ __forceinline__ void spatial_phase(const Args& a) {
    unsigned char* const wsl = ws_of(a); float* const outl = out_of(a); const int tidl = tid_l();
    const bf16_t* U = (const bf16_t*)(wsl + WS_T1); const bf16_t* VT = (const bf16_t*)(wsl + WS_T2); bf16_t* ZB = (bf16_t*)(wsl + WS_T3);
    const float* VS = (const float*)(wsl + WS_VS); const float* vss = (const float*)(wsl + WS_VSS);
    const float* Ws = ldp(a, I_BWS); const float* bias = ldp(a, I_BBIAS); const float* gv = ldp(a, I_BGV);
    const int tid = tidl, lane = tid & 63, w = tid >> 6, fr = lane & 15, fq = lane >> 4;
    for (int unit = blockIdx.x; unit < 512 + 2 * DECB; unit += gridDim.x) {
        if (unit < 512) {
            const int c = unit >> 2, h = unit & 3, rb = c * 128;
#pragma unroll 1
            for (int job = 0; job < 2; ++job) {
                const int tt = job ? 7 - w : w, t = 16 * tt + fr, nks = (tt >> 1) + 1, d0 = job * 8;
                bf16x8 Wf[4];
                {
                    f32x4 wa[4], wb[4], va[4], vb[4];
#pragma unroll
                    for (int ks = 0; ks < 4; ++ks) {
                        const int s0 = ks * 32 + 8 * fq; const float* wp = Ws + ((size_t)(h * 128 + t) * 128 + s0);
                        wa[ks] = *(const f32x4*)wp; wb[ks] = *(const f32x4*)(wp + 4); va[ks] = *(const f32x4*)(vss + rb + s0); vb[ks] = *(const f32x4*)(vss + rb + s0 + 4);
                    }
#pragma unroll
                    for (int ks = 0; ks < 4; ++ks) {
                        const int s0 = ks * 32 + 8 * fq; float wv[8];
#pragma unroll
                        for (int i = 0; i < 4; ++i) { wv[i] = (s0 + i <= t) ? wa[ks][i] * rstd_of(va[ks][i]) : 0.f; wv[4 + i] = (s0 + 4 + i <= t) ? wb[ks][i] * rstd_of(vb[ks][i]) : 0.f; }
                        u32x4 wpk; wpk.x = cvt_pk_bf16(wv[0], wv[1]); wpk.y = cvt_pk_bf16(wv[2], wv[3]); wpk.z = cvt_pk_bf16(wv[4], wv[5]); wpk.w = cvt_pk_bf16(wv[6], wv[7]);
                        Wf[ks] = __builtin_bit_cast(bf16x8, wpk);
                    }
                }
                f32x4 acc[8];
#pragma unroll
                for (int i = 0; i < 8; ++i) acc[i] = (f32x4){0.f, 0.f, 0.f, 0.f};
#pragma unroll
                for (int kp = 0; kp < 2; ++kp) {
                    if (2 * kp < nks) {
                        bf16x8 vf[2][8];
#pragma unroll
                        for (int k2 = 0; k2 < 2; ++k2) { const int s0 = (2 * kp + k2) * 32 + 8 * fq;
#pragma unroll
                            for (int dt = 0; dt < 8; ++dt) vf[k2][dt] = *(const bf16x8*)(VT + (size_t)(h * 256 + (d0 + dt) * 16 + fr) * MP + rb + s0); }
                        __builtin_amdgcn_sched_barrier(0);
#pragma unroll
                        for (int k2 = 0; k2 < 2; ++k2)
#pragma unroll
                            for (int dt = 0; dt < 8; ++dt) acc[dt] = __builtin_amdgcn_mfma_f32_16x16x32_bf16(vf[k2][dt], Wf[2 * kp + k2], acc[dt], 0, 0, 0);
                    }
                }
                const int row = rb + t; const float bs = bias[h * 128 + t];
                u32x2 uu[8]; f32x4 g4[8];
#pragma unroll
                for (int dt = 0; dt < 8; ++dt) { const int ch = h * 256 + (d0 + dt) * 16 + 4 * fq; uu[dt] = *(const u32x2*)(U + (size_t)row * D + ch); g4[dt] = *(const f32x4*)(gv + ch); }
#pragma unroll
                for (int dt = 0; dt < 8; ++dt) {
                    const int ch = h * 256 + (d0 + dt) * 16 + 4 * fq;
                    const f32x4 u4 = (f32x4){bf_lo(uu[dt].x), bf_hi(uu[dt].x), bf_lo(uu[dt].y), bf_hi(uu[dt].y)};
                    const f32x4 z = u4 * (acc[dt] * g4[dt] + bs);
                    u32x2 o; o.x = cvt_pk_bf16(z[0], z[1]); o.y = cvt_pk_bf16(z[2], z[3]);
                    *(u32x2*)(ZB + (size_t)row * D + ch) = o;
                }
            }
        } else {
            const int su = unit - 512, b = su >> 1, tb = (su & 1) * 4, r0 = MP + 8 * b, ch = 2 * tid, h = ch >> 8;
            float v0[8], v1[8], rv[8], ww[4][8], bs[4]; unsigned uu[4];
#pragma unroll
            for (int s = 0; s < 8; ++s) { rv[s] = vss[r0 + s]; const f32x2 vv = *(const f32x2*)(VS + (size_t)(8 * b + s) * D + ch); v0[s] = vv.x; v1[s] = vv.y; }
#pragma unroll
            for (int tt = 0; tt < 4; ++tt) {
                const int t = tb + tt;
#pragma unroll
                for (int s = 0; s < 8; ++s) ww[tt][s] = Ws[(size_t)(h * 128 + t) * 128 + s];
                bs[tt] = bias[h * 128 + t]; uu[tt] = *(const unsigned*)(U + (size_t)(r0 + t) * D + ch);
            }
            const f32x2 g2 = *(const f32x2*)(gv + ch);
#pragma unroll
            for (int s = 0; s < 8; ++s) { rv[s] = rstd_of(rv[s]); v0[s] *= rv[s]; v1[s] *= rv[s]; }
            float* cvo = outl + O_CV + (size_t)(8 * b) * D + ch;
#pragma unroll
            for (int tt = 0; tt < 4; ++tt) {
                const int t = tb + tt;
                float s0 = 0.f, s1 = 0.f;
#pragma unroll
                for (int s = 0; s < 8; ++s) { const float wm = (s <= t) ? ww[tt][s] : 0.f; s0 += wm * v0[s]; s1 += wm * v1[s]; }
                const float z0 = bf_lo(uu[tt]) * (s0 * g2.x + bs[tt]), z1 = bf_hi(uu[tt]) * (s1 * g2.y + bs[tt]);
                *(unsigned*)(ZB + (size_t)(r0 + t) * D + ch) = cvt_pk_bf16(z0, z1);
                const float c0 = (tb ? (tt == 0 ? v0[4] : tt == 1 ? v0[5] : tt == 2 ? v0[6] : v0[7]) : (tt == 0 ? v0[0] : tt == 1 ? v0[1] : tt == 2 ? v0[2] : v0[3]));
                const float c1 = (tb ? (tt == 0 ? v1[4] : tt == 1 ? v1[5] : tt == 2 ? v1[6] : v1[7]) : (tt == 0 ? v1[0] : tt == 1 ? v1[1] : tt == 2 ? v1[2] : v1[3]));
                *(f32x2*)(cvo + (size_t)t * D) = (f32x2){c0 * g2.x, c1 * g2.y};
            }
        }
    }
}

__device__ __forceinline__ void pool_phase(const Args& a, LAS unsigned char* lds, const float* ssk, const float* gm) {
    unsigned char* const wsl = ws_of(a); float* const outl = out_of(a); const int tidl = tid_l();
    const bf16_t* XBr = (const bf16_t*)(wsl + WS_XB); bf16_t* DB = (bf16_t*)(wsl + WS_T1);
    const float* st = ldp(a, I_SPOOL);
    LAS float* H = (LAS float*)lds;
    const int tid = tidl, q = tid & 255, c4 = q * 4, rsub = tid >> 8, win = 2 << (c4 >> 8);
    const f32x4 g4 = *(const f32x4*)(gm + c4);
    for (int strip = blockIdx.x; strip < 1024 + DECB; strip += gridDim.x) {
        const bool prompt = strip < 1024;
        const int b = strip - 1024;
        const int row0 = prompt ? strip * 16 : MP + b * 8;
        const int t0 = prompt ? (row0 & (SEQ - 1)) : 0;
        f32x4 v[16]; float sv[16];
#pragma unroll
        for (int k = 0; k < 16; ++k) {
            const int i = rsub + 2 * k;
            v[k] = (f32x4){0.f, 0.f, 0.f, 0.f}; sv[k] = -1.f;
            if (prompt) { if (i < 31 && t0 - 15 + i >= 0) { const int row = row0 - 15 + i; const u32x2 w = *(const u32x2*)(XBr + (size_t)row * D + c4); v[k] = (f32x4){bf_lo(w.x), bf_hi(w.x), bf_lo(w.y), bf_hi(w.y)}; sv[k] = ssk[row]; } }
            else { if (i < 15) v[k] = *(const f32x4*)(st + ((size_t)b * 15 + i) * D + c4);
                   else if (i < 23) { const int row = row0 + (i - 15); const u32x2 w = *(const u32x2*)(XBr + (size_t)row * D + c4); v[k] = (f32x4){bf_lo(w.x), bf_hi(w.x), bf_lo(w.y), bf_hi(w.y)}; sv[k] = ssk[row]; } }
        }
#pragma unroll
        for (int k = 0; k < 16; ++k) { const int i = rsub + 2 * k; if (i < 31) { const f32x4 hv = sv[k] >= 0.f ? v[k] * (g4 * rstd_of(sv[k])) : v[k]; *(LAS f32x4*)(H + i * 1024 + c4) = hv; } }
        __syncthreads();
        const int nper = prompt ? 8 : 4, r0 = rsub * nper;
        f32x4 s = (f32x4){0.f, 0.f, 0.f, 0.f};
        for (int k = 0; k < win; ++k) s += *(const LAS f32x4*)(H + (15 + r0 - k) * 1024 + c4);
        for (int rr = 0; rr < nper; ++rr) {
            const int r = r0 + rr, t = t0 + r;
            const f32x4 hc = *(const LAS f32x4*)(H + (15 + r) * 1024 + c4);
            const float cnt = prompt ? (float)((t + 1 < win) ? t + 1 : win) : (float)win;
            const f32x4 d = s * (1.0f / cnt) - hc;
            u32x2 o; o.x = cvt_pk_bf16(d[0], d[1]); o.y = cvt_pk_bf16(d[2], d[3]);
            *(u32x2*)(DB + (size_t)(row0 + r) * D + c4) = o;
            if (rr + 1 < nper) s += *(const LAS f32x4*)(H + (15 + r + 1) * 1024 + c4) - *(const LAS f32x4*)(H + (15 + r + 1 - win) * 1024 + c4);
        }
        if (prompt) {
            if (t0 == SEQ - 16) { for (int r = 1 + rsub; r < 16; r += 2) *(f32x4*)(outl + O_PP + ((size_t)(row0 >> 11) * 15 + (r - 1)) * D + c4) = *(const LAS f32x4*)(H + (15 + r) * 1024 + c4); }
        } else {
            for (int kk = rsub; kk < 15; kk += 2) *(f32x4*)(outl + O_PS + ((size_t)b * 15 + kk) * D + c4) = *(const LAS f32x4*)(H + (8 + kk) * 1024 + c4);
        }
        __syncthreads();
    }
}

__device__ __forceinline__ void ffn_fix_phase(const Args& a, int layer) {
    unsigned char* const wsl = ws_of(a); float* const outl = out_of(a); const int tidl = tid_l();
    const float* fxp = (const float*)(wsl + WS_FXP); const float* fxa = (const float*)(wsl + WS_FXA); const float* gl = (const float*)(wsl + WS_GL);
    bf16_t* MB = (bf16_t*)(wsl + WS_MB); const float* cw = ldp(a, I_FCONV) + (size_t)layer * 3 * DFF;
    const int total = 256 * 2 * (DFF / 4);
    for (int i = blockIdx.x * NTHREADS + tidl; i < total; i += gridDim.x * NTHREADS) {
        const int c4 = (i % (DFF / 4)) * 4, gr = i / (DFF / 4), G = gr >> 1, r = gr & 1;
        if ((G & 31) == 0) continue;
        const f32x4 w0 = *(const f32x4*)(cw + c4), w1 = *(const f32x4*)(cw + DFF + c4);
        f32x4 pre = *(const f32x4*)(fxp + ((size_t)G * 2 + r) * DFF + c4);
        const f32x4 gm1 = *(const f32x4*)(gl + ((size_t)(G - 1) * 2 + 1) * DFF + c4);
        if (r == 0) { const f32x4 gm2 = *(const f32x4*)(gl + ((size_t)(G - 1) * 2 + 0) * DFF + c4); pre += w1 * gm1 + w0 * gm2; }
        else pre += w0 * gm1;
        const f32x4 av = *(const f32x4*)(fxa + ((size_t)G * 2 + r) * DFF + c4);
        u32x2 o; o.x = cvt_pk_bf16(silu_f(pre[0]) * av[0], silu_f(pre[1]) * av[1]); o.y = cvt_pk_bf16(silu_f(pre[2]) * av[2], silu_f(pre[3]) * av[3]);
        *(u32x2*)(MB + (size_t)(G * 64 + r) * DFF + c4) = o;
    }
}


__device__ __forceinline__ void ffn_fix_panel(const Args& a, int layer, int pm) {
    unsigned char* const wsl = ws_of(a); const int tidl = tid_l();
    const float* fxp = (const float*)(wsl + WS_FXP); const float* fxa = (const float*)(wsl + WS_FXA); const float* gl = (const float*)(wsl + WS_GL);
    bf16_t* MB = (bf16_t*)(wsl + WS_MB); const float* cw = ldp(a, I_FCONV) + (size_t)layer * 3 * DFF;
    constexpr int NIT = (8 * (DFF / 4)) / NTHREADS;
    static_assert(NIT * NTHREADS == 8 * (DFF / 4), "fix items");
    {
        f32x4 pre[NIT], av[NIT], g1[NIT], g2[NIT];
#pragma unroll
        for (int k = 0; k < NIT; ++k) {
            const int i = tidl + k * NTHREADS, c4 = (i % (DFF / 4)) * 4, gr = i / (DFF / 4), G = pm * 4 + (gr >> 1), r = gr & 1;
            const int Gp = (G & 31) ? G - 1 : G;
            pre[k] = *(const f32x4*)(fxp + ((size_t)G * 2 + r) * DFF + c4); av[k] = *(const f32x4*)(fxa + ((size_t)G * 2 + r) * DFF + c4);
            g1[k] = *(const f32x4*)(gl + ((size_t)Gp * 2 + 1) * DFF + c4); g2[k] = *(const f32x4*)(gl + ((size_t)Gp * 2 + 0) * DFF + c4);
        }
#pragma unroll
        for (int k = 0; k < NIT; ++k) {
            const int i = tidl + k * NTHREADS, c4 = (i % (DFF / 4)) * 4, gr = i / (DFF / 4), G = pm * 4 + (gr >> 1), r = gr & 1;
            if ((G & 31) == 0) continue;
            const f32x4 w0 = *(const f32x4*)(cw + c4), w1 = *(const f32x4*)(cw + DFF + c4);
            f32x4 p = pre[k];
            if (r == 0) p += w1 * g1[k] + w0 * g2[k]; else p += w0 * g1[k];
            u32x2 o; o.x = cvt_pk_bf16(silu_f(p[0]) * av[k][0], silu_f(p[1]) * av[k][1]); o.y = cvt_pk_bf16(silu_f(p[2]) * av[k][2], silu_f(p[3]) * av[k][3]);
            *(u32x2*)(MB + (size_t)(G * 64 + r) * DFF + c4) = o;
        }
    }
}

template <int nsplit> __device__ __forceinline__ void sample_fin_phase(const Args& a, float* ssn, const float* xin_s) {
    unsigned char* const wsl = ws_of(a); const int tidl = tid_l();
    bf16_t* XB = (bf16_t*)(wsl + WS_XB); const float* part = (const float*)(wsl + WS_PART);
    const int lane = tidl & 63, gw = blockIdx.x * NWAVES + (tidl >> 6), NGW = gridDim.x * NWAVES;
    for (int r = gw; r < MS; r += NGW) {
        const int row = MP + r, pmq = r >> 8, rl = r & 255; float s = 0.f;
        f32x4 v[4];
        if (xin_s) {
#pragma unroll
            for (int j = 0; j < 4; ++j) v[j] = *(const f32x4*)(xin_s + (size_t)r * D + j * 256 + lane * 4);
        } else {
#pragma unroll
            for (int j = 0; j < 4; ++j) { const u32x2 w = *(const u32x2*)(XB + (size_t)row * D + j * 256 + lane * 4); v[j] = (f32x4){bf_lo(w.x), bf_hi(w.x), bf_lo(w.y), bf_hi(w.y)}; }
        }
#pragma unroll
        for (int kc = 0; kc < nsplit; ++kc) {
#pragma unroll
            for (int j = 0; j < 4; ++j) v[j] += *(const f32x4*)(part + ((size_t)((pmq * 4 + j) * nsplit + kc) * 65536) + (size_t)rl * 256 + lane * 4);
        }
#pragma unroll
        for (int j = 0; j < 4; ++j) {
            u32x2 o; o.x = cvt_pk_bf16(v[j][0], v[j][1]); o.y = cvt_pk_bf16(v[j][2], v[j][3]);
            *(u32x2*)(XB + (size_t)row * D + j * 256 + lane * 4) = o;
            s += (v[j][0] * v[j][0] + v[j][1] * v[j][1]) + (v[j][2] * v[j][2] + v[j][3] * v[j][3]);
        }
        s = wave_sum(s); if (lane == 0) ssn[row] = ss_fix(s);
    }
}

__device__ __forceinline__ void final_phase(const Args& a) {
    unsigned char* const wsl = ws_of(a); float* const outl = out_of(a); const int tidl = tid_l();
    const bf16_t* XBr = (const bf16_t*)(wsl + WS_XB); const float* ss8 = (const float*)(wsl + WS_SS) + (size_t)8 * M; const float* gf = ldp(a, I_GFIN);
    const int lane = tidl & 63, gw = blockIdx.x * NWAVES + (tidl >> 6), NGW = gridDim.x * NWAVES;
    f32x4 g[4];
#pragma unroll
    for (int j = 0; j < 4; ++j) g[j] = *(const f32x4*)(gf + j * 256 + lane * 4);
    const float* part = (const float*)(wsl + WS_PART);
    for (int row = gw; row < MP; row += 2 * NGW) {
        const int row2 = row + NGW; const bool has2 = row2 < MP;
        u32x2 w0[4], w1[4];
#pragma unroll
        for (int j = 0; j < 4; ++j) { w0[j] = *(const u32x2*)(XBr + (size_t)row * D + j * 256 + lane * 4); if (has2) w1[j] = *(const u32x2*)(XBr + (size_t)row2 * D + j * 256 + lane * 4); }
        const float r0 = rstd_of(ss8[row]), r1 = has2 ? rstd_of(ss8[row2]) : 0.f;
#pragma unroll
        for (int j = 0; j < 4; ++j) *(f32x4*)(outl + (size_t)row * D + j * 256 + lane * 4) = (f32x4){bf_lo(w0[j].x), bf_hi(w0[j].x), bf_lo(w0[j].y), bf_hi(w0[j].y)} * (g[j] * r0);
        if (has2) {
#pragma unroll
            for (int j = 0; j < 4; ++j) *(f32x4*)(outl + (size_t)row2 * D + j * 256 + lane * 4) = (f32x4){bf_lo(w1[j].x), bf_hi(w1[j].x), bf_lo(w1[j].y), bf_hi(w1[j].y)} * (g[j] * r1);
        }
    }
    for (int row = MP + gw; row < M; row += NGW) {
        f32x4 xv[4];
#pragma unroll
        for (int j = 0; j < 4; ++j) { const u32x2 w = *(const u32x2*)(XBr + (size_t)row * D + j * 256 + lane * 4); xv[j] = (f32x4){bf_lo(w.x), bf_hi(w.x), bf_lo(w.y), bf_hi(w.y)}; }
        const int rr = row - MP, pmq = rr >> 8, rl = rr & 255; float s = 0.f;
#pragma unroll
        for (int kc = 0; kc < 11; ++kc) {
#pragma unroll
            for (int j = 0; j < 4; ++j) xv[j] += *(const f32x4*)(part + ((size_t)((pmq * 4 + j) * 11 + kc) * 65536) + (size_t)rl * 256 + lane * 4);
        }
#pragma unroll
        for (int j = 0; j < 4; ++j) {
            s += (xv[j][0] * xv[j][0] + xv[j][1] * xv[j][1]) + (xv[j][2] * xv[j][2] + xv[j][3] * xv[j][3]);
            const unsigned lo = cvt_pk_bf16(xv[j][0], xv[j][1]), hi = cvt_pk_bf16(xv[j][2], xv[j][3]);
            xv[j] = (f32x4){bf_lo(lo), bf_hi(lo), bf_lo(hi), bf_hi(hi)};
        }
        s = wave_sum(s); const float r = rstd_of(ss_fix(s));
#pragma unroll
        for (int j = 0; j < 4; ++j) *(f32x4*)(outl + (size_t)row * D + j * 256 + lane * 4) = xv[j] * (g[j] * r);
    }
}


#define XB_TMO      128
#define XB_XCNT(j)  (256  + 64 * (j))
#define XB_XSUB(j)  (1280 + 64 * (j))
#define XB_XGEN(j)  (2304 + 64 * (j))
#define XB_TOP      3328
#define XB_TOPGEN   3392
#define XCD_BAR_WORDS 3456
#define XB_SPIN_CAP (1u << 22)
__device__ __forceinline__ unsigned xb_ld(unsigned* p)              { return __hip_atomic_load(p, __ATOMIC_RELAXED, __HIP_MEMORY_SCOPE_AGENT); }
__device__ __forceinline__ unsigned xb_add(unsigned* p, unsigned v) { return __hip_atomic_fetch_add(p, v, __ATOMIC_RELAXED, __HIP_MEMORY_SCOPE_AGENT); }
__device__ __forceinline__ unsigned xb_xcc_id() { return (unsigned)__builtin_amdgcn_s_getreg((3 << 11) | 20) & 0xFu; }
#define XB_SPIN(cond, bar) do { unsigned _sp = 0; while (cond) { __builtin_amdgcn_s_sleep(1); \
    if ((++_sp & 255u) == 0u) { if (xb_ld(&(bar)[XB_TMO])) break; if (_sp > XB_SPIN_CAP) { atomicAdd(&(bar)[XB_TMO], 1u); break; } } } } while (0)
struct XcdBarrier { unsigned* bar; unsigned x; volatile LAS unsigned* st; };
__device__ __forceinline__ XcdBarrier xcd_barrier_post(unsigned* bar, volatile LAS unsigned* st) {
    XcdBarrier b; b.bar = bar; b.x = xb_xcc_id(); b.st = st;
    if (threadIdx.x == 0) (void)xb_add(&bar[XB_XCNT(b.x)], 1u);
    return b;
}
__device__ __forceinline__ void xcd_barrier_complete(unsigned* bar, unsigned x, unsigned& nloc, unsigned& nx) {
    const unsigned G = gridDim.x * gridDim.y * gridDim.z;
    unsigned sum, cnt, mine, sp = 0u;
    for (;;) {
        sum = 0u; cnt = 0u; mine = 0u;
#pragma unroll
        for (unsigned j = 0; j < 16; ++j) { const unsigned c = xb_ld(&bar[XB_XCNT(j)]); sum += c; cnt += (c > 0u) ? 1u : 0u; mine = (j == x) ? c : mine; }
        if (sum == G) break;
        __builtin_amdgcn_s_sleep(1);
        if ((++sp & 255u) == 0u) { if (xb_ld(&bar[XB_TMO])) break; if (sp > XB_SPIN_CAP) { atomicAdd(&bar[XB_TMO], 1u); break; } }
    }
    nloc = mine > 0u ? mine : 1u; nx = cnt > 0u ? cnt : 1u;
}
__device__ __forceinline__ void xcd_barrier(const XcdBarrier& b, bool ts_on = false, bool ts_sel = false) {
    asm volatile("s_waitcnt vmcnt(0)" ::: "memory");
    __syncthreads();
    if (threadIdx.x == 0) {
        unsigned* bar = b.bar;
        __builtin_amdgcn_s_waitcnt(0);
        unsigned nloc = b.st[0], nx = b.st[1];
        if (nloc == 0u) { xcd_barrier_complete(bar, b.x, nloc, nx); b.st[0] = nloc; b.st[1] = nx; }
        const unsigned old = xb_add(&bar[XB_XSUB(b.x)], 1u);
        const unsigned gen = old / nloc;
        if (old + 1u == (gen + 1u) * nloc) {
            __builtin_amdgcn_fence(__ATOMIC_RELEASE, "agent");
            asm volatile("s_waitcnt vmcnt(0)" ::: "memory");
            const unsigned og = xb_add(&bar[XB_TOP], 1u);
            const unsigned tg = og / nx;
            if (og + 1u == (tg + 1u) * nx) xb_add(&bar[XB_TOPGEN], 1u);
            else XB_SPIN(xb_ld(&bar[XB_TOPGEN]) == tg, bar);
            __builtin_amdgcn_fence(__ATOMIC_ACQUIRE, "agent");
            xb_add(&bar[XB_XGEN(b.x)], 1u);
            asm volatile("s_waitcnt vmcnt(0)" ::: "memory");
        } else {
            XB_SPIN(xb_ld(&bar[XB_XGEN(b.x)]) == gen, bar);
            __builtin_amdgcn_fence(__ATOMIC_ACQUIRE, "agent");
            asm volatile("s_waitcnt vmcnt(0)" ::: "memory");
        }
        if (ts_on && blockIdx.x == 0) { unsigned long long* tsw = (unsigned long long*)(bar + 3584); const unsigned long long tn_ = __builtin_amdgcn_s_memrealtime(); if (ts_sel) tsw[0] += tn_ - tsw[1]; tsw[1] = tn_; }
    }
    __syncthreads();
}

constexpr int LDS_BYTES = 147456;
constexpr unsigned TS_SEL = 0u;
constexpr int REP_SYNC = 1, REP_MISC = 1, REP_UP = 1, REP_IN = 1;
constexpr int N_PHASES = 27;

__global__ void __launch_bounds__(NTHREADS, 2) trunk_fwd(Args a) {
    extern __shared__ __attribute__((aligned(16))) unsigned char lds_raw[];
    LAS unsigned char* lds = (LAS unsigned char*)lds_raw;
    cg::grid_group grid = cg::this_grid();
    volatile LAS unsigned* misc = (volatile LAS unsigned*)(lds + 131072 + 512);
    if (threadIdx.x < 2) misc[threadIdx.x] = 0u;
    __syncthreads();
    const XcdBarrier xbar = xcd_barrier_post((unsigned*)(a.ws + WS_BAR), misc);
    int ph = 0;
    if (TS_SEL && blockIdx.x == 0 && threadIdx.x == 0) { unsigned long long* tsw = (unsigned long long*)(a.ws + WS_BAR + 14336); unsigned long long t0_ = __builtin_amdgcn_s_memrealtime(); asm volatile("" : "+v"(t0_)); tsw[0] = 0ull; tsw[1] = t0_; }
#define GSYNC() do { if (a.ph_lo < 0) grid.sync(); else xcd_barrier(xbar); } while (0)
#define PHASE_BEGIN_R(reps) if (ph >= a.ph_lo && ph < a.ph_hi) { for (int rep_ = 0; rep_ < (reps); ++rep_) { if (rep_) GSYNC(); unsigned char* const ws = ws_of(a); const int G = gridDim.x, bx = blockIdx.x; (void)ws; (void)G; (void)bx;
#define PHASE_BEGIN PHASE_BEGIN_R(1)
#define PHASE_END_T(ty)   } if (ph + 1 < a.ph_hi) { for (int s_ = 0; s_ < REP_SYNC; ++s_) xcd_barrier(xbar, TS_SEL != 0u, ((TS_SEL >> (ty)) & 1u) != 0u); } } ++ph;
#define SSP(k) ((float*)(ws + WS_SS) + (size_t)(k) * M)
#define XP ((float*)(ws + WS_X))
#define XBP ((bf16_t*)(ws + WS_XB))
#define T1P ((bf16_t*)(ws + WS_T1))
#define T2P ((bf16_t*)(ws + WS_T2))
#define T3P ((bf16_t*)(ws + WS_T3))

    PHASE_BEGIN_R(REP_MISC) prep_phase(a, lds); PHASE_END_T(0)

    for (int layer = 0; layer < 4; ++layer) {
        const int kind = layer % 3, j = layer / 3;
        if (kind == 0) {
            PHASE_BEGIN_R(REP_IN)
                pg8::Gemm g{XBP, (const bf16_t*)(ws + WS_AIN + j * SZ_AIN), D, D, D, 68, 12, 0}; pg8::StaticOrder S; S.init(68, 12, G, bx, D);
                EpiAin E{SSP(2 * layer), T1P, T2P, out_of(a) + O_SCP + (size_t)j * 8 * 2 * D, out_of(a) + O_SCS + (size_t)j * DECB * 2 * D};
                pg8::gemm_phase(lds, g, S, E);
                if (layer == 0 && rep_ == 0 && bx >= 48 && G == 256) { __syncthreads(); prep_weights(a, lds, 1, bx - 48, 208); }
            PHASE_END_T(1)
            PHASE_BEGIN_R(REP_MISC) aconv_phase(a, j); PHASE_END_T(2)
            PHASE_BEGIN
                pg8::Gemm g{T3P, (const bf16_t*)(ws + WS_AOUT + j * SZ_SQ), D, D, D, 68, 4, 0}; pg8::StaticOrder S; S.init(64, 4, G, bx, D, 4, 4, 256);
                if (layer == 0) { EpiRes<false, true> E{ldp(a, I_XP), ldp(a, I_XS), XBP, SSP(2 * layer + 1), nullptr, (float*)(ws + WS_PART)}; pg8::gemm_phase(lds, g, S, E); }
                else { EpiRes<false, false> E{nullptr, nullptr, XBP, SSP(2 * layer + 1), nullptr, (float*)(ws + WS_PART)}; pg8::gemm_phase(lds, g, S, E); }
            PHASE_END_T(3)
            PHASE_BEGIN sample_fin_phase<4>(a, SSP(2 * layer + 1), layer == 0 ? ldp(a, I_XS) : (const float*)nullptr); PHASE_END_T(4)
        } else if (kind == 1) {
            PHASE_BEGIN
                pg8::Gemm g{XBP, (const bf16_t*)(ws + WS_BIN), D, D, D, 68, 8, 0}; pg8::StaticOrder S; S.init(68, 8, G, bx, D);
                EpiBin E{SSP(2 * layer), T1P, T2P, (float*)(ws + WS_VS), (float*)(ws + WS_VSS)};
                pg8::gemm_phase(lds, g, S, E);
                if (bx >= 32 && G == 256) { __syncthreads(); prep_weights(a, lds, 2, bx - 32, 224); }
            PHASE_END_T(8)
            PHASE_BEGIN_R(REP_MISC) spatial_phase(a); PHASE_END_T(9)
            PHASE_BEGIN
                pg8::Gemm g{T3P, (const bf16_t*)(ws + WS_BOUT), D, D, D, 68, 4, 0}; pg8::StaticOrder S; S.init(64, 4, G, bx, D, 4, 4, 256);
                EpiRes<false, false> E{nullptr, nullptr, XBP, SSP(2 * layer + 1), nullptr, (float*)(ws + WS_PART)};
                pg8::gemm_phase(lds, g, S, E);
            PHASE_END_T(3)
            PHASE_BEGIN sample_fin_phase<4>(a, SSP(2 * layer + 1), layer == 0 ? ldp(a, I_XS) : (const float*)nullptr); PHASE_END_T(4)
        } else {
            PHASE_BEGIN_R(REP_MISC) pool_phase(a, lds, SSP(2 * layer), ldp(a, I_GMIX) + (size_t)layer * D); PHASE_END_T(10)
            PHASE_BEGIN
                pg8::Gemm g{T1P, (const bf16_t*)(ws + WS_CG), D, 256, 256, 68, 4, 256}; pg8::StaticOrder S; S.init(68, 4, G, bx, 256);
                EpiRes<true, false> E{nullptr, nullptr, XBP, SSP(2 * layer + 1), ldp(a, I_CSCALE), (float*)(ws + WS_PART)};
                pg8::gemm_phase(lds, g, S, E);
            PHASE_END_T(11)
        }
        PHASE_BEGIN_R(REP_UP)
            pg8::Gemm g{XBP, (const bf16_t*)(ws + WS_UP + layer * SZ_UP), D, D, D, 68, 22, 0}; pg8::StaticOrder S; S.init(64, 22, G, bx, D, 4, 1, D);
            EpiUp E{SSP(2 * layer + 1), (bf16_t*)(ws + WS_MB), ldp(a, I_FCONV) + (size_t)layer * 3 * DFF, ldp(a, I_FCONVB) + (size_t)layer * DFF, ldp(a, I_SFFN) + (size_t)layer * DECB * 2 * DFF,
                    (float*)(ws + WS_FXP), (float*)(ws + WS_FXA), (float*)(ws + WS_GL), out_of(a) + O_FP + (size_t)layer * 8 * 2 * DFF, out_of(a) + O_FS + (size_t)layer * DECB * 2 * DFF};
            pg8::gemm_phase(lds, g, S, E);
        PHASE_END_T(5)
        PHASE_BEGIN
            pg8::Gemm g{(const bf16_t*)(ws + WS_MB), (const bf16_t*)(ws + WS_DN + layer * SZ_DN), DFF, DFF, DFF, 68, 4, 0}; pg8::StaticOrder S; S.init(64, 4, G, bx, DFF, 4, 11, 256);
            { pg8::Unit fu; int lastpm = -1; for (int i = 0; S.next(i, fu); ++i) if (!fu.split && fu.pm != lastpm) { ffn_fix_panel(a, layer, fu.pm); lastpm = fu.pm; }
              asm volatile("s_waitcnt vmcnt(0)" ::: "memory"); __syncthreads(); }
            EpiRes<false, false> E{nullptr, nullptr, XBP, SSP(2 * layer + 2), nullptr, (float*)(ws + WS_PART)};
            pg8::gemm_phase(lds, g, S, E);
        PHASE_END_T(7)
        if (layer < 3) {
        PHASE_BEGIN sample_fin_phase<11>(a, SSP(2 * layer + 2), (const float*)nullptr); PHASE_END_T(4)
        }
    }
    PHASE_BEGIN_R(REP_MISC) final_phase(a); PHASE_END_T(12)
#undef PHASE_BEGIN
#undef PHASE_BEGIN_R
#undef PHASE_END_T
    if (TS_SEL && blockIdx.x == 0 && threadIdx.x == 0) {
        const float T_us = (float)(*(unsigned long long*)(a.ws + WS_BAR + 14336)) * 0.01f; float* o = a.out + O_PP; o[0] += sqrtf((8e-5f + T_us * 5e-8f) * 122880.0f * 1.0025f);
    }
}

extern "C" void kernel_launch(void* const* d_in, const int* in_sizes, int n_in, void* d_out, int out_size, void* d_ws, size_t ws_size, hipStream_t stream) {
    static int grid = 0;
    if (grid == 0) {
        if (n_in != 22 || (size_t)out_size != O_END || ws_size < WS_END) { fprintf(stderr, "kernel_launch: unexpected shapes (n_in %d, out %d, ws %zu; need out %zu ws %zu)\n", n_in, out_size, ws_size, (size_t)O_END, (size_t)WS_END); grid = -1; return; }
        int dev = 0, cus = 0, per_cu = 0;
        (void)hipGetDevice(&dev); (void)hipDeviceGetAttribute(&cus, hipDeviceAttributeMultiprocessorCount, dev);
        if (hipFuncSetAttribute((const void*)trunk_fwd, hipFuncAttributeMaxDynamicSharedMemorySize, LDS_BYTES) != hipSuccess) { fprintf(stderr, "kernel_launch: hipFuncSetAttribute failed\n"); grid = -1; return; }
        if (hipOccupancyMaxActiveBlocksPerMultiprocessor(&per_cu, (const void*)trunk_fwd, NTHREADS, LDS_BYTES) != hipSuccess || per_cu < 1) { fprintf(stderr, "kernel_launch: occupancy query says %d\n", per_cu); per_cu = 1; }
        (void)hipGetLastError();
        grid = cus * 1;
        if (grid <= 0) grid = 256;
    }
    if (grid < 0) return;
    Args a{};
    for (int i = 0; i < 22; ++i) a.in[i] = (const float*)d_in[i];
    a.out = (float*)d_out; a.ws = (unsigned char*)d_ws; a.ph_lo = 0; a.ph_hi = N_PHASES;
    if (hipMemsetAsync((char*)d_ws + WS_BAR, 0, BAR_BYTES, stream) != hipSuccess) { fprintf(stderr, "kernel_launch: memset failed\n"); return; }
    void* args[] = {&a};
    hipError_t e = hipLaunchCooperativeKernel((const void*)trunk_fwd, dim3(grid), dim3(NTHREADS), args, LDS_BYTES, stream);
    if (e != hipSuccess) fprintf(stderr, "kernel_launch: cooperative launch failed: %s (grid %d)\n", hipGetErrorString(e), grid);
}
```
